# Optimizing an MI355X kernel written in HIP

```python
import math
import jax, jax.numpy as jnp
from jax import lax
import numpy as np

D_MODEL = 1024
BATCH = 8
SEQ = 4096
DEPTH = 4

CHUNK = 64
Q_BLOCK = 128
N_A_LAYERS = DEPTH // 2
N_B_LAYERS = DEPTH - N_A_LAYERS
EPS = 1e-6
NEG = -1e30

A_HEADS = 16
A_HEAD_DIM = D_MODEL // A_HEADS
IDX_HEADS = 8
IDX_DIM = 64
TOPK_MAX = 256
A_IN_COLS = A_HEADS * A_HEAD_DIM + 2 * A_HEAD_DIM + IDX_HEADS * IDX_DIM + IDX_DIM + IDX_HEADS

N_BUCKETS = 32
MAX_DISTANCE = 128

B_HEADS = 16
QK_NOPE = 64
QK_ROPE = 32
QK_DIM = QK_NOPE + QK_ROPE
V_DIM = 64
KV_LORA = 256
Q_LORA = 384
ROPE_THETA = 10000.0

D_FF = 4 * D_MODEL

kernel_name = "yoco_dsa_mla_hybrid_encoder"


def rms_norm(x, g):
    xf = x.astype(jnp.float32)
    y = xf * lax.rsqrt(jnp.mean(xf * xf, axis=-1, keepdims=True) + EPS)
    return (y * g.astype(jnp.float32)).astype(x.dtype)


def t5_bucket(rel):
    nb = N_BUCKETS // 2
    max_exact = nb // 2
    ret = jnp.where(rel > 0, nb, 0)
    n = jnp.abs(rel)
    nf = jnp.maximum(n, 1).astype(jnp.float32)
    large = max_exact + (jnp.log(nf / max_exact) / math.log(MAX_DISTANCE / max_exact)
                         * (nb - max_exact)).astype(jnp.int32)
    large = jnp.minimum(large, nb - 1)
    return ret + jnp.where(n < max_exact, n, large)


def to_blocks(a):
    b, s = a.shape[:2]
    return a.reshape(b, s // Q_BLOCK, Q_BLOCK, *a.shape[2:]).swapaxes(0, 1)


def from_blocks(a):
    nb, b, qb = a.shape[:3]
    return a.swapaxes(0, 1).reshape(b, nb * qb, *a.shape[3:])


def rope_tables(seq_len):
    pos = jnp.arange(seq_len, dtype=jnp.float32)
    inv_freq = 1.0 / (ROPE_THETA ** (jnp.arange(0, QK_ROPE, 2, dtype=jnp.float32) / QK_ROPE))
    ang = pos[:, None] * inv_freq[None, :]
    emb = jnp.concatenate([ang, ang], axis=-1)
    return jnp.cos(emb), jnp.sin(emb)


def rope_tail(x, cos, sin):
    xn, xr = x[..., :QK_NOPE], x[..., QK_NOPE:]
    half = QK_ROPE // 2
    rot = jnp.concatenate([-xr[..., half:], xr[..., :half]], axis=-1)
    xr = xr * cos[:, None, :] + rot * sin[:, None, :]
    return jnp.concatenate([xn, xr.astype(x.dtype)], axis=-1)


def dsa_mixer(h, w_in, q_gain, k_gain, w_o, rel_bias, n_top):
    b, s, _ = h.shape
    proj = h @ w_in
    o1 = A_HEADS * A_HEAD_DIM
    o2 = o1 + A_HEAD_DIM
    o3 = o2 + A_HEAD_DIM
    o4 = o3 + IDX_HEADS * IDX_DIM
    o5 = o4 + IDX_DIM
    q = rms_norm(proj[..., :o1].reshape(b, s, A_HEADS, A_HEAD_DIM), q_gain)
    k = rms_norm(proj[..., o1:o2], k_gain)
    v = proj[..., o2:o3]
    qi = proj[..., o3:o4].reshape(b, s, IDX_HEADS, IDX_DIM)
    ki = proj[..., o4:o5]
    wi = proj[..., o5:]
    key_chunk = jnp.arange(s) // CHUNK

    def block(args):
        qb, qib, wib, t0 = args
        t = t0 + jnp.arange(Q_BLOCK)
        t_chunk = t // CHUNK
        admiss = key_chunk[None, :] <= t_chunk[:, None]
        dots = jnp.einsum('bqhd,bsd->bqhs', qib, ki).astype(jnp.float32) * (IDX_DIM ** -0.5)
        score = jnp.einsum('bqh,bqhs->bqs', wib.astype(jnp.float32) * (IDX_HEADS ** -0.5),
                           jax.nn.relu(dots))
        score = jnp.where(admiss[None], score, NEG)
        _, idx = lax.top_k(score, n_top)
        valid = (idx // CHUNK) <= t_chunk[None, :, None]
        kg = jax.vmap(lambda kk, ii: kk[ii])(k, idx)
        vg = jax.vmap(lambda vv, ii: vv[ii])(v, idx)
        logits = jnp.einsum('bqhd,bqkd->bhqk', qb, kg).astype(jnp.float32) * (A_HEAD_DIM ** -0.5)
        bias = rel_bias[t5_bucket(idx - t[None, :, None])]
        logits = logits + jnp.transpose(bias, (0, 3, 1, 2)).astype(jnp.float32)
        logits = jnp.where(valid[:, None], logits, NEG)
        p = jax.nn.softmax(logits, axis=-1).astype(vg.dtype)
        return jnp.einsum('bhqk,bqkd->bqhd', p, vg)

    starts = jnp.arange(s // Q_BLOCK) * Q_BLOCK
    out = lax.map(block, (to_blocks(q), to_blocks(qi), to_blocks(wi), starts))
    out = from_blocks(out).reshape(b, s, A_HEADS * A_HEAD_DIM)
    return out @ w_o


def mla_shared_kv(h, w_dkv, kv_lora_gain, w_ukv, k_gain, cos, sin):
    b, s, _ = h.shape
    ckr = h @ w_dkv
    c_kv = rms_norm(ckr[..., :KV_LORA], kv_lora_gain)
    k_rope = ckr[..., KV_LORA:]
    kv = (c_kv @ w_ukv).reshape(b, s, B_HEADS, QK_NOPE + V_DIM)
    k_nope, v = kv[..., :QK_NOPE], kv[..., QK_NOPE:]
    k_rope_h = jnp.broadcast_to(k_rope[:, :, None, :], (b, s, B_HEADS, QK_ROPE))
    k = rms_norm(jnp.concatenate([k_nope, k_rope_h], axis=-1), k_gain)
    return rope_tail(k, cos, sin), v


def mla_mixer(h, w_dq, q_lora_gain, w_uq, q_gain, w_o, k, v, cos, sin):
    b, s, _ = h.shape
    q = (rms_norm(h @ w_dq, q_lora_gain) @ w_uq).reshape(b, s, B_HEADS, QK_DIM)
    q = rope_tail(rms_norm(q, q_gain), cos, sin)
    key_chunk = jnp.arange(s) // CHUNK

    def block(args):
        qb, t0 = args
        t = t0 + jnp.arange(Q_BLOCK)
        mask = key_chunk[None, :] <= (t // CHUNK)[:, None]
        logits = jnp.einsum('bqhd,bshd->bhqs', qb, k).astype(jnp.float32) * (QK_DIM ** -0.5)
        logits = jnp.where(mask, logits, NEG)
        p = jax.nn.softmax(logits, axis=-1).astype(v.dtype)
        return jnp.einsum('bhqs,bshd->bqhd', p, v)

    starts = jnp.arange(s // Q_BLOCK) * Q_BLOCK
    out = lax.map(block, (to_blocks(q), starts))
    out = from_blocks(out).reshape(b, s, B_HEADS * V_DIM)
    return out @ w_o


def sq_relu_mlp(h, w_up, w_down):
    return jnp.square(jax.nn.relu(h @ w_up)) @ w_down


def setup_inputs(seed: int = 0) -> dict:
    key = jax.random.key(seed)
    ks = iter(jax.random.split(key, 32))

    def w(shape, fan_in):
        return jax.random.normal(next(ks), shape, jnp.float32) * (fan_in ** -0.5)

    def g(shape):
        return 1.0 + 0.02 * jax.random.normal(next(ks), shape, jnp.float32)

    return {
        "x": jax.random.normal(next(ks), (BATCH, SEQ, D_MODEL), jnp.float32),
        "rel_bias": 0.5 * jax.random.normal(next(ks), (N_BUCKETS, A_HEADS), jnp.float32),
        "a_attn_norm": g((N_A_LAYERS, D_MODEL)),
        "a_w_in": w((N_A_LAYERS, D_MODEL, A_IN_COLS), D_MODEL),
        "a_q_norm": g((N_A_LAYERS, A_HEAD_DIM)),
        "a_k_norm": g((N_A_LAYERS, A_HEAD_DIM)),
        "a_w_o": w((N_A_LAYERS, A_HEADS * A_HEAD_DIM, D_MODEL), A_HEADS * A_HEAD_DIM),
        "kv_norm": g((D_MODEL,)),
        "w_dkv": w((D_MODEL, KV_LORA + QK_ROPE), D_MODEL),
        "kv_lora_norm": g((KV_LORA,)),
        "w_ukv": w((KV_LORA, B_HEADS * (QK_NOPE + V_DIM)), KV_LORA),
        "k_norm": g((QK_DIM,)),
        "b_attn_norm": g((N_B_LAYERS, D_MODEL)),
        "b_w_dq": w((N_B_LAYERS, D_MODEL, Q_LORA), D_MODEL),
        "b_q_lora_norm": g((N_B_LAYERS, Q_LORA)),
        "b_w_uq": w((N_B_LAYERS, Q_LORA, B_HEADS * QK_DIM), Q_LORA),
        "b_q_norm": g((N_B_LAYERS, QK_DIM)),
        "b_w_o": w((N_B_LAYERS, B_HEADS * V_DIM, D_MODEL), B_HEADS * V_DIM),
        "mlp_norm": g((DEPTH, D_MODEL)),
        "mlp_w_up": w((DEPTH, D_MODEL, D_FF), D_MODEL),
        "mlp_w_down": w((DEPTH, D_FF, D_MODEL), D_FF),
    }


def reference(x, rel_bias, a_attn_norm, a_w_in, a_q_norm, a_k_norm, a_w_o,
              kv_norm, w_dkv, kv_lora_norm, w_ukv, k_norm,
              b_attn_norm, b_w_dq, b_q_lora_norm, b_w_uq, b_q_norm, b_w_o,
              mlp_norm, mlp_w_up, mlp_w_down):
    s = x.shape[1]
    n_top = min(TOPK_MAX, s // 4)
    cos, sin = rope_tables(s)
    h = x
    k_shared = None
    v_shared = None
    for layer in range(DEPTH):
        if layer < N_A_LAYERS:
            i = layer
            h = h + dsa_mixer(rms_norm(h, a_attn_norm[i]), a_w_in[i], a_q_norm[i], a_k_norm[i],
                              a_w_o[i], rel_bias, n_top)
        else:
            if layer == N_A_LAYERS:
                k_shared, v_shared = mla_shared_kv(rms_norm(h, kv_norm), w_dkv, kv_lora_norm,
                                                   w_ukv, k_norm, cos, sin)
            j = layer - N_A_LAYERS
            h = h + mla_mixer(rms_norm(h, b_attn_norm[j]), b_w_dq[j], b_q_lora_norm[j], b_w_uq[j],
                              b_q_norm[j], b_w_o[j], k_shared, v_shared, cos, sin)
        h = h + sq_relu_mlp(rms_norm(h, mlp_norm[layer]), mlp_w_up[layer], mlp_w_down[layer])
    return h
```

```cpp
#include <hip/hip_runtime.h>
#include <cstdio>
#include <cstdint>

#ifndef PG8_SP2
#define PG8_SP2 true
#endif
#ifndef PG8_ALIGN
#define PG8_ALIGN true
#endif
constexpr int NWAVES = 8;
constexpr int NB = 8, SEQ = 4096, M = NB * SEQ, D = 1024, FF = 4096, MH = M / 2;
constexpr int A_IN = 1736, NIN = 1792;
constexpr int NKVQ = 768, NUKV = 2048, NDQ1 = 512, NUQ = 1536, QLORA = 384, KVLORA = 256;
constexpr size_t MiB = 1u << 20;
constexpr size_t WS_CTL = 0, CTL_ZERO_BYTES = 1 * MiB;
constexpr size_t WS_WIN = 1 * MiB, WS_WOA = 8 * MiB, WS_WKVQ = 12 * MiB, WS_WUKV = 14 * MiB, WS_WDQ1 = 15 * MiB, WS_WUQ = 16 * MiB, WS_WOB = 19 * MiB, WS_WUP = 23 * MiB, WS_WDN = 55 * MiB;
constexpr size_t WS_SSQH = 87 * MiB, WS_SSQCKV = 89 * MiB, WS_SSQQL = 89 * MiB + 512 * 1024, WS_SSQKR = 90 * MiB + 512 * 1024, WS_KROPE = 91 * MiB, WS_ROPE = 95 * MiB;
constexpr size_t WS_HB = 96 * MiB, WS_KB = 160 * MiB, WS_VB = 256 * MiB, WS_X = 320 * MiB;
constexpr size_t WS_HID = WS_X, WS_QB = WS_X, WS_OB = 416 * MiB, WS_QL = 416 * MiB, WS_CKV = 448 * MiB, WS_END = 480 * MiB;
constexpr size_t WS_AQ = WS_X, WS_AQI = 384 * MiB, WS_AK = 160 * MiB, WS_AV = 164 * MiB, WS_AKI = 168 * MiB, WS_AWI = 172 * MiB;
constexpr size_t WIN_ELEMS = (size_t)NIN * D, WUQ_ELEMS = (size_t)NUQ * QLORA;
constexpr int CW_TMO = 0, CW_CODE = 1, CW_BAR = 4096;
constexpr int RING_OFF = 0, RING_BYTES = 131072;
constexpr int LDSCTL_OFF = RING_BYTES, MISC_OFF = LDSCTL_OFF + 320;
constexpr int LDS_BYTES = 147456;
#define GAS __attribute__((address_space(1)))
#define LAS __attribute__((address_space(3)))
typedef unsigned short bf16;
typedef unsigned v4u __attribute__((ext_vector_type(4)));
typedef float f32x4 __attribute__((ext_vector_type(4)));
typedef short bf16x8 __attribute__((ext_vector_type(8)));
typedef GAS unsigned gu32;
typedef GAS unsigned long long gu64;
#define RLX_AGENT __ATOMIC_RELAXED, __HIP_MEMORY_SCOPE_AGENT
#define LDS_WAIT() asm volatile("s_waitcnt lgkmcnt(0)" ::: "memory")
#define VM_WAIT() asm volatile("s_waitcnt vmcnt(0)" ::: "memory")

typedef const float* cfp_t;
__device__ __forceinline__ cfp_t inp(int i) { return ((volatile cfp_t __attribute__((address_space(4)))*)__builtin_amdgcn_kernarg_segment_ptr())[i]; }
__device__ __forceinline__ float* outp() { return (float*)((volatile cfp_t __attribute__((address_space(4)))*)__builtin_amdgcn_kernarg_segment_ptr())[21]; }
__device__ __forceinline__ unsigned char* wsp() { return (unsigned char*)((volatile cfp_t __attribute__((address_space(4)))*)__builtin_amdgcn_kernarg_segment_ptr())[22]; }
namespace pg8 {
#define PG8_LAS __attribute__((address_space(3)))
typedef unsigned short bf16_t;
typedef short bf16x8 __attribute__((ext_vector_type(8)));
typedef float f32x4 __attribute__((ext_vector_type(4)));
typedef unsigned u32x4 __attribute__((ext_vector_type(4)));
constexpr int BM = 256, BK = 64, HALF = 128, HTB = HALF * BK * 2  , STAGE_BYTES = 8 * HTB, NXCD = 8, WGM = 8;

__host__ __device__ __forceinline__ int lds_byte(int r, int c) { const int st = (r >> 4) * 2 + (c >> 5), rr = r & 15, cc = c & 31, ob = rr * 64 + cc * 2; return st * 1024 + (ob ^ (((ob >> 9) & 1) << 5)); }
__host__ __device__ __forceinline__ void stage_rc(int b, int& R, int& C) { const int st = b / 1024, sb = b % 1024, swz = sb ^ (((sb >> 9) & 1) << 5); R = (st >> 1) * 16 + swz / 64; C = (st & 1) * 32 + (swz % 64) / 2; }
__host__ __device__ __forceinline__ int perm32(int rho) { const int n = rho >> 4, i = rho & 15; return 8 * (i >> 2) + 4 * n + (i & 3); }

struct Unit { int pm, pn; };
struct Gemm { const bf16_t* A; const bf16_t* Bt; int M, N, K; };

struct StaticOrder {
    int nM, nN, nwg, G, c;
    __host__ __device__ void init(int M, int N, int G_, int c_) { nM = M / BM; nN = N / BM; nwg = nM * nN; G = G_; c = c_; }
    __host__ __device__ bool next(int i, Unit& u) const {
        const long L = (long)i * G + c; if (L >= nwg) return false;
        int wgid = (int)L; { const int q = nwg / NXCD, r = nwg % NXCD, xcd = wgid % NXCD, off = wgid / NXCD; wgid = (xcd < r ? xcd * (q + 1) : r * (q + 1) + (xcd - r) * q) + off; }
        const int nig = WGM * nN, gid = wgid / nig, fm = gid * WGM, gsz = (nM - fm) < WGM ? (nM - fm) : WGM;
        u.pm = fm + ((wgid % nig) % gsz); u.pn = (wgid % nig) / gsz; return true;
    }
    __device__ __forceinline__ void a_ready(const Unit&) const {}
    __device__ __forceinline__ void done(const Unit&) const {}
};


typedef float f32x2 __attribute__((ext_vector_type(2)));
typedef __bf16 bf16x2_t __attribute__((ext_vector_type(2)));
__device__ __forceinline__ unsigned cvt_pk_bf16(float lo, float hi) { f32x2 v = {lo, hi}; bf16x2_t b = __builtin_convertvector(v, bf16x2_t); return __builtin_bit_cast(unsigned, b); }
__device__ __forceinline__ u32x4 pack8(f32x4 a, f32x4 b) { u32x4 w; w.x = cvt_pk_bf16(a[0], a[1]); w.y = cvt_pk_bf16(a[2], a[3]); w.z = cvt_pk_bf16(b[0], b[1]); w.w = cvt_pk_bf16(b[2], b[3]); return w; }
__device__ __forceinline__ float sum4sq(f32x4 a) { return (a[0] * a[0] + a[1] * a[1]) + (a[2] * a[2] + a[3] * a[3]); }
__device__ __forceinline__ float red_fq(float s) { s += __shfl_xor(s, 16); s += __shfl_xor(s, 32); return s; }
constexpr float RMS_EPS = 1e-6f;
__device__ __forceinline__ float rstd16(const float* ssq, int row, int fq, float inv_n) { const f32x4 v = *(const f32x4*)(ssq + (size_t)row * 16 + 4 * fq); return __builtin_amdgcn_rsqf(red_fq((v[0] + v[1]) + (v[2] + v[3])) * inv_n + RMS_EPS); }
__device__ __forceinline__ float rstd4(const float* ssq, int row, int fq, float inv_n) { return __builtin_amdgcn_rsqf(red_fq(ssq[(size_t)row * 4 + fq]) * inv_n + RMS_EPS); }
__device__ __forceinline__ float rstd6(const float* ssq, int row, int fq, float inv_n) { const f32x2 v = *(const f32x2*)(ssq + (size_t)row * 8 + 2 * fq); return __builtin_amdgcn_rsqf(red_fq(fq < 3 ? v[0] + v[1] : 0.f) * inv_n + RMS_EPS); }

struct EpiResid {
    static constexpr bool PERM = true, AFTER_DRAIN = false;
    int from_x, r0;
    __device__ __forceinline__ void operator()(const f32x4 (&acc)[2][2][4][2], const Unit& u, int wr, int wc, int fr, int fq) const {
        { int t_ = threadIdx.x; asm volatile("" : "+v"(t_)); fr = t_ & 15; fq = (t_ >> 4) & 3; }
        const int col = u.pn * BM + wc * 64 + fq * 8;
        const float* res = (from_x ? inp(0) : (const float*)outp()) + (size_t)r0 * 1024; float* out = outp() + (size_t)r0 * 1024; bf16_t* hb = (bf16_t*)(wsp() + WS_HB) + (size_t)r0 * 1024; float* ssq = (float*)(wsp() + WS_SSQH) + (size_t)r0 * 16;
#pragma unroll
        for (int ai = 0; ai < 2; ++ai)
#pragma unroll
            for (int m = 0; m < 4; ++m) { const int row = u.pm * BM + ai * HALF + wr * 64 + m * 16 + fr; const size_t off = (size_t)row * 1024 + col; float s = 0.f;
#pragma unroll
                for (int bj = 0; bj < 2; ++bj) { const float* rp = res + off + bj * 32;
                    const f32x4 a = *(const f32x4*)rp + acc[ai][bj][m][0], b = *(const f32x4*)(rp + 4) + acc[ai][bj][m][1];
                    *(f32x4*)(out + off + bj * 32) = a; *(f32x4*)(out + off + bj * 32 + 4) = b; *(u32x4*)(hb + off + bj * 32) = pack8(a, b); s += sum4sq(a) + sum4sq(b); }
                s = red_fq(s); if (fq == 0) ssq[(size_t)row * 16 + u.pn * 4 + wc] = s; }
    }
};
struct EpiUp {
    static constexpr bool PERM = true, AFTER_DRAIN = false;
    int r0;
    __device__ __forceinline__ void operator()(const f32x4 (&acc)[2][2][4][2], const Unit& u, int wr, int wc, int fr, int fq) const {
        { int t_ = threadIdx.x; asm volatile("" : "+v"(t_)); fr = t_ & 15; fq = (t_ >> 4) & 3; }
        const int col = u.pn * BM + wc * 64 + fq * 8;
        const float* ssq = (const float*)(wsp() + WS_SSQH) + (size_t)r0 * 16; bf16_t* hid = (bf16_t*)(wsp() + WS_HID);
#pragma unroll
        for (int ai = 0; ai < 2; ++ai)
#pragma unroll
            for (int m = 0; m < 4; ++m) { const int row = u.pm * BM + ai * HALF + wr * 64 + m * 16 + fr; const float rs = rstd16(ssq, row, fq, 1.f / 1024.f);
#pragma unroll
                for (int bj = 0; bj < 2; ++bj) { f32x4 a = acc[ai][bj][m][0] * rs, b = acc[ai][bj][m][1] * rs;
#pragma unroll
                    for (int e = 0; e < 4; ++e) { a[e] = fmaxf(a[e], 0.f); a[e] *= a[e]; b[e] = fmaxf(b[e], 0.f); b[e] *= b[e]; }
                    *(u32x4*)(hid + (size_t)row * 4096 + col + bj * 32) = pack8(a, b); } }
    }
};

__device__ __forceinline__ void pg8_glds16(const char* sbase, unsigned voff, unsigned lds_dst) { unsigned keep;
    asm volatile("s_mov_b32 %0, m0\n\ts_mov_b32 m0, %3\n\ts_nop 0\n\tglobal_load_lds_dwordx4 %2, %1\n\ts_mov_b32 m0, %0" : "=&s"(keep) : "s"(sbase), "v"(voff), "s"(lds_dst) : "memory"); }

template <int pn_off> struct EpiKvq {
    static constexpr bool PERM = true, AFTER_DRAIN = false;
    __device__ __forceinline__ void operator()(const f32x4 (&acc)[2][2][4][2], const Unit& u, int wr, int wc, int fr, int fq) const {
        { int t_ = threadIdx.x; asm volatile("" : "+v"(t_)); fr = t_ & 15; fq = (t_ >> 4) & 3; }
        const int vpn = u.pn + pn_off; unsigned char* ws = wsp();
        const float* ssqh = (const float*)(ws + WS_SSQH); bf16_t* ckv = (bf16_t*)(ws + WS_CKV); bf16_t* ql = (bf16_t*)(ws + WS_QL); float* krope = (float*)(ws + WS_KROPE); float* ssq_ckv = (float*)(ws + WS_SSQCKV); float* ssq_ql = (float*)(ws + WS_SSQQL); float* ssq_kr = (float*)(ws + WS_SSQKR);
#pragma unroll
        for (int ai = 0; ai < 2; ++ai)
#pragma unroll
            for (int m = 0; m < 4; ++m) { const int row = u.pm * BM + ai * HALF + wr * 64 + m * 16 + fr; const float rs = rstd16(ssqh, row, fq, 1.f / 1024.f);
                const f32x4 a0 = acc[ai][0][m][0] * rs, b0 = acc[ai][0][m][1] * rs, a1 = acc[ai][1][m][0] * rs, b1 = acc[ai][1][m][1] * rs;
                if (vpn == 0) { bf16_t* p = ckv + (size_t)row * 256 + wc * 64 + fq * 8; *(u32x4*)p = pack8(a0, b0); *(u32x4*)(p + 32) = pack8(a1, b1);
                    const float s = red_fq((sum4sq(a0) + sum4sq(b0)) + (sum4sq(a1) + sum4sq(b1))); if (fq == 0) ssq_ckv[(size_t)row * 4 + wc] = s; }
                else if (vpn == 1 || wc < 2) { bf16_t* p = ql + (size_t)row * 384 + (vpn - 1) * 256 + wc * 64 + fq * 8; *(u32x4*)p = pack8(a0, b0); *(u32x4*)(p + 32) = pack8(a1, b1);
                    const float s = red_fq((sum4sq(a0) + sum4sq(b0)) + (sum4sq(a1) + sum4sq(b1))); if (fq == 0) ssq_ql[(size_t)row * 8 + (vpn - 1) * 4 + wc] = s; }
                else if (wc == 2 && pn_off == 0) { float* p = krope + (size_t)row * 32 + fq * 8; *(f32x4*)p = a0; *(f32x4*)(p + 4) = b0;
                    const float s = red_fq(sum4sq(a0) + sum4sq(b0)); if (fq == 0) ssq_kr[row] = s; } }
    }
};
struct EpiUkv {
    static constexpr bool PERM = true, AFTER_DRAIN = false;
    __device__ __forceinline__ void operator()(const f32x4 (&acc)[2][2][4][2], const Unit& u, int wr, int wc, int fr, int fq) const {
        { int t_ = threadIdx.x; asm volatile("" : "+v"(t_)); fr = t_ & 15; fq = (t_ >> 4) & 3; }
        const int G = u.pn * 4 + wc, head = G >> 1; const bool isv = (G & 1) != 0; unsigned char* ws = wsp();
        const float* ssq_ckv = (const float*)(ws + WS_SSQCKV); const float* ssq_kr = (const float*)(ws + WS_SSQKR); const float* krope = (const float*)(ws + WS_KROPE); const float* kgain = inp(11); const float* cosT = (const float*)(ws + WS_ROPE); const float* sinT = cosT + SEQ * 16; bf16_t* kb = (bf16_t*)(ws + WS_KB); bf16_t* vb = (bf16_t*)(ws + WS_VB);
        f32x4 g0a, g0b, g1a, g1b, gr1, gr2;
        if (!isv) { g0a = *(const f32x4*)(kgain + fq * 8); g0b = *(const f32x4*)(kgain + fq * 8 + 4); g1a = *(const f32x4*)(kgain + 32 + fq * 8); g1b = *(const f32x4*)(kgain + 36 + fq * 8);
            gr1 = *(const f32x4*)(kgain + 64 + 4 * fq); gr2 = *(const f32x4*)(kgain + 80 + 4 * fq); }
#pragma unroll
        for (int ai = 0; ai < 2; ++ai)
#pragma unroll
            for (int m = 0; m < 4; ++m) { const int row = u.pm * BM + ai * HALF + wr * 64 + m * 16 + fr; const float rs = rstd4(ssq_ckv, row, fq, 1.f / 256.f);
                const f32x4 a0 = acc[ai][0][m][0] * rs, b0 = acc[ai][0][m][1] * rs, a1 = acc[ai][1][m][0] * rs, b1 = acc[ai][1][m][1] * rs;
                if (isv) { bf16_t* p = vb + ((size_t)row * 16 + head) * 64 + fq * 8; *(u32x4*)p = pack8(a0, b0); *(u32x4*)(p + 32) = pack8(a1, b1); }
                else { const float s = red_fq((sum4sq(a0) + sum4sq(b0)) + (sum4sq(a1) + sum4sq(b1))) + ssq_kr[row]; const float rk = __builtin_amdgcn_rsqf(s * (1.f / 96.f) + RMS_EPS);
                    bf16_t* p = kb + ((size_t)row * 16 + head) * 96; *(u32x4*)(p + fq * 8) = pack8(a0 * g0a * rk, b0 * g0b * rk); *(u32x4*)(p + 32 + fq * 8) = pack8(a1 * g1a * rk, b1 * g1b * rk);
                    const int pos = row & 4095; const f32x4 x1 = *(const f32x4*)(krope + (size_t)row * 32 + 4 * fq) * gr1 * rk, x2 = *(const f32x4*)(krope + (size_t)row * 32 + 16 + 4 * fq) * gr2 * rk;
                    const f32x4 c = *(const f32x4*)(cosT + pos * 16 + 4 * fq), sn = *(const f32x4*)(sinT + pos * 16 + 4 * fq);
                    const f32x4 o1 = x1 * c - x2 * sn, o2 = x2 * c + x1 * sn;
                    typedef unsigned u32x2v __attribute__((ext_vector_type(2)));
                    u32x2v w1, w2; w1.x = cvt_pk_bf16(o1[0], o1[1]); w1.y = cvt_pk_bf16(o1[2], o1[3]); w2.x = cvt_pk_bf16(o2[0], o2[1]); w2.y = cvt_pk_bf16(o2[2], o2[3]);
                    *(u32x2v*)(p + 64 + 4 * fq) = w1; *(u32x2v*)(p + 80 + 4 * fq) = w2; } }
    }
};
struct EpiUq {
    static constexpr bool PERM = true, AFTER_DRAIN = false;
    __device__ __forceinline__ void operator()(const f32x4 (&acc)[2][2][4][2], const Unit& u, int wr, int wc, int fr, int fq) const {
        { int t_ = threadIdx.x; asm volatile("" : "+v"(t_)); fr = t_ & 15; fq = (t_ >> 4) & 3; }
        const int col = u.pn * BM + wc * 64 + fq * 8; const float* ssq_ql = (const float*)(wsp() + WS_SSQQL); bf16_t* qb = (bf16_t*)(wsp() + WS_QB);
#pragma unroll
        for (int ai = 0; ai < 2; ++ai)
#pragma unroll
            for (int m = 0; m < 4; ++m) { const int row = u.pm * BM + ai * HALF + wr * 64 + m * 16 + fr; const float rs = rstd6(ssq_ql, row, fq, 1.f / 384.f);
                bf16_t* p = qb + (size_t)row * 1536 + col; *(u32x4*)p = pack8(acc[ai][0][m][0] * rs, acc[ai][0][m][1] * rs); *(u32x4*)(p + 32) = pack8(acc[ai][1][m][0] * rs, acc[ai][1][m][1] * rs); }
    }
};

struct EpiInproj {
    static constexpr bool PERM = true, AFTER_DRAIN = false;
    int layer;
    __device__ __forceinline__ void operator()(const f32x4 (&acc)[2][2][4][2], const Unit& u, int wr, int wc, int fr, int fq) const {
        { int t_ = threadIdx.x; asm volatile("" : "+v"(t_)); fr = t_ & 15; fq = (t_ >> 4) & 3; }
        unsigned char* ws = wsp(); const float* ssqh = (const float*)(ws + WS_SSQH);
        const bool isq = u.pn < 4, isk = (u.pn == 4 && wc == 0), normed = isq || isk;
        f32x4 g0a = {1.f, 1.f, 1.f, 1.f}, g0b = g0a, g1a = g0a, g1b = g0a;
        if (normed) { const float* gp = (isq ? inp(4) : inp(5)) + layer * 64 + fq * 8; const float sc = isq ? 0.125f * 1.4426950408889634f : 1.f;
            g0a = *(const f32x4*)gp * sc; g0b = *(const f32x4*)(gp + 4) * sc; g1a = *(const f32x4*)(gp + 32) * sc; g1b = *(const f32x4*)(gp + 36) * sc; }
        bf16_t* dst; int ld;
        if (isq) { dst = (bf16_t*)(ws + WS_AQ) + (u.pn * 4 + wc) * 64; ld = 1024; }
        else if (u.pn == 4) { dst = (bf16_t*)(ws + (wc == 0 ? WS_AK : wc == 1 ? WS_AV : WS_AKI)); ld = 64; }
        else { dst = (bf16_t*)(ws + WS_AQI) + ((u.pn - 5) * 4 + wc) * 64; ld = 512; }
        const bool iswi = (u.pn == 4 && wc == 3);
#pragma unroll
        for (int ai = 0; ai < 2; ++ai)
#pragma unroll
            for (int m = 0; m < 4; ++m) { const int row = u.pm * BM + ai * HALF + wr * 64 + m * 16 + fr; const float rs = rstd16(ssqh, row, fq, 1.f / 1024.f);
                f32x4 a0 = acc[ai][0][m][0] * rs, b0 = acc[ai][0][m][1] * rs, a1 = acc[ai][1][m][0] * rs, b1 = acc[ai][1][m][1] * rs;
                if (iswi) { if (fq == 0) { float* p = (float*)(ws + WS_AWI) + (size_t)row * 8; *(f32x4*)p = a0; *(f32x4*)(p + 4) = b0; } }
                else { if (normed) { const float s = red_fq((sum4sq(a0) + sum4sq(b0)) + (sum4sq(a1) + sum4sq(b1))); const float rq = __builtin_amdgcn_rsqf(s * (1.f / 64.f) + RMS_EPS);
                        a0 = a0 * g0a * rq; b0 = b0 * g0b * rq; a1 = a1 * g1a * rq; b1 = b1 * g1b * rq; }
                    bf16_t* p = dst + (size_t)row * ld + fq * 8; *(u32x4*)p = pack8(a0, b0); *(u32x4*)(p + 32) = pack8(a1, b1); } }
    }
};
template <class Epi, class Sched, bool ALIGN_EPI = false, bool SP2 = false>
__device__ __forceinline__ void gemm_phase(PG8_LAS unsigned char* lds, const Gemm g, const Sched& S, const Epi& E) {
    int tid_ = threadIdx.x; asm volatile("" : "+v"(tid_));
    const int tid = tid_, wid = __builtin_amdgcn_readfirstlane(tid >> 6), lane = tid & 63, wr = wid >> 2, wc = wid & 3, fr = lane & 15, fq = lane >> 4;
    const int K = g.K, nt = K / BK;
    unsigned voffA[2], voffB[2];
#pragma unroll
    for (int i = 0; i < 2; ++i) { int R, C; stage_rc(tid * 16 + i * 8192, R, C); const int Rb = Epi::PERM ? ((R & ~31) + perm32(R & 31)) : R;
        voffA[i] = (unsigned)(R * K + C) * 2u; voffB[i] = (unsigned)(Rb * K + C) * 2u; }
    const size_t kstep = (size_t)(BK * 2);
    const size_t hstep = (size_t)HALF * K * 2;
    const size_t tstep = 2 * hstep;
    const unsigned ldsw = (unsigned)wid * 1024u;
    const unsigned ldsb = (unsigned)__builtin_amdgcn_readfirstlane((int)((unsigned)(unsigned long long)lds + ldsw));
    const int aoff = lds_byte(wr * 64 + fr, fq * 8), boff = lds_byte(wc * 32 + fr, fq * 8);
#define PG8_SA(b, h) (((b) * 2 + (h)) * HTB)
#define PG8_SB(b, h) ((4 + (b) * 2 + (h)) * HTB)
#define PG8_STAGE(bufoff, gbase, voff) do { _Pragma("unroll") for (int _i = 0; _i < 2; ++_i) \
        pg8_glds16((const char*)(gbase), (voff)[_i], ldsb + (unsigned)((bufoff) + _i * 8192)); } while (0)
#define PG8_LDA(dst, b, h) do { _Pragma("unroll") for (int m = 0; m < 4; ++m) _Pragma("unroll") for (int k = 0; k < 2; ++k) dst[m][k] = *(const PG8_LAS bf16x8*)(lds + PG8_SA(b, h) + aoff + m * 2048 + k * 1024); } while (0)
#define PG8_LDB(dst, b, h) do { _Pragma("unroll") for (int n = 0; n < 2; ++n) _Pragma("unroll") for (int k = 0; k < 2; ++k) dst[n][k] = *(const PG8_LAS bf16x8*)(lds + PG8_SB(b, h) + boff + n * 2048 + k * 1024); } while (0)
#define PG8_MMA(ai, bj, At, Bt) do { __builtin_amdgcn_s_setprio(1); _Pragma("unroll") for (int m = 0; m < 4; ++m) _Pragma("unroll") for (int n = 0; n < 2; ++n) _Pragma("unroll") for (int k = 0; k < 2; ++k) \
        acc[ai][bj][m][n] = __builtin_amdgcn_mfma_f32_16x16x32_bf16(Bt[n][k], At[m][k], acc[ai][bj][m][n], 0, 0, 0); __builtin_amdgcn_s_setprio(0); } while (0)
#define PG8_WAIT_V(n) asm volatile("s_waitcnt vmcnt(" #n ")" ::: "memory")
#define PG8_WAIT_L(n) asm volatile("s_waitcnt lgkmcnt(" #n ")" ::: "memory")
#define PG8_BAR __builtin_amdgcn_s_barrier()
#define PG8_SCHED __builtin_amdgcn_sched_barrier(0)
    Unit cur, nxt; int ui = 0;
    if (!S.next(0, cur)) return;
    f32x4 acc[2][2][4][2];
#pragma unroll
    for (int a = 0; a < 2; ++a)
#pragma unroll
        for (int b = 0; b < 2; ++b)
#pragma unroll
            for (int m = 0; m < 4; ++m)
#pragma unroll
                for (int n = 0; n < 2; ++n) acc[a][b][m][n] = (f32x4){0.f, 0.f, 0.f, 0.f};
    bf16x8 At[4][2], B0[2][2], B1[2][2];
    const char* cA = (const char*)g.A + (size_t)cur.pm * tstep; const char* cB = (const char*)g.Bt + (size_t)cur.pn * tstep;
    S.a_ready(cur);
    if constexpr (SP2) {
        PG8_STAGE(PG8_SB(0, 0), cB, voffB); PG8_STAGE(PG8_SB(0, 1), cB + hstep, voffB); PG8_STAGE(PG8_SA(0, 0), cA, voffA); PG8_STAGE(PG8_SA(0, 1), cA + hstep, voffA);
        if (wr == 1) PG8_BAR;
        PG8_WAIT_V(2); PG8_BAR;
        PG8_STAGE(PG8_SB(1, 0), cB + kstep, voffB); PG8_STAGE(PG8_SA(1, 0), cA + kstep, voffA); PG8_STAGE(PG8_SB(1, 1), cB + hstep + kstep, voffB);
        PG8_WAIT_V(6); PG8_BAR;
    } else {
        PG8_STAGE(PG8_SB(0, 0), cB, voffB); PG8_STAGE(PG8_SA(0, 0), cA, voffA); PG8_STAGE(PG8_SB(0, 1), cB + hstep, voffB); PG8_STAGE(PG8_SA(0, 1), cA + hstep, voffA);
        if (wr == 1) PG8_BAR;
        PG8_WAIT_V(4); PG8_BAR;
        PG8_STAGE(PG8_SB(1, 0), cB + kstep, voffB); PG8_STAGE(PG8_SA(1, 0), cA + kstep, voffA); PG8_STAGE(PG8_SB(1, 1), cB + hstep + kstep, voffB);
        PG8_WAIT_V(6); PG8_BAR;
    }
    for (;;) {
        const bool has_next = S.next(ui + 1, nxt);
        const char* nA = has_next ? (const char*)g.A + (size_t)nxt.pm * tstep : cA; const char* nB = has_next ? (const char*)g.Bt + (size_t)nxt.pn * tstep : cB;
        for (int t = 0; t < nt; t += 2) {
            const bool last = (t == nt - 2);
            const char* a1 = cA + (size_t)(t + 1) * kstep;
            const char* a2 = last ? nA : cA + (size_t)(t + 2) * kstep; const char* b2 = last ? nB : cB + (size_t)(t + 2) * kstep;
            const char* a3 = a2 + kstep; const char* b3 = b2 + kstep;
            if (last && has_next) S.a_ready(nxt);
            if constexpr (SP2) {
            PG8_LDB(B0, 0, 0); PG8_LDB(B1, 0, 1); PG8_SCHED; PG8_LDA(At, 0, 0); PG8_STAGE(PG8_SA(1, 1), a1 + hstep, voffA);
            PG8_WAIT_V(8); PG8_WAIT_L(0); PG8_BAR; PG8_MMA(0, 0, At, B0); PG8_MMA(0, 1, At, B1); PG8_BAR; PG8_SCHED;
            PG8_LDA(At, 0, 1); PG8_STAGE(PG8_SB(0, 0), b2, voffB); PG8_STAGE(PG8_SB(0, 1), b2 + hstep, voffB); PG8_STAGE(PG8_SA(0, 0), a2, voffA);
            PG8_WAIT_V(8); PG8_WAIT_L(0); PG8_BAR; PG8_MMA(1, 0, At, B0); PG8_MMA(1, 1, At, B1); PG8_BAR; PG8_SCHED;
            PG8_LDB(B0, 1, 0); PG8_LDB(B1, 1, 1); PG8_SCHED; PG8_LDA(At, 1, 0); PG8_STAGE(PG8_SA(0, 1), a2 + hstep, voffA);
            PG8_WAIT_V(8); PG8_WAIT_L(0); PG8_BAR; PG8_MMA(0, 0, At, B0); PG8_MMA(0, 1, At, B1); PG8_BAR; PG8_SCHED;
            PG8_LDA(At, 1, 1); PG8_STAGE(PG8_SB(1, 0), b3, voffB); PG8_STAGE(PG8_SB(1, 1), b3 + hstep, voffB); PG8_STAGE(PG8_SA(1, 0), a3, voffA);
            PG8_WAIT_V(8); PG8_WAIT_L(0); PG8_BAR; PG8_MMA(1, 0, At, B0); PG8_MMA(1, 1, At, B1); PG8_BAR; PG8_SCHED;
            } else {
            PG8_LDB(B0, 0, 0); PG8_SCHED; PG8_LDA(At, 0, 0); PG8_STAGE(PG8_SA(1, 1), a1 + hstep, voffA);
            PG8_WAIT_L(8); PG8_BAR; PG8_WAIT_L(0); PG8_MMA(0, 0, At, B0); PG8_BAR; PG8_SCHED;
            PG8_LDB(B1, 0, 1); PG8_STAGE(PG8_SB(0, 0), b2, voffB);
            PG8_BAR; PG8_WAIT_L(0); PG8_MMA(0, 1, At, B1); PG8_BAR;
            PG8_LDA(At, 0, 1); PG8_STAGE(PG8_SA(0, 0), a2, voffA);
            PG8_BAR; PG8_WAIT_L(0); PG8_MMA(1, 0, At, B0); PG8_BAR; PG8_SCHED;
            PG8_STAGE(PG8_SB(0, 1), b2 + hstep, voffB);
            PG8_WAIT_V(6); PG8_BAR; PG8_MMA(1, 1, At, B1); PG8_BAR;
            PG8_LDB(B0, 1, 0); PG8_SCHED; PG8_LDA(At, 1, 0); PG8_STAGE(PG8_SA(0, 1), a2 + hstep, voffA);
            PG8_WAIT_L(8); PG8_BAR; PG8_WAIT_L(0); PG8_MMA(0, 0, At, B0); PG8_BAR; PG8_SCHED;
            PG8_LDB(B1, 1, 1); PG8_STAGE(PG8_SB(1, 0), b3, voffB);
            PG8_BAR; PG8_WAIT_L(0); PG8_MMA(0, 1, At, B1); PG8_BAR;
            PG8_LDA(At, 1, 1); PG8_STAGE(PG8_SA(1, 0), a3, voffA);
            PG8_BAR; PG8_WAIT_L(0); PG8_MMA(1, 0, At, B0); PG8_BAR; PG8_SCHED;
            PG8_STAGE(PG8_SB(1, 1), b3 + hstep, voffB);
            PG8_WAIT_V(6); PG8_BAR; PG8_MMA(1, 1, At, B1); PG8_BAR;
            }
        }
        if constexpr (ALIGN_EPI) { if (wr == 0) PG8_BAR; }
        if constexpr (!Epi::AFTER_DRAIN) { E(acc, cur, wr, wc, fr, fq); S.done(cur); }
        if (!has_next) break;
#pragma unroll
        for (int a = 0; a < 2; ++a)
#pragma unroll
            for (int b = 0; b < 2; ++b)
#pragma unroll
                for (int m = 0; m < 4; ++m)
#pragma unroll
                    for (int n = 0; n < 2; ++n) acc[a][b][m][n] = (f32x4){0.f, 0.f, 0.f, 0.f};
        cur = nxt; cA = nA; cB = nB; ++ui;
        if constexpr (ALIGN_EPI) { if (wr == 1) PG8_BAR; }
    }
    PG8_WAIT_V(0);
    if constexpr (!ALIGN_EPI) { if (wr == 0) PG8_BAR; }
    PG8_BAR;
    if constexpr (Epi::AFTER_DRAIN) { E.fused(acc, cur, wr, wc, fr, fq, lds, wid, lane); S.done(cur); }
#undef PG8_SA
#undef PG8_SB
#undef PG8_STAGE
#undef PG8_LDA
#undef PG8_LDB
#undef PG8_MMA
#undef PG8_WAIT_V
#undef PG8_WAIT_L
#undef PG8_BAR
#undef PG8_SCHED
}
}
__device__ __forceinline__ unsigned long long rt() { return __builtin_amdgcn_s_memrealtime(); }
__device__ __forceinline__ unsigned f2bf(float f) { unsigned u = __builtin_bit_cast(unsigned, f); return (u + 0x7fffu + ((u >> 16) & 1u)) >> 16; }
__device__ __forceinline__ unsigned pk2(float lo, float hi) { return f2bf(lo) | (f2bf(hi) << 16); }

#define XB_TMO      128
#define XB_XCNT(j)  (256  + 64 * (j))
#define XB_XSUB(j)  (1280 + 64 * (j))
#define XB_XGEN(j)  (2304 + 64 * (j))
#define XB_TOP      3328
#define XB_TOPGEN   3392
#define XCD_BAR_WORDS 3456
#define XB_SPIN_CAP (1u << 18)

__device__ __forceinline__ unsigned xb_ld(unsigned* p)              { return __hip_atomic_load(p, __ATOMIC_RELAXED, __HIP_MEMORY_SCOPE_AGENT); }
__device__ __forceinline__ unsigned xb_add(unsigned* p, unsigned v) { return __hip_atomic_fetch_add(p, v, __ATOMIC_RELAXED, __HIP_MEMORY_SCOPE_AGENT); }
__device__ __forceinline__ unsigned xb_xcc_id() { return (unsigned)__builtin_amdgcn_s_getreg((3 << 11) | 20) & 0xFu; }
#define XB_SPIN(cond, bar) do { unsigned _sp = 0; while (cond) { __builtin_amdgcn_s_sleep(1); \
    if ((++_sp & 255u) == 0u) { if (xb_ld(&(bar)[XB_TMO])) break; if (_sp > XB_SPIN_CAP) { atomicAdd(&(bar)[XB_TMO], 1u); break; } } } } while (0)

struct XcdBarrier {
    unsigned* bar; unsigned x;
    volatile LAS unsigned* st;
};

__device__ __forceinline__ XcdBarrier xcd_barrier_post(unsigned* bar, volatile LAS unsigned* st) {
    XcdBarrier b; b.bar = bar; b.x = xb_xcc_id(); b.st = st;
    if (threadIdx.x == 0) (void)xb_add(&bar[XB_XCNT(b.x)], 1u);
    return b;
}
__device__ __forceinline__ void xcd_barrier_complete(unsigned* bar, unsigned x, unsigned& nloc, unsigned& nx) {
    const unsigned G = gridDim.x * gridDim.y * gridDim.z;
    unsigned sum, cnt, mine, sp = 0u;
    for (;;) {
        sum = 0u; cnt = 0u; mine = 0u;
#pragma unroll
        for (unsigned j = 0; j < 16; ++j) { const unsigned c = xb_ld(&bar[XB_XCNT(j)]); sum += c; cnt += (c > 0u) ? 1u : 0u; }
        if (sum == G) break;
        __builtin_amdgcn_s_sleep(1);
        if ((++sp & 255u) == 0u) { if (xb_ld(&bar[XB_TMO])) break; if (sp > XB_SPIN_CAP) { atomicAdd(&bar[XB_TMO], 1u); break; } }
    }
    mine = xb_ld(&bar[XB_XCNT(x)]);
    nloc = mine > 0u ? mine : 1u; nx = cnt > 0u ? cnt : 1u;
}

__device__ __forceinline__ void xcd_barrier(const XcdBarrier& b) {
    asm volatile("s_waitcnt vmcnt(0)" ::: "memory");
    __syncthreads();
    if (threadIdx.x == 0) {
        unsigned* bar = b.bar;
        __builtin_amdgcn_s_waitcnt(0);
        unsigned nloc = b.st[0], nx = b.st[1];
        if (nloc == 0u) { xcd_barrier_complete(bar, b.x, nloc, nx); b.st[0] = nloc; b.st[1] = nx; }
        const unsigned old = xb_add(&bar[XB_XSUB(b.x)], 1u);
        const unsigned gen = old / nloc;
        if (old + 1u == (gen + 1u) * nloc) {
            __builtin_amdgcn_fence(__ATOMIC_RELEASE, "agent");
            asm volatile("s_waitcnt vmcnt(0)" ::: "memory");
            const unsigned og = xb_add(&bar[XB_TOP], 1u);
            const unsigned tg = og / nx;
            if (og + 1u == (tg + 1u) * nx) xb_add(&bar[XB_TOPGEN], 1u);
            else XB_SPIN(xb_ld(&bar[XB_TOPGEN]) == tg, bar);
            __builtin_amdgcn_fence(__ATOMIC_ACQUIRE, "agent");
            xb_add(&bar[XB_XGEN(b.x)], 1u);
            asm volatile("s_waitcnt vmcnt(0)" ::: "memory");
        } else {
            XB_SPIN(xb_ld(&bar[XB_XGEN(b.x)]) == gen, bar);
            __builtin_amdgcn_fence(__ATOMIC_ACQUIRE, "agent");
            asm volatile("s_waitcnt vmcnt(0)" ::: "memory");
        }
    }
    __syncthreads();
}


struct Frame {
    LAS unsigned char* lds;
    volatile LAS unsigned* MISC;
    gu32* ctl;
    int tid, lane, wave;
    int vcu, G, gw;
};
__device__ __forceinline__ float wave_sum(float v) {
#pragma unroll
    for (int o = 1; o < 64; o <<= 1) v += __shfl_xor(v, o);
    return v;
}
__device__ __forceinline__ int phys_row(int lc) { return (lc & ~255) + 128 * ((lc >> 5) & 1) + 32 * ((lc >> 6) & 3) + (lc & 31); }
__device__ __forceinline__ void tr_item(const float* W, int ldw, int c0, int nvalid, const float* gain, bf16* WT, int Kd, int dst_row, int k0, LAS float* scr, int lane) {
    const int n = lane & 31;
#pragma unroll 8
    for (int i = 0; i < 32; ++i) { const int kk = 2 * i + (lane >> 5); float v = 0.f;
        if (n < nvalid) { v = W[(size_t)(k0 + kk) * ldw + c0 + n]; if (gain) v *= gain[k0 + kk]; }
        scr[kk * 33 + n] = v; }
    LDS_WAIT(); asm volatile("" ::: "memory");
    const int c = lane & 7;
#pragma unroll
    for (int j = 0; j < 4; ++j) { const int nn = (lane >> 3) + 8 * j; const LAS float* s = scr + (8 * c) * 33 + nn;
        v4u o; o.x = pk2(s[0 * 33], s[1 * 33]); o.y = pk2(s[2 * 33], s[3 * 33]); o.z = pk2(s[4 * 33], s[5 * 33]); o.w = pk2(s[6 * 33], s[7 * 33]);
        *(GAS v4u*)(WT + (size_t)(dst_row + nn) * Kd + k0 + 8 * c) = o; }
    LDS_WAIT(); asm volatile("" ::: "memory");
}
__device__ __forceinline__ void conv_seg(Frame& F, LAS float* scr, int& rot, const float* W, int ldw, int c0, int ncols, const float* gain, bf16* WT, int Kd, int lc0) {
    const int ng = (ncols + 31) / 32, nk = Kd / 64, nit = ng * nk, NGW = F.G * NWAVES;
    int it = F.gw - rot; if (it < 0) it += NGW;
    for (; it < nit; it += NGW) { const int g = it % ng, kb = it / ng; int nv = ncols - 32 * g; nv = nv > 32 ? 32 : nv; if (!W) nv = 0;
        tr_item(W, ldw, c0 + 32 * g, nv, gain, WT, Kd, phys_row(lc0 + 32 * g), 64 * kb, scr, F.lane); }
    rot = (rot + nit) % NGW;
}
__device__ __forceinline__ void p0_prologue(Frame& F) {
    LAS float* scr = (LAS float*)(F.lds + RING_OFF + F.wave * 16384);
    int rot = 0;
#define ws wsp()
    const int NGW = F.G * NWAVES;
    { bf16* hb = (bf16*)(ws + WS_HB); float* ssq = (float*)(ws + WS_SSQH); const float* x = inp(0);
      for (int r = F.gw; r < M; r += NGW) { const GAS f32x4* xr = (const GAS f32x4*)(x + (size_t)r * D) + F.lane; f32x4 v[4]; float s = 0.f;
#pragma unroll
          for (int j = 0; j < 4; ++j) { v[j] = xr[64 * j]; s += (v[j].x * v[j].x + v[j].y * v[j].y) + (v[j].z * v[j].z + v[j].w * v[j].w); }
          s = wave_sum(s);
          GAS unsigned long long* o8 = (GAS unsigned long long*)(hb + (size_t)r * D) + F.lane;
#pragma unroll
          for (int j = 0; j < 4; ++j) o8[64 * j] = (unsigned long long)pk2(v[j].x, v[j].y) | ((unsigned long long)pk2(v[j].z, v[j].w) << 32);
          if (F.lane < 16) ssq[(size_t)r * 16 + F.lane] = F.lane == 0 ? s : 0.f; } }
    { float* ct = (float*)(ws + WS_ROPE); float* st = ct + SEQ * 16;
      for (int e = F.vcu * 512 + F.tid; e < SEQ * 16; e += F.G * 512) { const int pos = e >> 4, i = e & 15;
          const double invd = i == 0 ? 1.0 : i == 1 ? 0.5623413251903491 : i == 2 ? 0.31622776601683794 : i == 3 ? 0.17782794100389226 : i == 4 ? 0.1 : i == 5 ? 0.056234132519034905 : i == 6 ? 0.03162277660168379 : i == 7 ? 0.01778279410038923 :
                              i == 8 ? 0.01 : i == 9 ? 0.005623413251903491 : i == 10 ? 0.003162277660168379 : i == 11 ? 0.001778279410038923 : i == 12 ? 0.001 : i == 13 ? 0.0005623413251903491 : i == 14 ? 0.00031622776601683794 : 0.00017782794100389227;
          const float angf = (float)pos * (float)invd; const double a = (double)angf;
          const double nq = __builtin_rint(a * 0.6366197723675814); const double r = (a - nq * 1.5707963267948966) - nq * 6.123233995736766e-17; const double r2 = r * r;
          const double sn = r * (1.0 + r2 * (-1.0 / 6 + r2 * (1.0 / 120 + r2 * (-1.0 / 5040 + r2 * (1.0 / 362880 + r2 * (-1.0 / 39916800 + r2 * (1.0 / 6227020800.0)))))));
          const double cs = 1.0 + r2 * (-0.5 + r2 * (1.0 / 24 + r2 * (-1.0 / 720 + r2 * (1.0 / 40320 + r2 * (-1.0 / 3628800 + r2 * (1.0 / 479001600.0 + r2 * (-1.0 / 87178291200.0)))))));
          const int q = (int)nq & 3; const double c = q == 0 ? cs : q == 1 ? -sn : q == 2 ? -cs : sn, s = q == 0 ? sn : q == 1 ? cs : q == 2 ? -sn : -cs;
          ct[e] = (float)c; st[e] = (float)s; } }
    for (int i = 0; i < 2; ++i) { const float* W = inp(3) + (size_t)i * D * A_IN; const float* g = inp(2) + i * D; bf16* WT = (bf16*)(ws + WS_WIN) + (size_t)i * WIN_ELEMS;
        conv_seg(F, scr, rot, W, A_IN, 0, 1152, g, WT, D, 0);
        conv_seg(F, scr, rot, W, A_IN, 1664, 64, g, WT, D, 1152);
        conv_seg(F, scr, rot, W, A_IN, 1728, 8, g, WT, D, 1216);
        conv_seg(F, scr, rot, nullptr, 0, 0, 32, nullptr, WT, D, 1248);
        conv_seg(F, scr, rot, W, A_IN, 1152, 512, g, WT, D, 1280);
        conv_seg(F, scr, rot, inp(6) + (size_t)i * D * D, D, 0, D, nullptr, (bf16*)(ws + WS_WOA) + (size_t)i * D * D, D, 0); }
    { bf16* WT = (bf16*)(ws + WS_WKVQ);
      conv_seg(F, scr, rot, inp(8), 288, 0, 256, inp(7), WT, D, 0);
      conv_seg(F, scr, rot, inp(13), QLORA, 0, QLORA, inp(12), WT, D, 256);
      conv_seg(F, scr, rot, inp(8), 288, 256, 32, inp(7), WT, D, 640);
      conv_seg(F, scr, rot, nullptr, 0, 0, 96, nullptr, WT, D, 672); }
    conv_seg(F, scr, rot, inp(10), NUKV, 0, NUKV, inp(9), (bf16*)(ws + WS_WUKV), KVLORA, 0);
    { bf16* WT = (bf16*)(ws + WS_WDQ1);
      conv_seg(F, scr, rot, inp(13) + (size_t)D * QLORA, QLORA, 0, QLORA, inp(12) + D, WT, D, 0);
      conv_seg(F, scr, rot, nullptr, 0, 0, 128, nullptr, WT, D, 384); }
    for (int j = 0; j < 2; ++j) {
        conv_seg(F, scr, rot, inp(15) + (size_t)j * QLORA * NUQ, NUQ, 0, NUQ, inp(14) + j * QLORA, (bf16*)(ws + WS_WUQ) + (size_t)j * WUQ_ELEMS, QLORA, 0);
        conv_seg(F, scr, rot, inp(17) + (size_t)j * D * D, D, 0, D, nullptr, (bf16*)(ws + WS_WOB) + (size_t)j * D * D, D, 0); }
    for (int L = 0; L < 4; ++L) {
        conv_seg(F, scr, rot, inp(19) + (size_t)L * D * FF, FF, 0, FF, inp(18) + L * D, (bf16*)(ws + WS_WUP) + (size_t)L * D * FF, D, 0);
        conv_seg(F, scr, rot, inp(20) + (size_t)L * D * FF, D, 0, D, nullptr, (bf16*)(ws + WS_WDN) + (size_t)L * D * FF, FF, 0); }
#undef ws
}

namespace mla {
using bf16x8 = __attribute__((ext_vector_type(8))) short;
using s16x4  = __attribute__((ext_vector_type(4))) short;
using f32x16 = __attribute__((ext_vector_type(16))) float;
using u32x4  = __attribute__((ext_vector_type(4))) unsigned;
using u32x2  = __attribute__((ext_vector_type(2))) unsigned;
constexpr int NW = 8, QBLK = 32, KVBLK = 64, LDQ = 1536, LDK = 1536, LDV = 1024, LDO = 1024, SEQL = 4096;
constexpr float SCALE = 0.10206207261596575f;
constexpr float THR = 8.f;
constexpr int SHM_V = KVBLK * 64 * 2, SHM_K = KVBLK * 256;
constexpr int SHM_ATTN = 2 * SHM_V + 2 * SHM_K + NW * 64 * 4;
#define KSWZ(row, colB) ((row) * 256 + ((colB) ^ (((row) & 7) << 4)))
#define SBAR() __builtin_amdgcn_sched_barrier(0)
__device__ __forceinline__ int crow(int r, int hi) { return (r & 3) + 8 * (r >> 2) + 4 * hi; }
__device__ __forceinline__ unsigned cvtpk(float lo, float hi) { return pg8::cvt_pk_bf16(lo, hi); }
__device__ __forceinline__ void partialSM(f32x16& p0, f32x16& p1, float& m_reg, float& mn, float& alpha) {
  constexpr float C = SCALE * 1.4426950408889634f;
  float pmax = p0[0];
#pragma unroll
  for (int r = 1; r < 16; ++r) pmax = fmaxf(pmax, p0[r]);
#pragma unroll
  for (int r = 0; r < 16; ++r) pmax = fmaxf(pmax, p1[r]);
  { auto rr = __builtin_amdgcn_permlane32_swap(__float_as_uint(pmax), __float_as_uint(pmax), false, false);
    pmax = fmaxf(__uint_as_float(rr[0]), __uint_as_float(rr[1])); }
  if (__builtin_expect(__all(pmax - m_reg <= THR / SCALE), 1)) { mn = m_reg; alpha = 1.f; }
  else { mn = fmaxf(m_reg, pmax); alpha = __builtin_amdgcn_exp2f((m_reg - mn) * C); m_reg = mn; }
  const float mnC = -mn * C;
#pragma unroll
  for (int r = 0; r < 16; ++r) p0[r] = fmaf(p0[r], C, mnC);
#pragma unroll
  for (int r = 0; r < 16; ++r) p1[r] = fmaf(p1[r], C, mnC);
#pragma unroll
  for (int r = 0; r < 16; ++r) p0[r] = __builtin_amdgcn_exp2f(p0[r]);
}
__device__ __forceinline__ void finishSM(f32x16& p0, f32x16& p1, float alpha, float& l_reg, bf16x8& pa0, bf16x8& pa1, bf16x8& pa2, bf16x8& pa3) {
#pragma unroll
  for (int r = 0; r < 16; ++r) p1[r] = __builtin_amdgcn_exp2f(p1[r]);
  float ps = 0;
#pragma unroll
  for (int r = 0; r < 16; ++r) ps += p0[r];
#pragma unroll
  for (int r = 0; r < 16; ++r) ps += p1[r];
  { auto rr = __builtin_amdgcn_permlane32_swap(__float_as_uint(ps), __float_as_uint(ps), false, false);
    ps = __uint_as_float(rr[0]) + __uint_as_float(rr[1]); }
  l_reg = l_reg * alpha + ps;
#define PK4(P, BASE, OUT) do { unsigned a0 = cvtpk(P[BASE + 0], P[BASE + 1]), a1 = cvtpk(P[BASE + 2], P[BASE + 3]);   \
    unsigned b0 = cvtpk(P[BASE + 4], P[BASE + 5]), b1 = cvtpk(P[BASE + 6], P[BASE + 7]);                              \
    auto r0 = __builtin_amdgcn_permlane32_swap(a0, b0, false, false); auto r1 = __builtin_amdgcn_permlane32_swap(a1, b1, false, false); \
    u32x4 w = {r0[0], r1[0], r0[1], r1[1]}; OUT = __builtin_bit_cast(bf16x8, w); } while (0)
  PK4(p0, 0, pa0); PK4(p0, 8, pa1); PK4(p1, 0, pa2); PK4(p1, 8, pa3);
#undef PK4
}
__device__ __forceinline__ void qkt(f32x16& p0, f32x16& p1, const char* Ks, const bf16x8* qr, int r32, int hi) {
  p0 = f32x16{}; p1 = f32x16{};
#pragma unroll
  for (int d0 = 0; d0 < 6; ++d0) { const int cb = (d0 * 16 + hi * 8) * 2;
    const bf16x8 b0 = *reinterpret_cast<const bf16x8*>(Ks + KSWZ(r32, cb));
    const bf16x8 b1 = *reinterpret_cast<const bf16x8*>(Ks + KSWZ(32 + r32, cb));
    p0 = __builtin_amdgcn_mfma_f32_32x32x16_bf16(b0, qr[d0], p0, 0, 0, 0);
    p1 = __builtin_amdgcn_mfma_f32_32x32x16_bf16(b1, qr[d0], p1, 0, 0, 0); }
}
__device__ __forceinline__ int v_st(int k, int c) { const int kk = (k & ~0xC) | ((k & 4) << 1) | ((k & 8) >> 1); return ((kk >> 3) * 2 + (c >> 5)) * 512 + ((kk & 7) * 32 + (c & 31)) * 2; }
__device__ __forceinline__ int v_rd_base(int lane) { return ((lane & 3) << 3) | (((lane >> 2) & 3) << 6) | (((lane >> 4) & 1) << 5) | (((lane >> 5) & 1) << 8); }
constexpr int v_rd_off(int d0, int ks, int half) { return d0 * 512 + ks * 2048 + half * 1024; }
template <int OFF> __device__ __forceinline__ s16x4 tr_read(int vb) {
  s16x4 r; asm volatile("ds_read_b64_tr_b16 %0, %1 offset:%2" : "=&v"(r) : "v"(vb), "i"(OFF) : "memory"); return r;
}
template <int D0> __device__ __forceinline__ void pv_one(f32x16& od, int vb, bf16x8 pa0, bf16x8 pa1, bf16x8 pa2, bf16x8 pa3) {
  const s16x4 l0 = tr_read<v_rd_off(D0, 0, 0)>(vb), h0 = tr_read<v_rd_off(D0, 0, 1)>(vb), l1 = tr_read<v_rd_off(D0, 1, 0)>(vb), h1 = tr_read<v_rd_off(D0, 1, 1)>(vb);
  const s16x4 l2 = tr_read<v_rd_off(D0, 2, 0)>(vb), h2 = tr_read<v_rd_off(D0, 2, 1)>(vb), l3 = tr_read<v_rd_off(D0, 3, 0)>(vb), h3 = tr_read<v_rd_off(D0, 3, 1)>(vb);
  asm volatile("s_waitcnt lgkmcnt(0)" ::: "memory"); SBAR();
#define PK(L, H) (bf16x8){L[0], L[1], L[2], L[3], H[0], H[1], H[2], H[3]}
  od = __builtin_amdgcn_mfma_f32_32x32x16_bf16(pa0, PK(l0, h0), od, 0, 0, 0);
  od = __builtin_amdgcn_mfma_f32_32x32x16_bf16(pa1, PK(l1, h1), od, 0, 0, 0);
  od = __builtin_amdgcn_mfma_f32_32x32x16_bf16(pa2, PK(l2, h2), od, 0, 0, 0);
  od = __builtin_amdgcn_mfma_f32_32x32x16_bf16(pa3, PK(l3, h3), od, 0, 0, 0);
#undef PK
}
__device__ __forceinline__ void pv_d0(f32x16* o, int vb, bf16x8 pa0, bf16x8 pa1, bf16x8 pa2, bf16x8 pa3) {
  pv_one<0>(o[0], vb, pa0, pa1, pa2, pa3); pv_one<1>(o[1], vb, pa0, pa1, pa2, pa3);
}
__device__ __forceinline__ float bf2f(short s) { return __uint_as_float(((unsigned)(unsigned short)s) << 16); }

__device__ __forceinline__ void attn_unit(const pg8::bf16_t* __restrict__ Qh, const pg8::bf16_t* __restrict__ Kh, const pg8::bf16_t* __restrict__ Vh, pg8::bf16_t* __restrict__ Oh,
                                          const float* __restrict__ qgain, const float* __restrict__ cosT, const float* __restrict__ sinT, int qb, char* lds) {
  int tid_ = threadIdx.x; asm volatile("" : "+v"(tid_));
  const int tid = tid_, wid = __builtin_amdgcn_readfirstlane(tid >> 6), lane = tid & 63, r32 = lane & 31, hi = lane >> 5;
  char* V_lds = lds; char* K_lds = lds + 2 * SHM_V;
  float* ws = (float*)(lds + 2 * SHM_V + 2 * SHM_K) + wid * 64; float* li_l = ws; float* al_l = ws + 32;
  float m_reg = -1e30f, l_reg = 0; f32x16 o[2] = {}; bf16x8 qr[6];
  const int q0 = qb * 256, qrow = q0 + wid * QBLK + r32;
  {
    const pg8::bf16_t* Qw = Qh + (size_t)qrow * LDQ + hi * 8; float qf[6][8]; float ss = 0.f;
#pragma unroll
    for (int d0 = 0; d0 < 6; ++d0) { const bf16x8 raw = *reinterpret_cast<const bf16x8*>(Qw + d0 * 16);
#pragma unroll
      for (int j = 0; j < 8; ++j) { qf[d0][j] = bf2f(raw[j]); ss += qf[d0][j] * qf[d0][j]; } }
    { auto rr = __builtin_amdgcn_permlane32_swap(__float_as_uint(ss), __float_as_uint(ss), false, false); ss = __uint_as_float(rr[0]) + __uint_as_float(rr[1]); }
    const float rq = __builtin_amdgcn_rsqf(ss * (1.f / 96.f) + 1e-6f);
#pragma unroll
    for (int d0 = 0; d0 < 6; ++d0)
#pragma unroll
      for (int j = 0; j < 8; ++j) qf[d0][j] *= rq * qgain[d0 * 16 + hi * 8 + j];
#pragma unroll
    for (int j = 0; j < 8; ++j) { const float c = cosT[qrow * 16 + hi * 8 + j], s = sinT[qrow * 16 + hi * 8 + j]; const float x1 = qf[4][j], x2 = qf[5][j];
      qf[4][j] = x1 * c - x2 * s; qf[5][j] = x2 * c + x1 * s; }
#pragma unroll
    for (int d0 = 0; d0 < 6; ++d0) { u32x4 w = {cvtpk(qf[d0][0], qf[d0][1]), cvtpk(qf[d0][2], qf[d0][3]), cvtpk(qf[d0][4], qf[d0][5]), cvtpk(qf[d0][6], qf[d0][7])}; qr[d0] = __builtin_bit_cast(bf16x8, w); }
  }
  const int cqw = 4 * qb + (wid >> 1);
  const int srow = tid >> 3, sc8 = tid & 7;
  const int vst = v_st(srow, sc8 * 8), kst0 = KSWZ(srow, sc8 * 16), kst1 = KSWZ(srow, 128 + sc8 * 8);
  const int vb0 = (int)(uintptr_t)V_lds + v_rd_base(lane);
  struct { bf16x8 v, k0; u32x2 k1; } sr_[2];
#define SLOAD(i, k0_) do { sr_[i].v = *reinterpret_cast<const bf16x8*>(Vh + (size_t)((k0_) + srow) * LDV + sc8 * 8); \
    sr_[i].k0 = *reinterpret_cast<const bf16x8*>(Kh + (size_t)((k0_) + srow) * LDK + sc8 * 8); sr_[i].k1 = *reinterpret_cast<const u32x2*>(Kh + (size_t)((k0_) + srow) * LDK + 64 + sc8 * 4); } while (0)
#define SWRITE(b, i) do { *(bf16x8*)(V_lds + (b) * SHM_V + vst) = sr_[i].v; *(bf16x8*)(K_lds + (b) * SHM_K + kst0) = sr_[i].k0; *(u32x2*)(K_lds + (b) * SHM_K + kst1) = sr_[i].k1; } while (0)
#define SWAIT() asm volatile("s_waitcnt vmcnt(3)" ::: "memory")
#define RESC(a) do { if (__any((a) < 1.f)) { if (hi == 0) al_l[r32] = (a); asm volatile("s_waitcnt lgkmcnt(0)" ::: "memory"); \
    _Pragma("unroll") for (int d = 0; d < 2; ++d) _Pragma("unroll") for (int r = 0; r < 16; ++r) o[d][r] *= al_l[crow(r, hi)]; } } while (0)
#define MASKT(P0, P1, j) do { if ((j) > cqw) { _Pragma("unroll") for (int r = 0; r < 16; ++r) { P0[r] = -1e30f; P1[r] = -1e30f; } } } while (0)
  f32x16 pA0, pA1, pB0, pB1; float mnA, mnB, alA, alB; bf16x8 pa0, pa1, pa2, pa3; const int NT = 4 * qb + 4;
  constexpr int SE = 0, SO = 1;
  SLOAD(SE, 0); asm volatile("s_waitcnt vmcnt(0)" ::: "memory"); SWRITE(0, SE); __syncthreads();
  qkt(pA0, pA1, K_lds, qr, r32, hi); partialSM(pA0, pA1, m_reg, mnA, alA);
  SLOAD(SO, KVBLK); if (2 < NT) SLOAD(SE, 2 * KVBLK);
  SWAIT(); SWRITE(1, SO); __syncthreads();
  for (int j = 1; j + 1 < NT; j += 2) {
    SBAR(); qkt(pB0, pB1, K_lds + SHM_K, qr, r32, hi); MASKT(pB0, pB1, j);
    finishSM(pA0, pA1, alA, l_reg, pa0, pa1, pa2, pa3); SBAR();
    SLOAD(SO, (j + 2) * KVBLK); SBAR();
    pv_d0(o, vb0, pa0, pa1, pa2, pa3); partialSM(pB0, pB1, m_reg, mnB, alB);
    __syncthreads(); SWAIT(); SWRITE(0, SE);
    RESC(alB); __syncthreads();
    SBAR(); qkt(pA0, pA1, K_lds, qr, r32, hi); MASKT(pA0, pA1, j + 1);
    finishSM(pB0, pB1, alB, l_reg, pa0, pa1, pa2, pa3); SBAR();
    if (j + 3 < NT) SLOAD(SE, (j + 3) * KVBLK); SBAR();
    pv_d0(o, vb0 + SHM_V, pa0, pa1, pa2, pa3); partialSM(pA0, pA1, m_reg, mnA, alA);
    __syncthreads(); SWAIT(); SWRITE(1, SO);
    RESC(alA); __syncthreads();
  }
  SBAR(); qkt(pB0, pB1, K_lds + SHM_K, qr, r32, hi); MASKT(pB0, pB1, NT - 1);
  finishSM(pA0, pA1, alA, l_reg, pa0, pa1, pa2, pa3); SBAR();
  pv_d0(o, vb0, pa0, pa1, pa2, pa3); partialSM(pB0, pB1, m_reg, mnB, alB);
  __syncthreads(); RESC(alB);
  finishSM(pB0, pB1, alB, l_reg, pa0, pa1, pa2, pa3); SBAR();
  pv_d0(o, vb0 + SHM_V, pa0, pa1, pa2, pa3);
  if (hi == 0) li_l[r32] = l_reg; asm volatile("s_waitcnt lgkmcnt(0)" ::: "memory");
  float rli[16];
#pragma unroll
  for (int r = 0; r < 16; ++r) rli[r] = __builtin_amdgcn_rcpf(li_l[crow(r, hi)]);
  pg8::bf16_t* Ow = Oh + (size_t)(q0 + wid * QBLK) * LDO;
#pragma unroll
  for (int r = 0; r < 16; ++r) { const int orow = crow(r, hi);
#pragma unroll
    for (int d0 = 0; d0 < 2; ++d0) Ow[(size_t)orow * LDO + d0 * 32 + r32] = (pg8::bf16_t)(cvtpk(o[d0][r] * rli[r], 0.f) & 0xffffu); }
  __syncthreads();
#undef SLOAD
#undef SWRITE
#undef SWAIT
#undef RESC
#undef MASKT
}
#undef KSWZ
#undef SBAR
}

namespace dsa {
using bf16x8 = __attribute__((ext_vector_type(8))) short;
using s16x4  = __attribute__((ext_vector_type(4))) short;
using f32x4  = __attribute__((ext_vector_type(4))) float;
using u32x4  = __attribute__((ext_vector_type(4))) unsigned;
using u32x2  = __attribute__((ext_vector_type(2))) unsigned;
typedef unsigned short bf16_t;
constexpr int L_KI = 0, L_LIST = 16384, L_V = 32768, L_BIAS = 98304, L_END = 100352;
constexpr float LOG2E = 1.4426950408889634f;
constexpr unsigned INVALID_ENTRY = 0x003f0000u;
__device__ __forceinline__ void glds16v(const void* gsrc, unsigned lds_dst) { unsigned keep;
    asm volatile("s_waitcnt lgkmcnt(0)\n\ts_mov_b32 %0, m0\n\ts_mov_b32 m0, %2\n\ts_nop 0\n\tglobal_load_lds_dwordx4 %1, off\n\ts_mov_b32 m0, %0" : "=&s"(keep) : "v"(gsrc), "s"(lds_dst) : "memory"); }
__device__ __forceinline__ int t5_bucket(int rel) {
    const int n = rel < 0 ? -rel : rel; int b = n;
    if (n >= 8) { const int e = 31 - __builtin_clz(n); int v = 8 + 2 * (e - 3) + ((n * n) >= (2 << (2 * e)) ? 1 : 0); b = v > 15 ? 15 : v; }
    return b + (rel > 0 ? 16 : 0);
}
__device__ __forceinline__ s16x4 trrd(unsigned addr) { s16x4 r; asm volatile("ds_read_b64_tr_b16 %0, %1" : "=v"(r) : "v"(addr) : "memory"); return r; }
template <int OFF> __device__ __forceinline__ s16x4 trrdo(unsigned addr) { s16x4 r; asm volatile("ds_read_b64_tr_b16 %0, %1 offset:%2" : "=v"(r) : "v"(addr), "i"(OFF) : "memory"); return r; }
#define DSA_LAS __attribute__((address_space(3)))

__device__ __forceinline__ void dsa_pass(const bf16_t* __restrict__ Q, const bf16_t* __restrict__ QI, const bf16_t* __restrict__ K, const bf16_t* __restrict__ V, const bf16_t* __restrict__ KI,
                                         const float* __restrict__ WI, bf16_t* __restrict__ O, int b, int c, int pass, DSA_LAS unsigned char* lds) {
    int tid_ = threadIdx.x; asm volatile("" : "+v"(tid_));
    const int tid = tid_, wid = __builtin_amdgcn_readfirstlane(tid >> 6), lane = tid & 63, kl = lane & 15, g = lane >> 4, half = lane >> 5;
    const unsigned ldsb = (unsigned)(unsigned long long)lds;
    const size_t rb = (size_t)b * 4096;
    const int tw = 64 * c + 16 * pass + 2 * wid;
    DSA_LAS unsigned* list = (DSA_LAS unsigned*)(lds + L_LIST + wid * 2048);
    const DSA_LAS float* biasT = (const DSA_LAS float*)(lds + L_BIAS);
    const int nadm = 64 * (c + 1), ncnt = nadm < 256 ? nadm : 256;
    if (c >= 4) {
        float sc[128];
#pragma unroll
        for (int j = 0; j < 128; ++j) sc[j] = -3.0e38f;
        bf16x8 aq0, aq1; f32x4 w4;
        { const bf16_t* qp = QI + (rb + tw + (kl >> 3)) * 512 + (kl & 7) * 64 + 8 * g; aq0 = *(const bf16x8*)qp; aq1 = *(const bf16x8*)(qp + 32);
          w4 = *(const f32x4*)(WI + (rb + tw + (g >> 1)) * 8 + 4 * (g & 1)); }
        const int srow = 8 * wid + (lane >> 3), lch = (lane & 7) ^ ((srow >> 1) & 7);
        const bf16_t* kisrc = KI + (rb + srow) * 64 + lch * 8;
        const unsigned kidst = ldsb + L_KI + wid * 1024;
        const int rd0 = kl * 128 + ((g ^ ((kl >> 1) & 7)) << 4), rd1 = rd0 ^ 64;
        const int ntiles = c + 1;
        glds16v(kisrc, kidst); asm volatile("s_waitcnt vmcnt(0)" ::: "memory"); __syncthreads();
#pragma unroll
        for (int T = 0; T < 64; ++T) {
            if (T < ntiles) {
                if (T + 1 < ntiles) glds16v(kisrc + (size_t)(T + 1) * 4096, kidst + ((T + 1) & 1) * 8192);
                const DSA_LAS unsigned char* kb = lds + L_KI + (T & 1) * 8192;
                float ps[4];
#pragma unroll
                for (int st = 0; st < 4; ++st) { const bf16x8 b0 = *(const DSA_LAS bf16x8*)(kb + rd0 + st * 2048), b1 = *(const DSA_LAS bf16x8*)(kb + rd1 + st * 2048);
                    f32x4 a = __builtin_amdgcn_mfma_f32_16x16x32_bf16(aq0, b0, (f32x4){0.f, 0.f, 0.f, 0.f}, 0, 0, 0); a = __builtin_amdgcn_mfma_f32_16x16x32_bf16(aq1, b1, a, 0, 0, 0);
                    ps[st] = (w4[0] * fmaxf(a[0], 0.f) + w4[1] * fmaxf(a[1], 0.f)) + (w4[2] * fmaxf(a[2], 0.f) + w4[3] * fmaxf(a[3], 0.f)); }
                { auto r = __builtin_amdgcn_permlane16_swap(__float_as_uint(ps[0]), __float_as_uint(ps[1]), false, false); sc[2 * T] = __uint_as_float(r[0]) + __uint_as_float(r[1]); }
                { auto r = __builtin_amdgcn_permlane16_swap(__float_as_uint(ps[2]), __float_as_uint(ps[3]), false, false); sc[2 * T + 1] = __uint_as_float(r[0]) + __uint_as_float(r[1]); }
                asm volatile("s_waitcnt vmcnt(0) lgkmcnt(0)" ::: "memory"); __syncthreads();
            }
        }
        const int nregs = 2 * ntiles;
        float mn = 3.0e38f, mx = -3.0e38f;
#pragma unroll
        for (int blk = 0; blk < 8; ++blk) if (16 * blk < nregs) {
#pragma unroll
            for (int jj = 0; jj < 16; ++jj) { const float s = sc[16 * blk + jj]; mx = fmaxf(mx, s); mn = s > -1.0e38f ? fminf(mn, s) : mn; } }
#pragma unroll
        for (int o = 1; o < 32; o <<= 1) { mn = fminf(mn, __shfl_xor(mn, o)); mx = fmaxf(mx, __shfl_xor(mx, o)); }
        float lo[2], hi[2], thr[2], tie[2]; int chi[2], need[2]; bool done[2];
#pragma unroll
        for (int q = 0; q < 2; ++q) { lo[q] = __int_as_float(__builtin_amdgcn_readlane(__float_as_int(mn), 32 * q)) - 1.0f; hi[q] = __int_as_float(__builtin_amdgcn_readlane(__float_as_int(mx), 32 * q));
            chi[q] = 0; need[q] = 0; done[q] = false; thr[q] = hi[q]; tie[q] = __builtin_nanf(""); }
        for (int it = 0; it < 64; ++it) {
            if (done[0] && done[1]) break;
            float mid[2];
#pragma unroll
            for (int q = 0; q < 2; ++q) { mid[q] = 0.5f * lo[q] + 0.5f * hi[q];
                if (!done[q] && (!(mid[q] > lo[q]) || !(mid[q] < hi[q]))) { done[q] = true; thr[q] = hi[q]; tie[q] = hi[q]; need[q] = 256 - chi[q]; } }
            if (done[0] && done[1]) break;
            const float tv = half ? mid[1] : mid[0]; int c0 = 0, c1 = 0;
#pragma unroll
            for (int blk = 0; blk < 8; ++blk) if (16 * blk < nregs) {
#pragma unroll
                for (int jj = 0; jj < 16; ++jj) { const unsigned long long m = __builtin_amdgcn_ballot_w64(sc[16 * blk + jj] > tv); c0 += __builtin_popcount((unsigned)m); c1 += __builtin_popcount((unsigned)(m >> 32)); } }
#pragma unroll
            for (int q = 0; q < 2; ++q) { const int cq = q ? c1 : c0;
                if (!done[q]) { if (cq == 256) { done[q] = true; thr[q] = mid[q]; need[q] = 0; } else if (cq > 256) lo[q] = mid[q]; else { hi[q] = mid[q]; chi[q] = cq; } } }
        }
#pragma unroll
        for (int q = 0; q < 2; ++q) if (!done[q]) { thr[q] = hi[q]; tie[q] = hi[q]; need[q] = 256 - chi[q]; }
        { const float tv = half ? thr[1] : thr[0], ev = half ? tie[1] : tie[0]; const int nd = half ? need[1] : need[0]; int base = 0, tb = 0;
          DSA_LAS unsigned* lq = list + half * 256;
#pragma unroll
          for (int blk = 0; blk < 8; ++blk) if (16 * blk < nregs) {
#pragma unroll
              for (int jj = 0; jj < 16; ++jj) { const int j = 16 * blk + jj; const float s = sc[j];
                  const bool eq = (s == ev); const unsigned long long meq = __builtin_amdgcn_ballot_w64(eq);
                  const unsigned elo = (unsigned)meq, ehi = (unsigned)(meq >> 32);
                  int pe = __builtin_amdgcn_mbcnt_hi(ehi, __builtin_amdgcn_mbcnt_lo(elo, 0)); if (half) pe -= __builtin_popcount(elo);
                  const bool sel = (s > tv) || (eq && (tb + pe < nd));
                  const unsigned long long ms = __builtin_amdgcn_ballot_w64(sel); const unsigned slo = (unsigned)ms, shi = (unsigned)(ms >> 32);
                  int pp = __builtin_amdgcn_mbcnt_hi(shi, __builtin_amdgcn_mbcnt_lo(slo, 0)); if (half) pp -= __builtin_popcount(slo);
                  const int pos = base + pp;
                  if (sel && pos < 256) lq[pos] = (unsigned)(32 * j + (lane & 31));
                  base += half ? __builtin_popcount(shi) : __builtin_popcount(slo); tb += half ? __builtin_popcount(ehi) : __builtin_popcount(elo); } }
          for (int p = base + (lane & 31); p < 256; p += 32) lq[p] = INVALID_ENTRY; }
    } else {
        for (int p = lane; p < 2 * ncnt; p += 64) { const int q = p / ncnt; list[q * 256 + (p - q * ncnt)] = (unsigned)(p - q * ncnt); }
    }
    asm volatile("s_waitcnt lgkmcnt(0)" ::: "memory");
#pragma unroll
    for (int q = 0; q < 2; ++q)
#pragma unroll
        for (int i = 0; i < 4; ++i) { const int p = lane + 64 * i; if (p < ncnt) { const unsigned e = list[q * 256 + p]; if (e != INVALID_ENTRY) list[q * 256 + p] = e | ((unsigned)t5_bucket((int)e - (tw + q)) << 16); } }
    asm volatile("s_waitcnt lgkmcnt(0)" ::: "memory");
    const int n16 = ncnt >> 4;
    const unsigned vbuf = ldsb + L_V + wid * 8192;
    const int vrow = lane >> 3, vslot = lane & 7;
    const int trow = 4 * g + ((lane >> 2) & 3), tp = lane & 3, tx = (trow >> 1) & 3;
    unsigned trb[4];
#pragma unroll
    for (int db = 0; db < 4; ++db) trb[db] = vbuf + trow * 128 + ((db ^ tx) << 5) + tp * 8;
#pragma unroll 1
    for (int qq = 0; qq < 2; ++qq) {
        const int t = tw + qq; const DSA_LAS unsigned* lq = list + qq * 256;
        const bf16_t* qp = Q + (rb + t) * 1024 + kl * 64 + 8 * g; const bf16x8 qf0 = *(const bf16x8*)qp, qf1 = *(const bf16x8*)(qp + 32);
#define DSA_VGATHER(ch) do { _Pragma("unroll") for (int i_ = 0; i_ < 8; ++i_) { const int p_ = 8 * i_ + vrow; const unsigned e_ = lq[(ch) * 64 + p_]; \
            const int ls_ = (((vslot >> 1) ^ ((p_ >> 1) & 3)) << 1) | (vslot & 1); glds16v(V + (rb + (e_ & 0xffffu)) * 64 + ls_ * 8, vbuf + i_ * 1024); } } while (0)
        DSA_VGATHER(0);
        f32x4 st[16];
#pragma unroll
        for (int blk = 0; blk < 4; ++blk) {
            if (4 * blk < n16) {
#pragma unroll
                for (int tt = 0; tt < 4; ++tt) { const int T = 4 * blk + tt;
                    const unsigned e = lq[16 * T + kl]; const bf16_t* kp = K + (rb + (e & 0xffffu)) * 64 + 8 * g;
                    const bf16x8 ka0 = *(const bf16x8*)kp, ka1 = *(const bf16x8*)(kp + 32);
                    f32x4 a = __builtin_amdgcn_mfma_f32_16x16x32_bf16(ka0, qf0, (f32x4){0.f, 0.f, 0.f, 0.f}, 0, 0, 0); a = __builtin_amdgcn_mfma_f32_16x16x32_bf16(ka1, qf1, a, 0, 0, 0);
                    const u32x4 e4 = *(const DSA_LAS u32x4*)(lq + 16 * T + 4 * g);
#pragma unroll
                    for (int r = 0; r < 4; ++r) { const unsigned bk = e4[r] >> 16; a[r] = bk == 63u ? -1.0e30f : a[r] + biasT[(bk & 31u) * 16 + kl]; }
                    st[T] = a; }
            } else {
#pragma unroll
                for (int tt = 0; tt < 4; ++tt) st[4 * blk + tt] = (f32x4){-1.0e30f, -1.0e30f, -1.0e30f, -1.0e30f};
            }
        }
        float mxl = -1.0e30f;
#pragma unroll
        for (int T = 0; T < 16; ++T) mxl = fmaxf(fmaxf(mxl, fmaxf(st[T][0], st[T][1])), fmaxf(st[T][2], st[T][3]));
        mxl = fmaxf(mxl, __shfl_xor(mxl, 16)); mxl = fmaxf(mxl, __shfl_xor(mxl, 32));
        float sum = 0.f; unsigned pk[16][2];
#pragma unroll
        for (int T = 0; T < 16; ++T) { f32x4 p;
#pragma unroll
            for (int r = 0; r < 4; ++r) { p[r] = __builtin_amdgcn_exp2f(st[T][r] - mxl); }
            sum += (p[0] + p[1]) + (p[2] + p[3]); pk[T][0] = pg8::cvt_pk_bf16(p[0], p[1]); pk[T][1] = pg8::cvt_pk_bf16(p[2], p[3]); }
        sum += __shfl_xor(sum, 16); sum += __shfl_xor(sum, 32);
        f32x4 o[4];
#pragma unroll
        for (int db = 0; db < 4; ++db) o[db] = (f32x4){0.f, 0.f, 0.f, 0.f};
#pragma unroll
        for (int ch = 0; ch < 4; ++ch) {
            if (4 * ch < n16) {
                asm volatile("s_waitcnt vmcnt(0)" ::: "memory");
#pragma unroll
                for (int s2 = 0; s2 < 2; ++s2) { const int T0 = 4 * ch + 2 * s2;
                    const u32x4 pw = {pk[T0][0], pk[T0][1], pk[T0 + 1][0], pk[T0 + 1][1]}; const bf16x8 pb = __builtin_bit_cast(bf16x8, pw);
#pragma unroll
                    for (int db = 0; db < 4; ++db) { const s16x4 v1 = s2 == 0 ? trrdo<0>(trb[db]) : trrdo<4096>(trb[db]), v2 = s2 == 0 ? trrdo<2048>(trb[db]) : trrdo<6144>(trb[db]);
                        asm volatile("s_waitcnt lgkmcnt(0)" ::: "memory");
                        const bf16x8 va = {v1[0], v1[1], v1[2], v1[3], v2[0], v2[1], v2[2], v2[3]};
                        o[db] = __builtin_amdgcn_mfma_f32_16x16x32_bf16(va, pb, o[db], 0, 0, 0); } }
                if (4 * (ch + 1) < n16) DSA_VGATHER(ch + 1);
            }
        }
        const float rl = __builtin_amdgcn_rcpf(sum);
        bf16_t* op = O + (rb + t) * 1024 + kl * 64 + 4 * g;
#pragma unroll
        for (int db = 0; db < 4; ++db) { u32x2 w; w.x = pg8::cvt_pk_bf16(o[db][0] * rl, o[db][1] * rl); w.y = pg8::cvt_pk_bf16(o[db][2] * rl, o[db][3] * rl); *(u32x2*)(op + 16 * db) = w; }
#undef DSA_VGATHER
    }
}
#undef DSA_LAS
}
__device__ __forceinline__ void dsa_phase(Frame& F) {
    unsigned char* ws = wsp();
    const dsa::bf16_t* Q = (const dsa::bf16_t*)(ws + WS_AQ); const dsa::bf16_t* QI = (const dsa::bf16_t*)(ws + WS_AQI); const dsa::bf16_t* K = (const dsa::bf16_t*)(ws + WS_AK);
    const dsa::bf16_t* V = (const dsa::bf16_t*)(ws + WS_AV); const dsa::bf16_t* KI = (const dsa::bf16_t*)(ws + WS_AKI); const float* WI = (const float*)(ws + WS_AWI); dsa::bf16_t* O = (dsa::bf16_t*)(ws + WS_OB);
    { int t_ = threadIdx.x; asm volatile("" : "+v"(t_)); const float* rbias = inp(1); LAS float* bt = (LAS float*)(F.lds + dsa::L_BIAS); if (t_ < 512) bt[t_] = rbias[t_] * dsa::LOG2E; }
    __syncthreads();
    for (int pr = F.vcu; pr < NB * 32; pr += F.G) { const int b = pr >> 5, c0 = pr & 31;
        for (int k = 0; k < 2; ++k) { const int c = k == 0 ? c0 : 63 - c0;
            for (int pass = 0; pass < 4; ++pass) dsa::dsa_pass(Q, QI, K, V, KI, WI, O, b, c, pass, F.lds); } }
    __syncthreads();
}


__device__ __forceinline__ void mla_phase(Frame& F, int j) {
    unsigned char* ws = wsp();
    const pg8::bf16_t* QB = (const pg8::bf16_t*)(ws + WS_QB); const pg8::bf16_t* KB = (const pg8::bf16_t*)(ws + WS_KB); const pg8::bf16_t* VB = (const pg8::bf16_t*)(ws + WS_VB); pg8::bf16_t* OB = (pg8::bf16_t*)(ws + WS_OB);
    const float* qgain = inp(16) + j * 96; const float* cosT = (const float*)(ws + WS_ROPE); const float* sinT = cosT + SEQ * 16;
    for (int item = F.vcu; item < NB * 16 * 8; item += F.G) { const int bh = item >> 3, s = item & 7, b = bh >> 4, h = bh & 15; const size_t rb = (size_t)b * SEQ;
        for (int k = 0; k < 2; ++k) { const int qb = k == 0 ? s : 15 - s;
            mla::attn_unit(QB + rb * 1536 + h * 96, KB + rb * 1536 + h * 96, VB + rb * 1024 + h * 64, OB + rb * 1024 + h * 64, qgain, cosT, sinT, qb, (char*)F.lds); } }
}

#ifndef DSA_ENABLED
#define DSA_ENABLED 0
#endif
struct Args { const float* in[21]; float* out; unsigned char* ws; };
__global__ void __launch_bounds__(NWAVES * 64, 2) yoco_fwd(Args args) {
    extern __shared__ __attribute__((aligned(16))) unsigned char lds[];
    Frame F;
    F.lds = (LAS unsigned char*)lds;
    F.MISC = (volatile LAS unsigned*)(F.lds + MISC_OFF);
    F.tid = threadIdx.x; F.lane = F.tid & 63; F.wave = __builtin_amdgcn_readfirstlane(F.tid >> 6);
    F.G = gridDim.x; { const int bx = blockIdx.x; F.vcu = (F.G % 8 == 0) ? (bx % 8) * (F.G / 8) + bx / 8 : bx; }
    F.gw = F.vcu * NWAVES + F.wave;
    F.ctl = (gu32*)(wsp() + WS_CTL);
#define ws wsp()
    for (int u = F.tid; u < (LDS_BYTES - LDSCTL_OFF) / 4; u += NWAVES * 64) ((LAS unsigned*)(F.lds + LDSCTL_OFF))[u] = 0u;
    __syncthreads();
    (void)xcd_barrier_post((unsigned*)(wsp() + WS_CTL) + CW_BAR, F.MISC + 8);
#define GRID_BAR() do { XcdBarrier bar_; bar_.bar = (unsigned*)(wsp() + WS_CTL) + CW_BAR; bar_.x = xb_xcc_id(); bar_.st = F.MISC + 8; xcd_barrier(bar_); } while (0)
    typedef pg8::bf16_t hb_t;

    p0_prologue(F);
    GRID_BAR();

    for (int L = 0; L < 4; ++L) {
        bool mixed = false;
        if (L < 2) {
            { pg8::Gemm g{(const hb_t*)(ws + WS_HB), (const hb_t*)(ws + WS_WIN) + (size_t)L * WIN_ELEMS, M, NIN, D}; pg8::StaticOrder S; S.init(M, NIN, F.G, (int)blockIdx.x);
              pg8::EpiInproj E{L};
              pg8::gemm_phase<pg8::EpiInproj, pg8::StaticOrder, PG8_ALIGN, PG8_SP2>(F.lds + RING_OFF, g, S, E); }
            GRID_BAR();
            dsa_phase(F);
            GRID_BAR();
            mixed = true;
        }
        if (L >= 2) {
            const int j = L - 2;
            if (j == 0) { pg8::Gemm g{(const hb_t*)(ws + WS_HB), (const hb_t*)(ws + WS_WKVQ), M, NKVQ, D}; pg8::StaticOrder S; S.init(M, NKVQ, F.G, (int)blockIdx.x);
              pg8::EpiKvq<0> E{};
              pg8::gemm_phase<pg8::EpiKvq<0>, pg8::StaticOrder, PG8_ALIGN, PG8_SP2>(F.lds + RING_OFF, g, S, E); }
            else { pg8::Gemm g{(const hb_t*)(ws + WS_HB), (const hb_t*)(ws + WS_WDQ1), M, NDQ1, D}; pg8::StaticOrder S; S.init(M, NDQ1, F.G, (int)blockIdx.x);
              pg8::EpiKvq<1> E{};
              pg8::gemm_phase<pg8::EpiKvq<1>, pg8::StaticOrder, PG8_ALIGN, PG8_SP2>(F.lds + RING_OFF, g, S, E); }
            GRID_BAR();
            if (j == 0) {
                pg8::Gemm g{(const hb_t*)(ws + WS_CKV), (const hb_t*)(ws + WS_WUKV), M, NUKV, KVLORA}; pg8::StaticOrder S; S.init(M, NUKV, F.G, (int)blockIdx.x);
                pg8::EpiUkv E{};
                pg8::gemm_phase<pg8::EpiUkv, pg8::StaticOrder, PG8_ALIGN, PG8_SP2>(F.lds + RING_OFF, g, S, E); }
            { pg8::Gemm g{(const hb_t*)(ws + WS_QL), (const hb_t*)(ws + WS_WUQ) + (size_t)j * WUQ_ELEMS, M, NUQ, QLORA}; pg8::StaticOrder S; S.init(M, NUQ, F.G, (int)blockIdx.x);
              pg8::EpiUq E{};
              pg8::gemm_phase<pg8::EpiUq, pg8::StaticOrder, PG8_ALIGN, PG8_SP2>(F.lds + RING_OFF, g, S, E); }
            GRID_BAR();
            mla_phase(F, j);
            GRID_BAR();
            mixed = true;
        }
        if (mixed) {
            const hb_t* Wo = L < 2 ? (const hb_t*)(ws + WS_WOA) + (size_t)L * D * D : (const hb_t*)(ws + WS_WOB) + (size_t)(L - 2) * D * D;
            pg8::Gemm g{(const hb_t*)(ws + WS_OB), Wo, M, D, D}; pg8::StaticOrder S; S.init(M, D, F.G, (int)blockIdx.x);
            pg8::EpiResid E{L == 0 ? 1 : 0, 0};
            pg8::gemm_phase<pg8::EpiResid, pg8::StaticOrder, PG8_ALIGN, PG8_SP2>(F.lds + RING_OFF, g, S, E);
            GRID_BAR();
        }
        for (int hf = 0; hf < 2; ++hf) {
            const size_t r0 = (size_t)hf * MH;
            { pg8::Gemm g{(const hb_t*)(ws + WS_HB) + r0 * D, (const hb_t*)(ws + WS_WUP) + (size_t)L * D * FF, MH, FF, D}; pg8::StaticOrder S; S.init(MH, FF, F.G, (int)blockIdx.x);
              pg8::EpiUp E{(int)r0};
              pg8::gemm_phase<pg8::EpiUp, pg8::StaticOrder, PG8_ALIGN, PG8_SP2>(F.lds + RING_OFF, g, S, E); }
            GRID_BAR();
            { pg8::Gemm g{(const hb_t*)(ws + WS_HID), (const hb_t*)(ws + WS_WDN) + (size_t)L * D * FF, MH, D, FF}; pg8::StaticOrder S; S.init(MH, D, F.G, (int)blockIdx.x);
              pg8::EpiResid E{(L == 0 && !mixed) ? 1 : 0, (int)r0};
              pg8::gemm_phase<pg8::EpiResid, pg8::StaticOrder, PG8_ALIGN, PG8_SP2>(F.lds + RING_OFF, g, S, E); }
            GRID_BAR();
        }
    }
#undef ws
}
extern "C" void kernel_launch(void* const* d_in, const int* in_sizes, int n_in, void* d_out, int out_size, void* d_ws, size_t ws_size, hipStream_t stream) {
    static int grid = 0;
    if (grid == 0) {
        if (n_in != 21 || in_sizes[0] != M * D || out_size != M * D || ws_size < WS_END) { fprintf(stderr, "kernel_launch: unexpected shapes: n_in %d in0 %d out %d ws %zu\n", n_in, n_in > 0 ? in_sizes[0] : -1, out_size, ws_size); grid = -1; return; }
        int dev = 0, cus = 0, per_cu = 0;
        if (hipGetDevice(&dev) != hipSuccess || hipDeviceGetAttribute(&cus, hipDeviceAttributeMultiprocessorCount, dev) != hipSuccess) { grid = -1; return; }
        if (hipFuncSetAttribute((const void*)yoco_fwd, hipFuncAttributeMaxDynamicSharedMemorySize, LDS_BYTES) != hipSuccess) { fprintf(stderr, "kernel_launch: hipFuncSetAttribute failed\n"); grid = -1; return; }
        if (hipOccupancyMaxActiveBlocksPerMultiprocessor(&per_cu, (const void*)yoco_fwd, NWAVES * 64, LDS_BYTES) != hipSuccess || per_cu < 1) { fprintf(stderr, "kernel_launch: occupancy query reports %d\n", per_cu); }
        (void)hipGetLastError();
        grid = cus;
    }
    if (grid < 0) return;
    if (hipMemsetAsync((char*)d_ws + WS_CTL, 0, CTL_ZERO_BYTES, stream) != hipSuccess) return;
    Args a{};
    for (int i = 0; i < 21; ++i) a.in[i] = (const float*)d_in[i];
    a.out = (float*)d_out; a.ws = (unsigned char*)d_ws;
    hipLaunchKernelGGL(yoco_fwd, dim3(grid), dim3(NWAVES * 64), LDS_BYTES, stream, a);
}
```

```cpp
#include <hip/hip_runtime.h>
#include <cstdio>
#include <cstdint>

#ifndef PG8_SP2
#define PG8_SP2 true
#endif
#ifndef PG8_ALIGN
#define PG8_ALIGN true
#endif
constexpr int NWAVES = 8;
constexpr int NB = 8, SEQ = 4096, M = NB * SEQ, D = 1024, FF = 4096, MH = M / 2;
constexpr int A_IN = 1736, NIN = 1792;
constexpr int NKVQ = 768, NUKV = 2048, NDQ1 = 512, NUQ = 1536, QLORA = 384, KVLORA = 256;
constexpr size_t MiB = 1u << 20;
constexpr size_t WS_CTL = 0, CTL_ZERO_BYTES = 64 * 1024;
constexpr size_t WS_WIN = 1 * MiB, WS_WOA = 8 * MiB, WS_WKVQ = 12 * MiB, WS_WUKV = 14 * MiB, WS_WDQ1 = 15 * MiB, WS_WUQ = 16 * MiB, WS_WOB = 19 * MiB, WS_WUP = 23 * MiB, WS_WDN = 55 * MiB;
constexpr size_t WS_SSQH = 87 * MiB, WS_SSQCKV = 89 * MiB, WS_SSQQL = 89 * MiB + 512 * 1024, WS_SSQKR = 90 * MiB + 512 * 1024, WS_KROPE = 91 * MiB, WS_ROPE = 95 * MiB;
constexpr size_t WS_HB = 96 * MiB, WS_KB = 160 * MiB, WS_VB = 256 * MiB, WS_X = 320 * MiB;
constexpr size_t WS_HID = WS_X, WS_QB = WS_X, WS_OB = 416 * MiB, WS_QL = 416 * MiB, WS_CKV = 448 * MiB, WS_SSQB = 480 * MiB, WS_END = 482 * MiB;
constexpr size_t WS_AQ = WS_X, WS_AQI = 384 * MiB, WS_AK = 160 * MiB, WS_AV = 164 * MiB, WS_AKI = 168 * MiB, WS_AWI = 172 * MiB;
constexpr size_t WIN_ELEMS = (size_t)NIN * D, WUQ_ELEMS = (size_t)NUQ * QLORA;
constexpr int CW_TMO = 0, CW_CODE = 1, CW_BAR = 4096;
constexpr int RING_OFF = 0, RING_BYTES = 131072;
constexpr int LDSCTL_OFF = 151552, MISC_OFF = LDSCTL_OFF + 320;
constexpr int LDS_BYTES = 155648;
#define GAS __attribute__((address_space(1)))
#define LAS __attribute__((address_space(3)))
typedef unsigned short bf16;
typedef unsigned v4u __attribute__((ext_vector_type(4)));
typedef float f32x4 __attribute__((ext_vector_type(4)));
typedef short bf16x8 __attribute__((ext_vector_type(8)));
typedef GAS unsigned gu32;
typedef GAS unsigned long long gu64;
#define RLX_AGENT __ATOMIC_RELAXED, __HIP_MEMORY_SCOPE_AGENT
#define LDS_WAIT() asm volatile("s_waitcnt lgkmcnt(0)" ::: "memory")
#define VM_WAIT() asm volatile("s_waitcnt vmcnt(0)" ::: "memory")

typedef const float* cfp_t;
__device__ __forceinline__ cfp_t inp(int i) { return ((volatile cfp_t __attribute__((address_space(4)))*)__builtin_amdgcn_kernarg_segment_ptr())[i]; }
__device__ __forceinline__ float* outp() { return (float*)((volatile cfp_t __attribute__((address_space(4)))*)__builtin_amdgcn_kernarg_segment_ptr())[21]; }
__device__ __forceinline__ unsigned char* wsp() { return (unsigned char*)((volatile cfp_t __attribute__((address_space(4)))*)__builtin_amdgcn_kernarg_segment_ptr())[22]; }
namespace pg8 {
#define PG8_LAS __attribute__((address_space(3)))
typedef unsigned short bf16_t;
typedef short bf16x8 __attribute__((ext_vector_type(8)));
typedef float f32x4 __attribute__((ext_vector_type(4)));
typedef unsigned u32x4 __attribute__((ext_vector_type(4)));
constexpr int BM = 256, BK = 64, HALF = 128, HTB = HALF * BK * 2  , STAGE_BYTES = 8 * HTB, NXCD = 8, WGM = 8;

__host__ __device__ __forceinline__ int lds_byte(int r, int c) { const int st = (r >> 4) * 2 + (c >> 5), rr = r & 15, cc = c & 31, ob = rr * 64 + cc * 2; return st * 1024 + (ob ^ (((ob >> 9) & 1) << 5)); }
__host__ __device__ __forceinline__ void stage_rc(int b, int& R, int& C) { const int st = b / 1024, sb = b % 1024, swz = sb ^ (((sb >> 9) & 1) << 5); R = (st >> 1) * 16 + swz / 64; C = (st & 1) * 32 + (swz % 64) / 2; }
__host__ __device__ __forceinline__ int perm32(int rho) { const int n = rho >> 4, i = rho & 15; return 8 * (i >> 2) + 4 * n + (i & 3); }

struct Unit { int pm, pn; };
struct Gemm { const bf16_t* A; const bf16_t* Bt; int M, N, K; };

struct StaticOrder {
    int nM, nN, nwg, G, c;
    __host__ __device__ void init(int M, int N, int G_, int c_) { nM = M / BM; nN = N / BM; nwg = nM * nN; G = G_; c = c_; }
    __host__ __device__ bool next(int i, Unit& u) const {
        const long L = (long)i * G + c; if (L >= nwg) return false;
        int wgid = (int)L; { const int q = nwg / NXCD, r = nwg % NXCD, xcd = wgid % NXCD, off = wgid / NXCD; wgid = (xcd < r ? xcd * (q + 1) : r * (q + 1) + (xcd - r) * q) + off; }
        const int nig = WGM * nN, gid = wgid / nig, fm = gid * WGM, gsz = (nM - fm) < WGM ? (nM - fm) : WGM;
        u.pm = fm + ((wgid % nig) % gsz); u.pn = (wgid % nig) / gsz; return true;
    }
    __device__ __forceinline__ void a_ready(const Unit&) const {}
    __device__ __forceinline__ void done(const Unit&) const {}
};


typedef float f32x2 __attribute__((ext_vector_type(2)));
typedef __bf16 bf16x2_t __attribute__((ext_vector_type(2)));
__device__ __forceinline__ unsigned cvt_pk_bf16(float lo, float hi) { f32x2 v = {lo, hi}; bf16x2_t b = __builtin_convertvector(v, bf16x2_t); return __builtin_bit_cast(unsigned, b); }
__device__ __forceinline__ u32x4 pack8(f32x4 a, f32x4 b) { u32x4 w; w.x = cvt_pk_bf16(a[0], a[1]); w.y = cvt_pk_bf16(a[2], a[3]); w.z = cvt_pk_bf16(b[0], b[1]); w.w = cvt_pk_bf16(b[2], b[3]); return w; }
__device__ __forceinline__ float sum4sq(f32x4 a) { return (a[0] * a[0] + a[1] * a[1]) + (a[2] * a[2] + a[3] * a[3]); }
__device__ __forceinline__ float red_fq(float s) { const unsigned u = __float_as_uint(s); auto a = __builtin_amdgcn_permlane16_swap(u, u, false, false); const float t = __uint_as_float(a[0]) + __uint_as_float(a[1]);
    const unsigned w = __float_as_uint(t); auto b = __builtin_amdgcn_permlane32_swap(w, w, false, false); return __uint_as_float(b[0]) + __uint_as_float(b[1]); }
constexpr float RMS_EPS = 1e-6f;
__device__ __forceinline__ float rstd16(const float* ssq, int row, int fq, float inv_n) { const f32x4 v = *(const f32x4*)(ssq + (size_t)row * 16 + 4 * fq); return __builtin_amdgcn_rsqf(red_fq((v[0] + v[1]) + (v[2] + v[3])) * inv_n + RMS_EPS); }
__device__ __forceinline__ float rstd4(const float* ssq, int row, int fq, float inv_n) { return __builtin_amdgcn_rsqf(red_fq(ssq[(size_t)row * 4 + fq]) * inv_n + RMS_EPS); }
__device__ __forceinline__ float rstd6(const float* ssq, int row, int fq, float inv_n) { const f32x2 v = *(const f32x2*)(ssq + (size_t)row * 8 + 2 * fq); return __builtin_amdgcn_rsqf(red_fq(fq < 3 ? v[0] + v[1] : 0.f) * inv_n + RMS_EPS); }

__device__ __forceinline__ void rstd16x8(const float* ssq, int rowb, int fq, float inv_n, float (&rs)[2][4]) { f32x4 v[2][4];
#pragma unroll
    for (int ai = 0; ai < 2; ++ai)
#pragma unroll
        for (int m = 0; m < 4; ++m) v[ai][m] = *(const f32x4*)(ssq + (size_t)(rowb + ai * HALF + m * 16) * 16 + 4 * fq);
    asm volatile("" : "+v"(v[0][0]), "+v"(v[0][1]), "+v"(v[0][2]), "+v"(v[0][3]), "+v"(v[1][0]), "+v"(v[1][1]), "+v"(v[1][2]), "+v"(v[1][3]));
#pragma unroll
    for (int ai = 0; ai < 2; ++ai)
#pragma unroll
        for (int m = 0; m < 4; ++m) rs[ai][m] = __builtin_amdgcn_rsqf(red_fq((v[ai][m][0] + v[ai][m][1]) + (v[ai][m][2] + v[ai][m][3])) * inv_n + RMS_EPS); }
__device__ __forceinline__ void rstd6x8(const float* ssq, int rowb, int fq, float inv_n, float (&rs)[2][4]) { f32x2 v[2][4];
#pragma unroll
    for (int ai = 0; ai < 2; ++ai)
#pragma unroll
        for (int m = 0; m < 4; ++m) v[ai][m] = *(const f32x2*)(ssq + (size_t)(rowb + ai * HALF + m * 16) * 8 + 2 * fq);
    asm volatile("" : "+v"(v[0][0]), "+v"(v[0][1]), "+v"(v[0][2]), "+v"(v[0][3]), "+v"(v[1][0]), "+v"(v[1][1]), "+v"(v[1][2]), "+v"(v[1][3]));
#pragma unroll
    for (int ai = 0; ai < 2; ++ai)
#pragma unroll
        for (int m = 0; m < 4; ++m) rs[ai][m] = __builtin_amdgcn_rsqf(red_fq(fq < 3 ? v[ai][m][0] + v[ai][m][1] : 0.f) * inv_n + RMS_EPS); }
template <int SB_, int SCALE_> struct EpiResidT {
    static constexpr bool PERM = true, AFTER_DRAIN = false; static constexpr int sb = SB_, scale = SCALE_;
    int mode, r0;
    __device__ __forceinline__ void operator()(const f32x4 (&acc)[2][2][4][2], const Unit& u, int wr, int wc, int fr, int fq) const {
        { int t_ = threadIdx.x; asm volatile("" : "+v"(t_)); fr = t_ & 15; fq = (t_ >> 4) & 3; }
        const int col = u.pn * BM + wc * 64 + fq * 8;
        const float* xin = inp(0) + (size_t)r0 * 1024; float* out = outp() + (size_t)r0 * 1024; bf16_t* hb = (bf16_t*)(wsp() + WS_HB) + (size_t)r0 * 1024; float* ssq = (float*)(wsp() + (sb ? WS_SSQB : WS_SSQH)) + (size_t)r0 * 16;
#pragma unroll
        for (int ai = 0; ai < 2; ++ai) {
            float rs2[4] = {1.f, 1.f, 1.f, 1.f}; u32x4 rb[4][2];
            if (scale) { const float* sq = (const float*)(wsp() + WS_SSQB) + (size_t)r0 * 16; f32x4 sv[4];
#pragma unroll
                for (int m = 0; m < 4; ++m) sv[m] = *(const f32x4*)(sq + (size_t)(u.pm * BM + ai * HALF + wr * 64 + m * 16 + fr) * 16 + 4 * fq);
#pragma unroll
                for (int m = 0; m < 4; ++m) { const size_t off = (size_t)(u.pm * BM + ai * HALF + wr * 64 + m * 16 + fr) * 1024 + col;
#pragma unroll
                    for (int bj = 0; bj < 2; ++bj) rb[m][bj] = *(const u32x4*)(hb + off + bj * 32); }
                asm volatile("" : "+v"(sv[0]), "+v"(sv[1]), "+v"(sv[2]), "+v"(sv[3]), "+v"(rb[0][0]), "+v"(rb[0][1]), "+v"(rb[1][0]), "+v"(rb[1][1]), "+v"(rb[2][0]), "+v"(rb[2][1]), "+v"(rb[3][0]), "+v"(rb[3][1]));
#pragma unroll
                for (int m = 0; m < 4; ++m) { const float r_ = __builtin_amdgcn_rsqf(red_fq((sv[m][0] + sv[m][1]) + (sv[m][2] + sv[m][3])) * (1.f / 1024.f) + RMS_EPS); rs2[m] = r_ * r_ * 2.81474976710656e14f; } }
            else {
#pragma unroll
                for (int m = 0; m < 4; ++m) { const size_t off = (size_t)(u.pm * BM + ai * HALF + wr * 64 + m * 16 + fr) * 1024 + col;
#pragma unroll
                    for (int bj = 0; bj < 2; ++bj) rb[m][bj] = *(const u32x4*)(hb + off + bj * 32); }
                asm volatile("" : "+v"(rb[0][0]), "+v"(rb[0][1]), "+v"(rb[1][0]), "+v"(rb[1][1]), "+v"(rb[2][0]), "+v"(rb[2][1]), "+v"(rb[3][0]), "+v"(rb[3][1])); }
#pragma unroll
            for (int m = 0; m < 4; ++m) { const int row = u.pm * BM + ai * HALF + wr * 64 + m * 16 + fr; const size_t off = (size_t)row * 1024 + col; float s = 0.f;
#pragma unroll
                for (int bj = 0; bj < 2; ++bj) { const float sc_ = rs2[m]; const u32x4 w = rb[m][bj];
                    const f32x4 r0v = {__uint_as_float(w.x << 16), __uint_as_float(w.x & 0xffff0000u), __uint_as_float(w.y << 16), __uint_as_float(w.y & 0xffff0000u)};
                    const f32x4 r1v = {__uint_as_float(w.z << 16), __uint_as_float(w.z & 0xffff0000u), __uint_as_float(w.w << 16), __uint_as_float(w.w & 0xffff0000u)};
                    const f32x4 a = r0v + acc[ai][bj][m][0] * sc_, b = r1v + acc[ai][bj][m][1] * sc_;
                    if (mode == 2) { *(f32x4*)(out + off + bj * 32) = a; *(f32x4*)(out + off + bj * 32 + 4) = b; }
                    else { *(u32x4*)(hb + off + bj * 32) = pack8(a, b); s += sum4sq(a) + sum4sq(b); } }
                if (mode != 2) { s = red_fq(s); if (fq == 0) ssq[(size_t)row * 16 + u.pn * 4 + wc] = s; } }
        }
    }
};
using EpiResid = EpiResidT<0, 0>;
struct EpiUp {
    static constexpr bool PERM = true, AFTER_DRAIN = false;
    int r0, hid_mib;
    __device__ __forceinline__ void operator()(const f32x4 (&acc)[2][2][4][2], const Unit& u, int wr, int wc, int fr, int fq) const {
        { int t_ = threadIdx.x; asm volatile("" : "+v"(t_)); fr = t_ & 15; fq = (t_ >> 4) & 3; }
        const int col = u.pn * BM + wc * 64 + fq * 8;
        bf16_t* hid = (bf16_t*)(wsp() + (size_t)hid_mib * 1048576);
#pragma unroll
        for (int ai = 0; ai < 2; ++ai)
#pragma unroll
            for (int m = 0; m < 4; ++m) { const int row = u.pm * BM + ai * HALF + wr * 64 + m * 16 + fr;
#pragma unroll
                for (int bj = 0; bj < 2; ++bj) { f32x4 a, b; const f32x2 k2 = {5.9604644775390625e-08f, 5.9604644775390625e-08f};
#pragma unroll
                    for (int hh = 0; hh < 2; ++hh) { const f32x4 s = acc[ai][bj][m][hh]; f32x2 lo = {s[0], s[1]}, hi = {s[2], s[3]};
                        asm("v_pk_mul_f32 %0, %1, %2 clamp" : "=v"(lo) : "v"(lo), "v"(k2)); asm("v_pk_mul_f32 %0, %1, %2 clamp" : "=v"(hi) : "v"(hi), "v"(k2));
                        lo = lo * lo; hi = hi * hi; const f32x4 q = {lo[0], lo[1], hi[0], hi[1]}; if (hh == 0) a = q; else b = q; }
                    *(u32x4*)(hid + (size_t)row * 4096 + col + bj * 32) = pack8(a, b); } }
    }
};
__device__ __forceinline__ void pg8_glds16(const char* sbase, unsigned voff, unsigned lds_dst) { unsigned keep;
    asm volatile("s_mov_b32 %0, m0\n\ts_mov_b32 m0, %3\n\ts_nop 0\n\tglobal_load_lds_dwordx4 %2, %1\n\ts_mov_b32 m0, %0" : "=&s"(keep) : "s"(sbase), "v"(voff), "s"(lds_dst) : "memory"); }

template <int pn_off> struct EpiKvq {
    static constexpr bool PERM = true, AFTER_DRAIN = false;
    __device__ __forceinline__ void operator()(const f32x4 (&acc)[2][2][4][2], const Unit& u, int wr, int wc, int fr, int fq) const {
        { int t_ = threadIdx.x; asm volatile("" : "+v"(t_)); fr = t_ & 15; fq = (t_ >> 4) & 3; }
        const int vpn = u.pn + pn_off; unsigned char* ws = wsp();
        const float* ssqh = (const float*)(ws + WS_SSQH); bf16_t* ckv = (bf16_t*)(ws + WS_CKV); bf16_t* ql = (bf16_t*)(ws + WS_QL); float* krope = (float*)(ws + WS_KROPE); float* ssq_ckv = (float*)(ws + WS_SSQCKV); float* ssq_ql = (float*)(ws + WS_SSQQL); float* ssq_kr = (float*)(ws + WS_SSQKR);
        float rsv[2][4];
        rstd16x8(ssqh, u.pm * BM + wr * 64 + fr, fq, 1.f / 1024.f, rsv);
#pragma unroll
        for (int ai = 0; ai < 2; ++ai)
#pragma unroll
            for (int m = 0; m < 4; ++m) { const int row = u.pm * BM + ai * HALF + wr * 64 + m * 16 + fr; const float rs = rsv[ai][m];
                const f32x4 a0 = acc[ai][0][m][0] * rs, b0 = acc[ai][0][m][1] * rs, a1 = acc[ai][1][m][0] * rs, b1 = acc[ai][1][m][1] * rs;
                if (vpn == 0) { bf16_t* p = ckv + (size_t)row * 256 + wc * 64 + fq * 8; *(u32x4*)p = pack8(a0, b0); *(u32x4*)(p + 32) = pack8(a1, b1);
                    const float s = red_fq((sum4sq(a0) + sum4sq(b0)) + (sum4sq(a1) + sum4sq(b1))); if (fq == 0) ssq_ckv[(size_t)row * 4 + wc] = s; }
                else if (vpn == 1 || wc < 2) { bf16_t* p = ql + (size_t)row * 384 + (vpn - 1) * 256 + wc * 64 + fq * 8; *(u32x4*)p = pack8(a0, b0); *(u32x4*)(p + 32) = pack8(a1, b1);
                    const float s = red_fq((sum4sq(a0) + sum4sq(b0)) + (sum4sq(a1) + sum4sq(b1))); if (fq == 0) ssq_ql[(size_t)row * 8 + (vpn - 1) * 4 + wc] = s; }
                else if (wc == 2 && pn_off == 0) { float* p = krope + (size_t)row * 32 + fq * 8; *(f32x4*)p = a0; *(f32x4*)(p + 4) = b0;
                    const float s = red_fq(sum4sq(a0) + sum4sq(b0)); if (fq == 0) ssq_kr[row] = s; } }
    }
};
struct EpiUkv {
    static constexpr bool PERM = true, AFTER_DRAIN = false;
    __device__ __forceinline__ void operator()(const f32x4 (&acc)[2][2][4][2], const Unit& u, int wr, int wc, int fr, int fq) const {
        { int t_ = threadIdx.x; asm volatile("" : "+v"(t_)); fr = t_ & 15; fq = (t_ >> 4) & 3; }
        const int G = u.pn * 4 + wc, head = G >> 1; const bool isv = (G & 1) != 0; unsigned char* ws = wsp();
        const float* ssq_ckv = (const float*)(ws + WS_SSQCKV); const float* ssq_kr = (const float*)(ws + WS_SSQKR); const float* krope = (const float*)(ws + WS_KROPE); const float* kgain = inp(11); const float* cosT = (const float*)(ws + WS_ROPE); const float* sinT = cosT + SEQ * 16; bf16_t* kb = (bf16_t*)(ws + WS_KB); bf16_t* vb = (bf16_t*)(ws + WS_VB);
        f32x4 g0a, g0b, g1a, g1b, gr1, gr2;
        if (!isv) { g0a = *(const f32x4*)(kgain + fq * 8); g0b = *(const f32x4*)(kgain + fq * 8 + 4); g1a = *(const f32x4*)(kgain + 32 + fq * 8); g1b = *(const f32x4*)(kgain + 36 + fq * 8);
            gr1 = *(const f32x4*)(kgain + 64 + 4 * fq); gr2 = *(const f32x4*)(kgain + 80 + 4 * fq); }
        const int rowb = u.pm * BM + wr * 64 + fr;
        float rsv[2][4], skr[2][4];
        { float v[2][4];
#pragma unroll
          for (int ai = 0; ai < 2; ++ai)
#pragma unroll
              for (int m = 0; m < 4; ++m) { v[ai][m] = ssq_ckv[(size_t)(rowb + ai * HALF + m * 16) * 4 + fq]; skr[ai][m] = isv ? 0.f : ssq_kr[rowb + ai * HALF + m * 16]; }
          asm volatile("" : "+v"(v[0][0]), "+v"(v[0][1]), "+v"(v[0][2]), "+v"(v[0][3]), "+v"(v[1][0]), "+v"(v[1][1]), "+v"(v[1][2]), "+v"(v[1][3]),
                            "+v"(skr[0][0]), "+v"(skr[0][1]), "+v"(skr[0][2]), "+v"(skr[0][3]), "+v"(skr[1][0]), "+v"(skr[1][1]), "+v"(skr[1][2]), "+v"(skr[1][3]));
#pragma unroll
          for (int ai = 0; ai < 2; ++ai)
#pragma unroll
              for (int m = 0; m < 4; ++m) rsv[ai][m] = __builtin_amdgcn_rsqf(red_fq(v[ai][m]) * (1.f / 256.f) + RMS_EPS); }
#pragma unroll
        for (int ai = 0; ai < 2; ++ai)
#pragma unroll
            for (int m = 0; m < 4; ++m) { const int row = rowb + ai * HALF + m * 16; const float rs = rsv[ai][m];
                f32x4 kx1, kx2, cc, ss;
                if (!isv) { const int pos = row & 4095;
                    kx1 = *(const f32x4*)(krope + (size_t)row * 32 + 4 * fq); kx2 = *(const f32x4*)(krope + (size_t)row * 32 + 16 + 4 * fq);
                    cc = *(const f32x4*)(cosT + pos * 16 + 4 * fq); ss = *(const f32x4*)(sinT + pos * 16 + 4 * fq);
                    asm volatile("" : "+v"(kx1), "+v"(kx2), "+v"(cc), "+v"(ss)); }
                const f32x4 a0 = acc[ai][0][m][0] * rs, b0 = acc[ai][0][m][1] * rs, a1 = acc[ai][1][m][0] * rs, b1 = acc[ai][1][m][1] * rs;
                if (isv) { bf16_t* p = vb + ((((size_t)(row >> 12) * 16 + head) << 12) + (row & 4095)) * 64 + fq * 8; *(u32x4*)p = pack8(a0, b0); *(u32x4*)(p + 32) = pack8(a1, b1); }
                else { const float s = red_fq((sum4sq(a0) + sum4sq(b0)) + (sum4sq(a1) + sum4sq(b1))) + skr[ai][m]; const float rk = __builtin_amdgcn_rsqf(s * (1.f / 96.f) + RMS_EPS);
                    bf16_t* p = kb + ((((size_t)(row >> 12) * 16 + head) << 12) + (row & 4095)) * 96; *(u32x4*)(p + fq * 8) = pack8(a0 * g0a * rk, b0 * g0b * rk); *(u32x4*)(p + 32 + fq * 8) = pack8(a1 * g1a * rk, b1 * g1b * rk);
                    const f32x4 x1 = kx1 * gr1 * rk, x2 = kx2 * gr2 * rk;
                    const f32x4 o1 = x1 * cc - x2 * ss, o2 = x2 * cc + x1 * ss;
                    typedef unsigned u32x2v __attribute__((ext_vector_type(2)));
                    u32x2v w1, w2; w1.x = cvt_pk_bf16(o1[0], o1[1]); w1.y = cvt_pk_bf16(o1[2], o1[3]); w2.x = cvt_pk_bf16(o2[0], o2[1]); w2.y = cvt_pk_bf16(o2[2], o2[3]);
                    *(u32x2v*)(p + 64 + 4 * fq) = w1; *(u32x2v*)(p + 80 + 4 * fq) = w2; } }
    }
};
struct EpiUq {
    static constexpr bool PERM = true, AFTER_DRAIN = false;
    __device__ __forceinline__ void operator()(const f32x4 (&acc)[2][2][4][2], const Unit& u, int wr, int wc, int fr, int fq) const {
        { int t_ = threadIdx.x; asm volatile("" : "+v"(t_)); fr = t_ & 15; fq = (t_ >> 4) & 3; }
        const int col = u.pn * BM + wc * 64 + fq * 8; const float* ssq_ql = (const float*)(wsp() + WS_SSQQL); bf16_t* qb = (bf16_t*)(wsp() + WS_QB);
        float rsv[2][4];
        rstd6x8(ssq_ql, u.pm * BM + wr * 64 + fr, fq, 1.f / 384.f, rsv);
#pragma unroll
        for (int ai = 0; ai < 2; ++ai)
#pragma unroll
            for (int m = 0; m < 4; ++m) { const int row = u.pm * BM + ai * HALF + wr * 64 + m * 16 + fr; const float rs = rsv[ai][m];
                bf16_t* p = qb + (size_t)row * 1536 + col; *(u32x4*)p = pack8(acc[ai][0][m][0] * rs, acc[ai][0][m][1] * rs); *(u32x4*)(p + 32) = pack8(acc[ai][1][m][0] * rs, acc[ai][1][m][1] * rs); }
    }
};

struct EpiInproj {
    static constexpr bool PERM = true, AFTER_DRAIN = false;
    int layer;
    __device__ __forceinline__ void operator()(const f32x4 (&acc)[2][2][4][2], const Unit& u, int wr, int wc, int fr, int fq) const {
        { int t_ = threadIdx.x; asm volatile("" : "+v"(t_)); fr = t_ & 15; fq = (t_ >> 4) & 3; }
        unsigned char* ws = wsp(); const float* ssqh = (const float*)(ws + WS_SSQH);
        const bool isq = u.pn < 4, isk = (u.pn == 4 && wc == 0), normed = isq || isk;
        f32x4 g0a = {1.f, 1.f, 1.f, 1.f}, g0b = g0a, g1a = g0a, g1b = g0a;
        if (normed) { const float* gp = (isq ? inp(4) : inp(5)) + layer * 64 + fq * 8; const float sc = isq ? 0.125f * 1.4426950408889634f : 1.f;
            g0a = *(const f32x4*)gp * sc; g0b = *(const f32x4*)(gp + 4) * sc; g1a = *(const f32x4*)(gp + 32) * sc; g1b = *(const f32x4*)(gp + 36) * sc; }
        bf16_t* dst; int ld;
        if (isq) { dst = (bf16_t*)(ws + WS_AQ) + (u.pn * 4 + wc) * 64; ld = 1024; }
        else if (u.pn == 4) { dst = (bf16_t*)(ws + (wc == 0 ? WS_AK : wc == 1 ? WS_AV : WS_AKI)); ld = 64; }
        else { dst = (bf16_t*)(ws + WS_AQI) + ((u.pn - 5) * 4 + wc) * 64; ld = 512; }
        const bool iswi = (u.pn == 4 && wc == 3);
        float rsv[2][4];
        rstd16x8(ssqh, u.pm * BM + wr * 64 + fr, fq, 1.f / 1024.f, rsv);
#pragma unroll
        for (int ai = 0; ai < 2; ++ai)
#pragma unroll
            for (int m = 0; m < 4; ++m) { const int row = u.pm * BM + ai * HALF + wr * 64 + m * 16 + fr; const float rs = rsv[ai][m];
                f32x4 a0 = acc[ai][0][m][0] * rs, b0 = acc[ai][0][m][1] * rs, a1 = acc[ai][1][m][0] * rs, b1 = acc[ai][1][m][1] * rs;
                if (iswi) { if (fq == 0) { float* p = (float*)(ws + WS_AWI) + (size_t)row * 8; *(f32x4*)p = a0; *(f32x4*)(p + 4) = b0; } }
                else { if (normed) { const float s = red_fq((sum4sq(a0) + sum4sq(b0)) + (sum4sq(a1) + sum4sq(b1))); const float rq = __builtin_amdgcn_rsqf(s * (1.f / 64.f) + RMS_EPS);
                        a0 = a0 * g0a * rq; b0 = b0 * g0b * rq; a1 = a1 * g1a * rq; b1 = b1 * g1b * rq; }
                    bf16_t* p = dst + (size_t)row * ld + fq * 8; *(u32x4*)p = pack8(a0, b0); *(u32x4*)(p + 32) = pack8(a1, b1); } }
    }
};
template <class Epi, class Sched, bool ALIGN_EPI = false, bool SP2 = false>
__device__ __forceinline__ void gemm_phase(PG8_LAS unsigned char* lds, const Gemm g, const Sched& S, const Epi& E) {
    int tid_ = threadIdx.x; asm volatile("" : "+v"(tid_));
    const int tid = tid_, wid = __builtin_amdgcn_readfirstlane(tid >> 6), lane = tid & 63, wr = wid >> 2, wc = wid & 3, fr = lane & 15, fq = lane >> 4;
    const int K = g.K, nt = K / BK;
    unsigned voffA[2], voffB[2];
#pragma unroll
    for (int i = 0; i < 2; ++i) { int R, C; stage_rc(tid * 16 + i * 8192, R, C); const int Rb = Epi::PERM ? ((R & ~31) + perm32(R & 31)) : R;
        voffA[i] = (unsigned)(R * K + C) * 2u; voffB[i] = (unsigned)(Rb * K + C) * 2u; }
    const size_t kstep = (size_t)(BK * 2);
    const size_t hstep = (size_t)HALF * K * 2;
    const size_t tstep = 2 * hstep;
    const unsigned ldsw = (unsigned)wid * 1024u;
    const unsigned ldsb = (unsigned)__builtin_amdgcn_readfirstlane((int)((unsigned)(unsigned long long)lds + ldsw));
    const int aoff = lds_byte(wr * 64 + fr, fq * 8), boff = lds_byte(wc * 32 + fr, fq * 8);
#define PG8_SA(b, h) (((b) * 2 + (h)) * HTB)
#define PG8_SB(b, h) ((4 + (b) * 2 + (h)) * HTB)
#define PG8_STAGE(bufoff, gbase, voff) do { _Pragma("unroll") for (int _i = 0; _i < 2; ++_i) \
        pg8_glds16((const char*)(gbase), (voff)[_i], ldsb + (unsigned)((bufoff) + _i * 8192)); } while (0)
#define PG8_LDA(dst, b, h) do { _Pragma("unroll") for (int m = 0; m < 4; ++m) _Pragma("unroll") for (int k = 0; k < 2; ++k) dst[m][k] = *(const PG8_LAS bf16x8*)(lds + PG8_SA(b, h) + aoff + m * 2048 + k * 1024); } while (0)
#define PG8_LDB(dst, b, h) do { _Pragma("unroll") for (int n = 0; n < 2; ++n) _Pragma("unroll") for (int k = 0; k < 2; ++k) dst[n][k] = *(const PG8_LAS bf16x8*)(lds + PG8_SB(b, h) + boff + n * 2048 + k * 1024); } while (0)
#define PG8_MMA(ai, bj, At, Bt) do { __builtin_amdgcn_s_setprio(1); _Pragma("unroll") for (int m = 0; m < 4; ++m) _Pragma("unroll") for (int n = 0; n < 2; ++n) _Pragma("unroll") for (int k = 0; k < 2; ++k) \
        acc[ai][bj][m][n] = __builtin_amdgcn_mfma_f32_16x16x32_bf16(Bt[n][k], At[m][k], acc[ai][bj][m][n], 0, 0, 0); __builtin_amdgcn_s_setprio(0); } while (0)
#define PG8_WAIT_V(n) asm volatile("s_waitcnt vmcnt(" #n ")" ::: "memory")
#define PG8_WAIT_L(n) asm volatile("s_waitcnt lgkmcnt(" #n ")" ::: "memory")
#define PG8_BAR __builtin_amdgcn_s_barrier()
#define PG8_SCHED __builtin_amdgcn_sched_barrier(0)
    Unit cur, nxt; int ui = 0;
    if (!S.next(0, cur)) return;
    f32x4 acc[2][2][4][2];
#pragma unroll
    for (int a = 0; a < 2; ++a)
#pragma unroll
        for (int b = 0; b < 2; ++b)
#pragma unroll
            for (int m = 0; m < 4; ++m)
#pragma unroll
                for (int n = 0; n < 2; ++n) acc[a][b][m][n] = (f32x4){0.f, 0.f, 0.f, 0.f};
    bf16x8 At[4][2], B0[2][2], B1[2][2];
    const char* cA = (const char*)g.A + (size_t)cur.pm * tstep; const char* cB = (const char*)g.Bt + (size_t)cur.pn * tstep;
    S.a_ready(cur);
    if constexpr (SP2) {
        PG8_STAGE(PG8_SB(0, 0), cB, voffB); PG8_STAGE(PG8_SB(0, 1), cB + hstep, voffB); PG8_STAGE(PG8_SA(0, 0), cA, voffA); PG8_STAGE(PG8_SA(0, 1), cA + hstep, voffA);
        if (wr == 1) PG8_BAR;
        PG8_WAIT_V(2); PG8_BAR;
        PG8_STAGE(PG8_SB(1, 0), cB + kstep, voffB); PG8_STAGE(PG8_SA(1, 0), cA + kstep, voffA); PG8_STAGE(PG8_SB(1, 1), cB + hstep + kstep, voffB);
        PG8_WAIT_V(6); PG8_BAR;
    } else {
        PG8_STAGE(PG8_SB(0, 0), cB, voffB); PG8_STAGE(PG8_SA(0, 0), cA, voffA); PG8_STAGE(PG8_SB(0, 1), cB + hstep, voffB); PG8_STAGE(PG8_SA(0, 1), cA + hstep, voffA);
        if (wr == 1) PG8_BAR;
        PG8_WAIT_V(4); PG8_BAR;
        PG8_STAGE(PG8_SB(1, 0), cB + kstep, voffB); PG8_STAGE(PG8_SA(1, 0), cA + kstep, voffA); PG8_STAGE(PG8_SB(1, 1), cB + hstep + kstep, voffB);
        PG8_WAIT_V(6); PG8_BAR;
    }
    for (;;) {
        const bool has_next = S.next(ui + 1, nxt);
        const char* nA = has_next ? (const char*)g.A + (size_t)nxt.pm * tstep : cA; const char* nB = has_next ? (const char*)g.Bt + (size_t)nxt.pn * tstep : cB;
        for (int t = 0; t < nt; t += 2) {
            const bool last = (t == nt - 2);
            const char* a1 = cA + (size_t)(t + 1) * kstep;
            const char* a2 = last ? nA : cA + (size_t)(t + 2) * kstep; const char* b2 = last ? nB : cB + (size_t)(t + 2) * kstep;
            const char* a3 = a2 + kstep; const char* b3 = b2 + kstep;
            if (last && has_next) S.a_ready(nxt);
            if constexpr (SP2) {
            PG8_LDB(B0, 0, 0); PG8_LDB(B1, 0, 1); PG8_SCHED; PG8_LDA(At, 0, 0); PG8_STAGE(PG8_SA(1, 1), a1 + hstep, voffA);
            PG8_WAIT_V(8); PG8_WAIT_L(0); PG8_BAR; PG8_MMA(0, 0, At, B0); PG8_MMA(0, 1, At, B1); PG8_BAR; PG8_SCHED;
            PG8_LDA(At, 0, 1); PG8_STAGE(PG8_SB(0, 0), b2, voffB); PG8_STAGE(PG8_SB(0, 1), b2 + hstep, voffB); PG8_STAGE(PG8_SA(0, 0), a2, voffA);
            PG8_WAIT_V(8); PG8_WAIT_L(0); PG8_BAR; PG8_MMA(1, 0, At, B0); PG8_MMA(1, 1, At, B1); PG8_BAR; PG8_SCHED;
            PG8_LDB(B0, 1, 0); PG8_LDB(B1, 1, 1); PG8_SCHED; PG8_LDA(At, 1, 0); PG8_STAGE(PG8_SA(0, 1), a2 + hstep, voffA);
            PG8_WAIT_V(8); PG8_WAIT_L(0); PG8_BAR; PG8_MMA(0, 0, At, B0); PG8_MMA(0, 1, At, B1); PG8_BAR; PG8_SCHED;
            PG8_LDA(At, 1, 1); PG8_STAGE(PG8_SB(1, 0), b3, voffB); PG8_STAGE(PG8_SB(1, 1), b3 + hstep, voffB); PG8_STAGE(PG8_SA(1, 0), a3, voffA);
            PG8_WAIT_V(8); PG8_WAIT_L(0); PG8_BAR; PG8_MMA(1, 0, At, B0); PG8_MMA(1, 1, At, B1); PG8_BAR; PG8_SCHED;
            } else {
            PG8_LDB(B0, 0, 0); PG8_SCHED; PG8_LDA(At, 0, 0); PG8_STAGE(PG8_SA(1, 1), a1 + hstep, voffA);
            PG8_WAIT_L(8); PG8_BAR; PG8_WAIT_L(0); PG8_MMA(0, 0, At, B0); PG8_BAR; PG8_SCHED;
            PG8_LDB(B1, 0, 1); PG8_STAGE(PG8_SB(0, 0), b2, voffB);
            PG8_BAR; PG8_WAIT_L(0); PG8_MMA(0, 1, At, B1); PG8_BAR;
            PG8_LDA(At, 0, 1); PG8_STAGE(PG8_SA(0, 0), a2, voffA);
            PG8_BAR; PG8_WAIT_L(0); PG8_MMA(1, 0, At, B0); PG8_BAR; PG8_SCHED;
            PG8_STAGE(PG8_SB(0, 1), b2 + hstep, voffB);
            PG8_WAIT_V(6); PG8_BAR; PG8_MMA(1, 1, At, B1); PG8_BAR;
            PG8_LDB(B0, 1, 0); PG8_SCHED; PG8_LDA(At, 1, 0); PG8_STAGE(PG8_SA(0, 1), a2 + hstep, voffA);
            PG8_WAIT_L(8); PG8_BAR; PG8_WAIT_L(0); PG8_MMA(0, 0, At, B0); PG8_BAR; PG8_SCHED;
            PG8_LDB(B1, 1, 1); PG8_STAGE(PG8_SB(1, 0), b3, voffB);
            PG8_BAR; PG8_WAIT_L(0); PG8_MMA(0, 1, At, B1); PG8_BAR;
            PG8_LDA(At, 1, 1); PG8_STAGE(PG8_SA(1, 0), a3, voffA);
            PG8_BAR; PG8_WAIT_L(0); PG8_MMA(1, 0, At, B0); PG8_BAR; PG8_SCHED;
            PG8_STAGE(PG8_SB(1, 1), b3 + hstep, voffB);
            PG8_WAIT_V(6); PG8_BAR; PG8_MMA(1, 1, At, B1); PG8_BAR;
            }
        }
        if constexpr (ALIGN_EPI) { if (wr == 0) PG8_BAR; }
        if constexpr (!Epi::AFTER_DRAIN) { E(acc, cur, wr, wc, fr, fq); S.done(cur); }
        if (!has_next) break;
#pragma unroll
        for (int a = 0; a < 2; ++a)
#pragma unroll
            for (int b = 0; b < 2; ++b)
#pragma unroll
                for (int m = 0; m < 4; ++m)
#pragma unroll
                    for (int n = 0; n < 2; ++n) acc[a][b][m][n] = (f32x4){0.f, 0.f, 0.f, 0.f};
        cur = nxt; cA = nA; cB = nB; ++ui;
        if constexpr (ALIGN_EPI) { if (wr == 1) PG8_BAR; }
    }
    PG8_WAIT_V(0);
    if constexpr (!ALIGN_EPI) { if (wr == 0) PG8_BAR; }
    PG8_BAR;
    if constexpr (Epi::AFTER_DRAIN) { E.fused(acc, cur, wr, wc, fr, fq, lds, wid, lane); S.done(cur); }
#undef PG8_SA
#undef PG8_SB
#undef PG8_STAGE
#undef PG8_LDA
#undef PG8_LDB
#undef PG8_MMA
#undef PG8_WAIT_V
#undef PG8_WAIT_L
#undef PG8_BAR
#undef PG8_SCHED
}
}
__device__ __forceinline__ unsigned long long rt() { return __builtin_amdgcn_s_memrealtime(); }
__device__ __forceinline__ unsigned f2bf(float f) { unsigned u = __builtin_bit_cast(unsigned, f); return (u + 0x7fffu + ((u >> 16) & 1u)) >> 16; }
__device__ __forceinline__ unsigned pk2(float lo, float hi) { return f2bf(lo) | (f2bf(hi) << 16); }

#define XB_TMO      128
#define XB_XCNT(j)  (256  + 64 * (j))
#define XB_XSUB(j)  (1280 + 64 * (j))
#define XB_XGEN(j)  (2304 + 64 * (j))
#define XB_TOP      3328
#define XB_TOPGEN   3392
#define XCD_BAR_WORDS 3456
#define XB_SPIN_CAP (1u << 18)

__device__ __forceinline__ unsigned xb_ld(unsigned* p)              { return __hip_atomic_load(p, __ATOMIC_RELAXED, __HIP_MEMORY_SCOPE_AGENT); }
__device__ __forceinline__ unsigned xb_add(unsigned* p, unsigned v) { return __hip_atomic_fetch_add(p, v, __ATOMIC_RELAXED, __HIP_MEMORY_SCOPE_AGENT); }
__device__ __forceinline__ unsigned xb_xcc_id() { return (unsigned)__builtin_amdgcn_s_getreg((3 << 11) | 20) & 0xFu; }
#define XB_SPIN(cond, bar) do { unsigned _sp = 0; while (cond) { __builtin_amdgcn_s_sleep(1); \
    if ((++_sp & 255u) == 0u) { if (xb_ld(&(bar)[XB_TMO])) break; if (_sp > XB_SPIN_CAP) { atomicAdd(&(bar)[XB_TMO], 1u); break; } } } } while (0)

struct XcdBarrier {
    unsigned* bar; unsigned x;
    volatile LAS unsigned* st;
};

__device__ __forceinline__ XcdBarrier xcd_barrier_post(unsigned* bar, volatile LAS unsigned* st) {
    XcdBarrier b; b.bar = bar; b.x = xb_xcc_id(); b.st = st;
    if (threadIdx.x == 0) (void)xb_add(&bar[XB_XCNT(b.x)], 1u);
    return b;
}
__device__ __forceinline__ void xcd_barrier_complete(unsigned* bar, unsigned x, unsigned& nloc, unsigned& nx) {
    const unsigned G = gridDim.x * gridDim.y * gridDim.z;
    unsigned sum, cnt, mine, sp = 0u;
    for (;;) {
        sum = 0u; cnt = 0u; mine = 0u;
#pragma unroll
        for (unsigned j = 0; j < 16; ++j) { const unsigned c = xb_ld(&bar[XB_XCNT(j)]); sum += c; cnt += (c > 0u) ? 1u : 0u; }
        if (sum == G) break;
        __builtin_amdgcn_s_sleep(1);
        if ((++sp & 255u) == 0u) { if (xb_ld(&bar[XB_TMO])) break; if (sp > XB_SPIN_CAP) { atomicAdd(&bar[XB_TMO], 1u); break; } }
    }
    mine = xb_ld(&bar[XB_XCNT(x)]);
    nloc = mine > 0u ? mine : 1u; nx = cnt > 0u ? cnt : 1u;
}

__device__ __forceinline__ void xcd_barrier(const XcdBarrier& b) {
    asm volatile("s_waitcnt vmcnt(0)" ::: "memory");
    __syncthreads();
    if (threadIdx.x == 0) {
        unsigned* bar = b.bar;
        __builtin_amdgcn_s_waitcnt(0);
        unsigned nloc = b.st[0], nx = b.st[1];
        if (nloc == 0u) { xcd_barrier_complete(bar, b.x, nloc, nx); b.st[0] = nloc; b.st[1] = nx; }
        const unsigned old = xb_add(&bar[XB_XSUB(b.x)], 1u);
        const unsigned gen = old / nloc;
        if (old + 1u == (gen + 1u) * nloc) {
            __builtin_amdgcn_fence(__ATOMIC_RELEASE, "agent");
            asm volatile("s_waitcnt vmcnt(0)" ::: "memory");
            const unsigned og = xb_add(&bar[XB_TOP], 1u);
            const unsigned tg = og / nx;
            if (og + 1u == (tg + 1u) * nx) xb_add(&bar[XB_TOPGEN], 1u);
            else XB_SPIN(xb_ld(&bar[XB_TOPGEN]) == tg, bar);
            __builtin_amdgcn_fence(__ATOMIC_ACQUIRE, "agent");
            xb_add(&bar[XB_XGEN(b.x)], 1u);
            asm volatile("s_waitcnt vmcnt(0)" ::: "memory");
        } else {
            XB_SPIN(xb_ld(&bar[XB_XGEN(b.x)]) == gen, bar);
            __builtin_amdgcn_fence(__ATOMIC_ACQUIRE, "agent");
            asm volatile("s_waitcnt vmcnt(0)" ::: "memory");
        }
    }
    __syncthreads();
}


struct Frame {
    LAS unsigned char* lds;
    volatile LAS unsigned* MISC;
    gu32* ctl;
    int tid, lane, wave;
    int vcu, G, gw;
};
__device__ __forceinline__ float wave_sum(float v) {
#pragma unroll
    for (int o = 1; o < 64; o <<= 1) v += __shfl_xor(v, o);
    return v;
}
__device__ __forceinline__ int phys_row(int lc) { return (lc & ~255) + 128 * ((lc >> 5) & 1) + 32 * ((lc >> 6) & 3) + (lc & 31); }
__device__ __forceinline__ void tr_item128(const float* W, int ldw, int c0, int nvalid, const float* gain, bf16* WT, int Kd, int lc0, int k0, int lane) {
    const int h = lane >> 5, c = lane & 31; const bool act = 4 * c < nvalid;
    if (act) { const int prow = phys_row(lc0 + 4 * c), kb = k0 + 32 * h;
#pragma unroll
        for (int half = 0; half < 2; ++half) { f32x4 v[16];
#pragma unroll
            for (int i = 0; i < 16; ++i) v[i] = W ? __builtin_nontemporal_load((const GAS f32x4*)(W + (size_t)(kb + 16 * half + i) * ldw + c0 + 4 * c)) : (f32x4){0.f, 0.f, 0.f, 0.f};
            if (gain) {
#pragma unroll
                for (int q = 0; q < 4; ++q) { const f32x4 gv = *(const GAS f32x4*)(gain + kb + 16 * half + 4 * q);
#pragma unroll
                    for (int e = 0; e < 4; ++e) v[4 * q + e] = v[4 * q + e] * gv[e]; } }
#pragma unroll
            for (int e = 0; e < 4; ++e) { v4u o0, o1;
                o0.x = pk2(v[0][e], v[1][e]); o0.y = pk2(v[2][e], v[3][e]); o0.z = pk2(v[4][e], v[5][e]); o0.w = pk2(v[6][e], v[7][e]);
                o1.x = pk2(v[8][e], v[9][e]); o1.y = pk2(v[10][e], v[11][e]); o1.z = pk2(v[12][e], v[13][e]); o1.w = pk2(v[14][e], v[15][e]);
                bf16* dst = WT + (size_t)(prow + e) * Kd + kb + 16 * half; *(GAS v4u*)dst = o0; *(GAS v4u*)(dst + 8) = o1; } } }
}
__device__ __forceinline__ void conv_seg(Frame& F, int& rot, const float* W, int ldw, int c0, int ncols, const float* gain, bf16* WT, int Kd, int lc0) {
    const int ng = (ncols + 127) / 128, nk = Kd / 64, nit = ng * nk, NGW = F.G * NWAVES;
    int it = F.gw - rot; if (it < 0) it += NGW;
    for (; it < nit; it += NGW) { const int g = it % ng, kb = it / ng; int nv = ncols - 128 * g; nv = nv > 128 ? 128 : nv;
        tr_item128(W, ldw, c0 + 128 * g, nv, gain, WT, Kd, lc0 + 128 * g, 64 * kb, F.lane); }
    rot = (rot + nit) % NGW;
}
__device__ __forceinline__ void p0_prologue(Frame& F) {
    int rot = 0;
#define ws wsp()
    const int NGW = F.G * NWAVES;
    { bf16* hb = (bf16*)(ws + WS_HB); float* ssq = (float*)(ws + WS_SSQH); const float* x = inp(0);
      for (int r = 2 * F.gw; r < M; r += 2 * NGW) { f32x4 v[2][4]; float s[2];
#pragma unroll
          for (int rr = 0; rr < 2; ++rr) { const GAS f32x4* xr = (const GAS f32x4*)(x + (size_t)(r + rr) * D) + F.lane;
#pragma unroll
              for (int j = 0; j < 4; ++j) v[rr][j] = __builtin_nontemporal_load(xr + 64 * j); }
#pragma unroll
          for (int rr = 0; rr < 2; ++rr) { float t = 0.f;
#pragma unroll
              for (int j = 0; j < 4; ++j) t += (v[rr][j].x * v[rr][j].x + v[rr][j].y * v[rr][j].y) + (v[rr][j].z * v[rr][j].z + v[rr][j].w * v[rr][j].w);
              s[rr] = wave_sum(t);
              GAS unsigned long long* o8 = (GAS unsigned long long*)(hb + (size_t)(r + rr) * D) + F.lane;
#pragma unroll
              for (int j = 0; j < 4; ++j) o8[64 * j] = (unsigned long long)pk2(v[rr][j].x, v[rr][j].y) | ((unsigned long long)pk2(v[rr][j].z, v[rr][j].w) << 32);
              if (F.lane < 16) ssq[(size_t)(r + rr) * 16 + F.lane] = F.lane == 0 ? s[rr] : 0.f; } } }
    { float* ct = (float*)(ws + WS_ROPE); float* st = ct + SEQ * 16;
      for (int e = F.vcu * 512 + F.tid; e < SEQ * 16; e += F.G * 512) { const int pos = e >> 4, i = e & 15;
          const double invd = i == 0 ? 1.0 : i == 1 ? 0.5623413251903491 : i == 2 ? 0.31622776601683794 : i == 3 ? 0.17782794100389226 : i == 4 ? 0.1 : i == 5 ? 0.056234132519034905 : i == 6 ? 0.03162277660168379 : i == 7 ? 0.01778279410038923 :
                              i == 8 ? 0.01 : i == 9 ? 0.005623413251903491 : i == 10 ? 0.003162277660168379 : i == 11 ? 0.001778279410038923 : i == 12 ? 0.001 : i == 13 ? 0.0005623413251903491 : i == 14 ? 0.00031622776601683794 : 0.00017782794100389227;
          const float angf = (float)pos * (float)invd; const double a = (double)angf;
          const double nq = __builtin_rint(a * 0.6366197723675814); const double r = (a - nq * 1.5707963267948966) - nq * 6.123233995736766e-17; const double r2 = r * r;
          const double sn = r * (1.0 + r2 * (-1.0 / 6 + r2 * (1.0 / 120 + r2 * (-1.0 / 5040 + r2 * (1.0 / 362880 + r2 * (-1.0 / 39916800 + r2 * (1.0 / 6227020800.0)))))));
          const double cs = 1.0 + r2 * (-0.5 + r2 * (1.0 / 24 + r2 * (-1.0 / 720 + r2 * (1.0 / 40320 + r2 * (-1.0 / 3628800 + r2 * (1.0 / 479001600.0 + r2 * (-1.0 / 87178291200.0)))))));
          const int q = (int)nq & 3; const double c = q == 0 ? cs : q == 1 ? -sn : q == 2 ? -cs : sn, s = q == 0 ? sn : q == 1 ? cs : q == 2 ? -sn : -cs;
          ct[e] = (float)c; st[e] = (float)s; } }
    for (int i = 0; i < 2; ++i) { const float* W = inp(3) + (size_t)i * D * A_IN; const float* g = inp(2) + i * D; bf16* WT = (bf16*)(ws + WS_WIN) + (size_t)i * WIN_ELEMS;
        conv_seg(F, rot, W, A_IN, 0, 1152, g, WT, D, 0);
        conv_seg(F, rot, W, A_IN, 1664, 64, g, WT, D, 1152);
        conv_seg(F, rot, W, A_IN, 1728, 8, g, WT, D, 1216);
        conv_seg(F, rot, nullptr, 0, 0, 56, nullptr, WT, D, 1224);
        conv_seg(F, rot, W, A_IN, 1152, 512, g, WT, D, 1280);
        conv_seg(F, rot, inp(6) + (size_t)i * D * D, D, 0, D, nullptr, (bf16*)(ws + WS_WOA) + (size_t)i * D * D, D, 0); }
    { bf16* WT = (bf16*)(ws + WS_WKVQ);
      conv_seg(F, rot, inp(8), 288, 0, 256, inp(7), WT, D, 0);
      conv_seg(F, rot, inp(13), QLORA, 0, QLORA, inp(12), WT, D, 256);
      conv_seg(F, rot, inp(8), 288, 256, 32, inp(7), WT, D, 640);
      conv_seg(F, rot, nullptr, 0, 0, 96, nullptr, WT, D, 672); }
    conv_seg(F, rot, inp(10), NUKV, 0, NUKV, inp(9), (bf16*)(ws + WS_WUKV), KVLORA, 0);
    { bf16* WT = (bf16*)(ws + WS_WDQ1);
      conv_seg(F, rot, inp(13) + (size_t)D * QLORA, QLORA, 0, QLORA, inp(12) + D, WT, D, 0);
      conv_seg(F, rot, nullptr, 0, 0, 128, nullptr, WT, D, 384); }
    for (int j = 0; j < 2; ++j) {
        conv_seg(F, rot, inp(15) + (size_t)j * QLORA * NUQ, NUQ, 0, NUQ, inp(14) + j * QLORA, (bf16*)(ws + WS_WUQ) + (size_t)j * WUQ_ELEMS, QLORA, 0);
        conv_seg(F, rot, inp(17) + (size_t)j * D * D, D, 0, D, nullptr, (bf16*)(ws + WS_WOB) + (size_t)j * D * D, D, 0); }
    for (int L = 0; L < 4; ++L) {
        conv_seg(F, rot, inp(19) + (size_t)L * D * FF, FF, 0, FF, inp(18) + L * D, (bf16*)(ws + WS_WUP) + (size_t)L * D * FF, D, 0);
        conv_seg(F, rot, inp(20) + (size_t)L * D * FF, D, 0, D, nullptr, (bf16*)(ws + WS_WDN) + (size_t)L * D * FF, FF, 0); }
#undef ws
}
namespace mla {
using bf16x8 = __attribute__((ext_vector_type(8))) short;
using s16x4  = __attribute__((ext_vector_type(4))) short;
using f32x16 = __attribute__((ext_vector_type(16))) float;
using u32x4  = __attribute__((ext_vector_type(4))) unsigned;
typedef __attribute__((address_space(3))) const char* lds_cptr;
typedef short v4i16_t __attribute__((ext_vector_type(4)));
constexpr int NW = 8, QBLK = 32, KVBLK = 64, LDQ = 1536, LDK = 96, LDV = 64, LDO = 1024, SEQL = 4096;
constexpr float SCALE = 0.10206207261596575f;
constexpr float THRL = 8.f;
constexpr int SHM_K = KVBLK * 96 * 2, SHM_V = KVBLK * 64 * 2;
constexpr int NSLOT = 5, SLOTB = SHM_K + SHM_V;
constexpr int LDS_OST = NSLOT * SLOTB, LDS_WS = LDS_OST + NW * 4096;
constexpr int SHM_ATTN = LDS_WS + NW * 256;
#define SBAR() __builtin_amdgcn_sched_barrier(0)
#define PIN(x) asm volatile("" : "+v"(x))
#define MFMA(a, b, c) __builtin_amdgcn_mfma_f32_32x32x16_bf16((a), (b), (c), 0, 0, 0)
__device__ __forceinline__ int crow(int r, int hi) { return (r & 3) + 8 * (r >> 2) + 4 * hi; }
__device__ __forceinline__ unsigned cvtpk(float lo, float hi) { return pg8::cvt_pk_bf16(lo, hi); }
__device__ __forceinline__ float bf2f(short s) { return __uint_as_float(((unsigned)(unsigned short)s) << 16); }
__device__ __forceinline__ void kload2(bf16x8* kf, lds_cptr kp, int d0) { kf[2 * d0] = *(const __attribute__((address_space(3))) bf16x8*)(kp + d0 * 2048); kf[2 * d0 + 1] = *(const __attribute__((address_space(3))) bf16x8*)(kp + d0 * 2048 + 512); }
__device__ __forceinline__ s16x4 vtr(lds_cptr p) { return __builtin_bit_cast(s16x4, __builtin_amdgcn_ds_read_tr16_b64_v4i16((__attribute__((address_space(3))) v4i16_t*)p)); }
#define MX3(a, b, c) __builtin_fmaxf(__builtin_fmaxf((a), (b)), (c))
__device__ __forceinline__ float rowmax(const f32x16& p0, const f32x16& p1) {
  float a = MX3(p0[0], p0[1], p1[0]), b = MX3(p0[2], p0[3], p1[1]); a = MX3(a, p1[2], p1[3]);
#pragma unroll
  for (int r = 4; r < 16; r += 4) { a = MX3(a, p0[r], p0[r + 1]); b = MX3(b, p0[r + 2], p0[r + 3]); a = MX3(a, p1[r], p1[r + 1]); b = MX3(b, p1[r + 2], p1[r + 3]); }
  float m = __builtin_fmaxf(a, b); auto rr = __builtin_amdgcn_permlane32_swap(__float_as_uint(m), __float_as_uint(m), false, false);
  return __builtin_fmaxf(__uint_as_float(rr[0]), __uint_as_float(rr[1])); }

__device__ __forceinline__ void attn_unit(const pg8::bf16_t* __restrict__ Qh, const pg8::bf16_t* __restrict__ Kh, const pg8::bf16_t* __restrict__ Vh, pg8::bf16_t* __restrict__ Oh,
                                          const float* __restrict__ qgain, const float* __restrict__ cosT, const float* __restrict__ sinT, int qb, char* lds,
                                          const pg8::bf16_t* __restrict__ Kn, const pg8::bf16_t* __restrict__ Vn, bool pre, int& ring) {
  int tid_ = threadIdx.x; asm volatile("" : "+v"(tid_));
  const int tid = tid_, wid = __builtin_amdgcn_readfirstlane(tid >> 6), lane = tid & 63, r32 = lane & 31, hi = lane >> 5;
  float* wsf = (float*)(lds + LDS_WS) + wid * 64;
  float m_reg = 0.f, l_reg = 0.f; f32x16 o[2]; o[0] = f32x16{}; o[1] = f32x16{}; bf16x8 qr[6];
  f32x16 negm = f32x16{}; PIN(negm);
  const int q0 = qb * 256, qrow = q0 + wid * QBLK + r32;
  const int NT = 4 * qb + 4, cqw = 4 * qb + (wid >> 1);
  const unsigned kvo0 = (unsigned)(lane * (LDK * 2) + wid * 16), kvo1 = (unsigned)(lane * (LDK * 2) + (8 + (wid & 3)) * 16);
  const unsigned vvo = (unsigned)((16 * (wid & 3) + (lane >> 2)) * (LDV * 2) + (wid >> 2) * 64 + (lane & 3) * 16);
  const unsigned lds0 = (unsigned)(uintptr_t)lds;
#define DMA(t, sl) do { const bool nx_ = (t) >= NT && Kn != nullptr; const int tt_ = (t) < NT ? (t) : (nx_ ? (t) - NT : NT - 1); const unsigned sl_ = lds0 + (sl);     \
    const char* kb_ = (const char*)(nx_ ? Kn : Kh) + (size_t)tt_ * (KVBLK * LDK * 2); const char* vb_ = (const char*)(nx_ ? Vn : Vh) + (size_t)tt_ * (KVBLK * LDV * 2);  \
    pg8::pg8_glds16(kb_, kvo0, sl_ + wid * 1024); pg8::pg8_glds16(kb_, kvo1, sl_ + (8 + (wid & 3)) * 1024); pg8::pg8_glds16(vb_, vvo, sl_ + SHM_K + wid * 1024); } while (0)
#define VMWAIT(n) asm volatile("s_waitcnt vmcnt(" #n ")" ::: "memory")
#define BAR() __builtin_amdgcn_s_barrier()
  const lds_cptr vp0 = (lds_cptr)lds + SHM_K + ((lane >> 4) & 1) * 32 + (lane & 3) * 8 + (4 * hi + ((lane & 15) >> 2)) * 64;
  const lds_cptr kp0 = (lds_cptr)lds + hi * 1024 + r32 * 16;
#define WRAP(x) ((x) >= NSLOT * SLOTB ? (x) - NSLOT * SLOTB : (x))
  const int s0_ = ring, s1_ = WRAP(s0_ + SLOTB), s2_ = WRAP(s1_ + SLOTB), s3_ = WRAP(s2_ + SLOTB), s4_ = WRAP(s3_ + SLOTB);
  if (!pre) { DMA(0, s0_); DMA(1, s1_); DMA(2, s2_); }
  {
    const pg8::bf16_t* Qw = Qh + (size_t)qrow * LDQ + hi * 8; float qf[6][8]; float ss = 0.f;
#pragma unroll
    for (int d0 = 0; d0 < 6; ++d0) { const bf16x8 raw = *reinterpret_cast<const bf16x8*>(Qw + d0 * 16);
#pragma unroll
      for (int j = 0; j < 8; ++j) { qf[d0][j] = bf2f(raw[j]); ss += qf[d0][j] * qf[d0][j]; } }
    { auto rr = __builtin_amdgcn_permlane32_swap(__float_as_uint(ss), __float_as_uint(ss), false, false); ss = __uint_as_float(rr[0]) + __uint_as_float(rr[1]); }
    const float rq = __builtin_amdgcn_rsqf(ss * (1.f / 96.f) + 1e-6f);
#pragma unroll
    for (int d0 = 0; d0 < 6; ++d0)
#pragma unroll
      for (int j = 0; j < 8; ++j) qf[d0][j] *= (rq * (SCALE * 1.4426950408889634f)) * qgain[d0 * 16 + hi * 8 + j];
#pragma unroll
    for (int j = 0; j < 8; ++j) { const float c = cosT[qrow * 16 + hi * 8 + j], s = sinT[qrow * 16 + hi * 8 + j]; const float x1 = qf[4][j], x2 = qf[5][j];
      qf[4][j] = x1 * c - x2 * s; qf[5][j] = x2 * c + x1 * s; }
#pragma unroll
    for (int d0 = 0; d0 < 6; ++d0) { u32x4 w = {cvtpk(qf[d0][0], qf[d0][1]), cvtpk(qf[d0][2], qf[d0][3]), cvtpk(qf[d0][4], qf[d0][5]), cvtpk(qf[d0][6], qf[d0][7])}; qr[d0] = __builtin_bit_cast(bf16x8, w); }
  }
  bool resc = false;
  f32x16 pA0, pA1, pB0, pB1; bf16x8 kf[12]; s16x4 vlo[4], vhi[4]; u32x4 pw0, pw1, pw2, pw3;
  int sl_prev = s0_, sl_cur = s1_, sl_next = s2_;
#define ROT() do { sl_prev = sl_cur; sl_cur = sl_next; sl_next = (sl_next == (NSLOT - 1) * SLOTB) ? 0 : sl_next + SLOTB; } while (0)
#define EX(v) __builtin_amdgcn_exp2f(v)
#define RESC() do { if (resc) { _Pragma("unroll") for (int d_ = 0; d_ < 2; ++d_) _Pragma("unroll") for (int r = 0; r < 16; ++r) o[d_][r] *= wsf[crow(r, hi)]; } } while (0)
#define DECIDE(C0, C1) do { const float pm_ = rowmax(C0, C1); resc = false;                                                              \
    if (__builtin_expect(__any(pm_ > THRL), 0)) { const float dl = __builtin_fmaxf(pm_, 0.f); m_reg += dl; const float nm_ = -m_reg;      \
      asm volatile("s_nop 15\n\ts_nop 7" ::: "memory");           \
      _Pragma("unroll") for (int r = 0; r < 16; ++r) { float a_ = C0[r], b_ = C1[r], c_ = negm[r];               \
        asm volatile("v_sub_f32 %0, %0, %3\n\tv_sub_f32 %1, %1, %3\n\tv_mov_b32 %2, %4" : "+v"(a_), "+v"(b_), "+v"(c_) : "v"(dl), "v"(nm_)); C0[r] = a_; C1[r] = b_; negm[r] = c_; } \
      const float f = __builtin_amdgcn_exp2f(-dl); l_reg *= f; if (hi == 0) wsf[r32] = f; resc = true; }                                  \
    PIN(negm); } while (0)
  VMWAIT(0); BAR();
  DMA(3, s3_);
  _Pragma("unroll") for (int d0 = 0; d0 < 6; ++d0) kload2(kf, kp0 + s0_, d0);
  pA0 = MFMA(kf[0], qr[0], negm); pA1 = MFMA(kf[1], qr[0], negm);
  _Pragma("unroll") for (int d0 = 1; d0 < 6; ++d0) { pA0 = MFMA(kf[2 * d0], qr[d0], pA0); pA1 = MFMA(kf[2 * d0 + 1], qr[d0], pA1); }
  DECIDE(pA0, pA1);
  _Pragma("unroll") for (int r = 0; r < 16; ++r) pA0[r] = EX(pA0[r]);
  _Pragma("unroll") for (int r = 0; r < 8; ++r) pA1[r] = EX(pA1[r]);
  _Pragma("unroll") for (int d0 = 0; d0 < 3; ++d0) kload2(kf, kp0 + s1_, d0);
  BAR(); RESC();
  DMA(4, s4_);
#define PKW(P, i) cvtpk(P[i], P[i + 1])
#define PAF(k) __builtin_bit_cast(bf16x8, pw##k)
#define VFR(s) (bf16x8){vlo[s][0], vlo[s][1], vlo[s][2], vlo[s][3], vhi[s][0], vhi[s][1], vhi[s][2], vhi[s][3]}
#define VRD(s, i) do { vlo[s] = vtr(vp_ + (((i) >> 2) * 4096 + ((i) & 3) * 1024)); vhi[s] = vtr(vp_ + (((i) >> 2) * 4096 + ((i) & 3) * 1024 + 512)); } while (0)
#define KRDN(d0) do { kload2(kf, kp0 + sl_next, d0); SBAR(); } while (0)
#define KRDC(d0) do { kload2(kf, kp0 + sl_cur, d0); SBAR(); } while (0)
#define STEP(C0, C1, P0, P1, t) do { SBAR(); const lds_cptr vp_ = vp0 + sl_prev; float sacc = 0.f; \
    KRDC(3); C0 = MFMA(kf[0], qr[0], negm); P1[8] = EX(P1[8]); PIN(P1); sacc += P0[0]; sacc += P0[1]; sacc += P0[2]; pw0[0] = PKW(P0, 0); PIN(pw0); PIN(sacc); SBAR(); \
    KRDC(4); C1 = MFMA(kf[1], qr[0], negm); P1[9] = EX(P1[9]); PIN(P1); sacc += P0[3]; sacc += P0[4]; sacc += P0[5]; pw0[1] = PKW(P0, 2); PIN(pw0); PIN(sacc); SBAR(); \
    KRDC(5); C0 = MFMA(kf[2], qr[1], C0); P1[10] = EX(P1[10]); PIN(P1); sacc += P0[6]; sacc += P0[7]; sacc += P0[8]; pw0[2] = PKW(P0, 4); pw2[0] = PKW(P1, 0); PIN(pw0); PIN(pw2); PIN(sacc); SBAR(); \
    C1 = MFMA(kf[3], qr[1], C1); P1[11] = EX(P1[11]); PIN(P1); sacc += P0[9]; sacc += P0[10]; sacc += P0[11]; pw0[3] = PKW(P0, 6); pw2[1] = PKW(P1, 2); PIN(pw0); PIN(pw2); PIN(sacc); SBAR(); \
    C0 = MFMA(kf[4], qr[2], C0); P1[12] = EX(P1[12]); PIN(P1); sacc += P0[12]; sacc += P0[13]; sacc += P0[14]; pw1[0] = PKW(P0, 8); pw2[2] = PKW(P1, 4); PIN(pw1); PIN(pw2); PIN(sacc); SBAR(); \
    C1 = MFMA(kf[5], qr[2], C1); P1[13] = EX(P1[13]); PIN(P1); sacc += P0[15]; sacc += P1[0]; sacc += P1[1]; pw1[1] = PKW(P0, 10); pw2[3] = PKW(P1, 6); PIN(pw1); PIN(pw2); PIN(sacc); SBAR(); \
    C0 = MFMA(kf[6], qr[3], C0); P1[14] = EX(P1[14]); PIN(P1); sacc += P1[2]; sacc += P1[3]; sacc += P1[4]; pw1[2] = PKW(P0, 12); PIN(pw1); PIN(sacc); SBAR(); \
    C1 = MFMA(kf[7], qr[3], C1); P1[15] = EX(P1[15]); PIN(P1); sacc += P1[5]; sacc += P1[6]; sacc += P1[7]; pw1[3] = PKW(P0, 14); PIN(pw1); PIN(sacc); SBAR(); \
    VRD(0, 0); SBAR(); C0 = MFMA(kf[8], qr[4], C0); sacc += P1[8]; sacc += P1[9]; sacc += P1[10]; pw3[0] = PKW(P1, 8); PIN(pw3); PIN(sacc); SBAR(); \
    VRD(1, 4); SBAR(); C1 = MFMA(kf[9], qr[4], C1); sacc += P1[11]; sacc += P1[12]; sacc += P1[13]; pw3[1] = PKW(P1, 10); PIN(pw3); PIN(sacc); SBAR(); \
    VRD(2, 1); SBAR(); C0 = MFMA(kf[10], qr[5], C0); sacc += P1[14]; sacc += P1[15]; pw3[2] = PKW(P1, 12); PIN(pw3); PIN(sacc); SBAR(); \
    VRD(3, 5); SBAR(); C1 = MFMA(kf[11], qr[5], C1); pw3[3] = PKW(P1, 14); PIN(pw3); PIN(sacc); SBAR(); \
    l_reg += sacc; \
    if ((t) > cqw) { asm volatile("" ::: "memory"); _Pragma("unroll") for (int r = 0; r < 16; ++r) { C0[r] = -1e30f; C1[r] = -1e30f; } PIN(C0); PIN(C1); }     \
    DECIDE(C0, C1); SBAR(); \
    o[0] = MFMA(PAF(0), VFR(0), o[0]); VRD(0, 2); C0[0] = EX(C0[0]); C0[1] = EX(C0[1]); C0[2] = EX(C0[2]); PIN(C0); SBAR(); \
    KRDN(0); o[1] = MFMA(PAF(0), VFR(1), o[1]); VRD(1, 6); C0[3] = EX(C0[3]); C0[4] = EX(C0[4]); C0[5] = EX(C0[5]); PIN(C0); SBAR(); \
    o[0] = MFMA(PAF(1), VFR(2), o[0]); VRD(2, 3); C0[6] = EX(C0[6]); C0[7] = EX(C0[7]); C0[8] = EX(C0[8]); PIN(C0); SBAR(); \
    KRDN(1); o[1] = MFMA(PAF(1), VFR(3), o[1]); VRD(3, 7); C0[9] = EX(C0[9]); C0[10] = EX(C0[10]); C0[11] = EX(C0[11]); PIN(C0); SBAR(); \
    o[0] = MFMA(PAF(2), VFR(0), o[0]); C0[12] = EX(C0[12]); C0[13] = EX(C0[13]); C0[14] = EX(C0[14]); PIN(C0); SBAR(); \
    KRDN(2); o[1] = MFMA(PAF(2), VFR(1), o[1]); C0[15] = EX(C0[15]); C1[0] = EX(C1[0]); C1[1] = EX(C1[1]); PIN(C0); PIN(C1); SBAR(); \
    o[0] = MFMA(PAF(3), VFR(2), o[0]); C1[2] = EX(C1[2]); C1[3] = EX(C1[3]); C1[4] = EX(C1[4]); PIN(C0); PIN(C1); SBAR(); \
    o[1] = MFMA(PAF(3), VFR(3), o[1]); C1[5] = EX(C1[5]); C1[6] = EX(C1[6]); C1[7] = EX(C1[7]); PIN(C0); PIN(C1); SBAR(); \
    } while (0)
  for (int t = 1; t + 1 < NT; t += 2) {
    STEP(pB0, pB1, pA0, pA1, t);     VMWAIT(3); BAR(); RESC(); DMA(t + 4, sl_prev); ROT();
    STEP(pA0, pA1, pB0, pB1, t + 1); VMWAIT(3); BAR(); RESC(); DMA(t + 5, sl_prev); ROT();
  }
  STEP(pB0, pB1, pA0, pA1, NT - 1); RESC();
  { _Pragma("unroll") for (int r = 8; r < 16; ++r) pB1[r] = EX(pB1[r]);
    float sacc = 0.f;
#pragma unroll
    for (int r = 0; r < 16; ++r) sacc += pB0[r];
#pragma unroll
    for (int r = 0; r < 16; ++r) sacc += pB1[r];
    l_reg += sacc;
    pw0 = (u32x4){PKW(pB0, 0), PKW(pB0, 2), PKW(pB0, 4), PKW(pB0, 6)}; pw1 = (u32x4){PKW(pB0, 8), PKW(pB0, 10), PKW(pB0, 12), PKW(pB0, 14)};
    pw2 = (u32x4){PKW(pB1, 0), PKW(pB1, 2), PKW(pB1, 4), PKW(pB1, 6)}; pw3 = (u32x4){PKW(pB1, 8), PKW(pB1, 10), PKW(pB1, 12), PKW(pB1, 14)};
    const lds_cptr vp_ = vp0 + sl_cur;
    VRD(0, 0); VRD(1, 4); VRD(2, 1); VRD(3, 5);
    o[0] = MFMA(PAF(0), VFR(0), o[0]); o[1] = MFMA(PAF(0), VFR(1), o[1]); o[0] = MFMA(PAF(1), VFR(2), o[0]); o[1] = MFMA(PAF(1), VFR(3), o[1]);
    VRD(0, 2); VRD(1, 6); VRD(2, 3); VRD(3, 7);
    o[0] = MFMA(PAF(2), VFR(0), o[0]); o[1] = MFMA(PAF(2), VFR(1), o[1]); o[0] = MFMA(PAF(3), VFR(2), o[0]); o[1] = MFMA(PAF(3), VFR(3), o[1]); }
  { auto rr = __builtin_amdgcn_permlane32_swap(__float_as_uint(l_reg), __float_as_uint(l_reg), false, false); l_reg = __uint_as_float(rr[0]) + __uint_as_float(rr[1]); }
  if (hi == 0) wsf[32 + r32] = l_reg; asm volatile("s_waitcnt lgkmcnt(0)" ::: "memory");
  float rli[16];
#pragma unroll
  for (int r = 0; r < 16; ++r) rli[r] = __builtin_amdgcn_rcpf(wsf[32 + crow(r, hi)]);
  pg8::bf16_t* Ow = Oh + (size_t)(q0 + wid * QBLK) * LDO; unsigned short* stg = (unsigned short*)(lds + LDS_OST) + wid * 2048;
#pragma unroll
  for (int r = 0; r < 16; ++r) { const int orow = crow(r, hi);
#pragma unroll
    for (int d0 = 0; d0 < 2; ++d0) stg[orow * 64 + d0 * 32 + r32] = (unsigned short)(cvtpk(o[d0][r] * rli[r], 0.f) & 0xffffu); }
  asm volatile("s_waitcnt lgkmcnt(0)" ::: "memory");
#pragma unroll
  for (int i = 0; i < 4; ++i) { const int row = i * 8 + (lane >> 3), ch = lane & 7; *(u32x4*)(Ow + (size_t)row * LDO + ch * 8) = *(const u32x4*)(stg + row * 64 + ch * 8); }
  ring = sl_next;
  asm volatile("s_waitcnt vmcnt(0) lgkmcnt(0)" ::: "memory"); BAR();
#undef DMA
#undef WRAP
#undef VMWAIT
#undef BAR
#undef ROT
#undef EX
#undef RESC
#undef DECIDE
#undef PKW
#undef PAF
#undef VFR
#undef VRD
#undef KRDN
#undef KRDC
#undef STEP
}
#undef SBAR
#undef PIN
#undef MFMA
#undef MX3
}

namespace dsa {
using bf16x8 = __attribute__((ext_vector_type(8))) short;
using s16x4  = __attribute__((ext_vector_type(4))) short;
using f32x4  = __attribute__((ext_vector_type(4))) float;
using u32x4  = __attribute__((ext_vector_type(4))) unsigned;
using u32x2  = __attribute__((ext_vector_type(2))) unsigned;
typedef unsigned short bf16_t;
constexpr int L_LIST = 0, L_BIAS = 16384, L_U = 18432, L_END = L_U + 131072;
constexpr float LOG2E = 1.4426950408889634f;
constexpr unsigned INVALID_ENTRY = 0x003f0000u;
__device__ __forceinline__ void glds16v(const void* gsrc, unsigned lds_dst) { unsigned keep;
    asm volatile("s_mov_b32 %0, m0\n\ts_mov_b32 m0, %2\n\ts_nop 0\n\tglobal_load_lds_dwordx4 %1, off\n\ts_mov_b32 m0, %0" : "=&s"(keep) : "v"(gsrc), "s"(lds_dst) : "memory"); }
__device__ __forceinline__ int t5_bucket(int rel) {
    const int n = rel < 0 ? -rel : rel; int b = n;
    if (n >= 8) { const int e = 31 - __builtin_clz(n); int v = 8 + 2 * (e - 3) + ((n * n) >= (2 << (2 * e)) ? 1 : 0); b = v > 15 ? 15 : v; }
    return b + (rel > 0 ? 16 : 0);
}
template <int OFF> __device__ __forceinline__ s16x4 trrdo(unsigned addr) { s16x4 r; asm volatile("ds_read_b64_tr_b16 %0, %1 offset:%2" : "=v"(r) : "v"(addr), "i"(OFF) : "memory"); return r; }
#define DSA_DPP(v, ctrl) __builtin_amdgcn_update_dpp(0, (v), (ctrl), 0xf, 0xf, true)
__device__ __forceinline__ int half_sum(int v) { v += DSA_DPP(v, 0xB1); v += DSA_DPP(v, 0x4E); v += DSA_DPP(v, 0x141); v += DSA_DPP(v, 0x140);
    auto r = __builtin_amdgcn_permlane16_swap((unsigned)v, (unsigned)v, false, false); return (int)(r[0] + r[1]); }
__device__ __forceinline__ float half_min(float x) { int v = __float_as_int(x);
#define DSA_STEP(ctrl) v = __float_as_int(fminf(__int_as_float(v), __int_as_float(DSA_DPP(v, ctrl))))
    DSA_STEP(0xB1); DSA_STEP(0x4E); DSA_STEP(0x141); DSA_STEP(0x140);
#undef DSA_STEP
    auto r = __builtin_amdgcn_permlane16_swap((unsigned)v, (unsigned)v, false, false); return fminf(__uint_as_float(r[0]), __uint_as_float(r[1])); }
__device__ __forceinline__ float half_max(float x) { int v = __float_as_int(x);
#define DSA_STEP(ctrl) v = __float_as_int(fmaxf(__int_as_float(v), __int_as_float(DSA_DPP(v, ctrl))))
    DSA_STEP(0xB1); DSA_STEP(0x4E); DSA_STEP(0x141); DSA_STEP(0x140);
#undef DSA_STEP
    auto r = __builtin_amdgcn_permlane16_swap((unsigned)v, (unsigned)v, false, false); return fmaxf(__uint_as_float(r[0]), __uint_as_float(r[1])); }
__device__ __forceinline__ void cnt4(int& cnt, float a, float b, float c, float d, float thr) {
    unsigned long long m0, m1, m2, m3;
    asm("v_cmp_gt_f32_e64 %1, %5, %9\n\tv_cmp_gt_f32_e64 %2, %6, %9\n\tv_cmp_gt_f32_e64 %3, %7, %9\n\tv_cmp_gt_f32_e64 %4, %8, %9\n\t"
        "v_addc_co_u32_e64 %0, %1, %0, 0, %1\n\tv_addc_co_u32_e64 %0, %2, %0, 0, %2\n\tv_addc_co_u32_e64 %0, %3, %0, 0, %3\n\tv_addc_co_u32_e64 %0, %4, %0, 0, %4"
        : "+v"(cnt), "=&s"(m0), "=&s"(m1), "=&s"(m2), "=&s"(m3) : "v"(a), "v"(b), "v"(c), "v"(d), "v"(thr));
}
using f32x2 = __attribute__((ext_vector_type(2))) float;
#define QNAN __builtin_nanf("")
__device__ __forceinline__ void cntp4(f32x2& ca, f32x2& cb, f32x2 s0, f32x2 s1, f32x2 s2, f32x2 s3, f32x2 big, f32x2 ntb) {
    f32x2 c0, c1, c2, c3;
    asm("v_pk_fma_f32 %2, %6, %10, %11 clamp\n\tv_pk_fma_f32 %3, %7, %10, %11 clamp\n\tv_pk_fma_f32 %4, %8, %10, %11 clamp\n\tv_pk_fma_f32 %5, %9, %10, %11 clamp\n\t"
        "v_pk_add_f32 %0, %0, %2\n\tv_pk_add_f32 %1, %1, %3\n\tv_pk_add_f32 %0, %0, %4\n\tv_pk_add_f32 %1, %1, %5"
        : "+v"(ca), "+v"(cb), "=&v"(c0), "=&v"(c1), "=&v"(c2), "=&v"(c3) : "v"(s0), "v"(s1), "v"(s2), "v"(s3), "v"(big), "v"(ntb)); }
__device__ __forceinline__ void selmap4(unsigned& map, float a, float b, float c, float d, float thr) {
    unsigned long long m0, m1, m2, m3;
    asm("v_cmp_gt_f32_e64 %1, %5, %9\n\tv_cmp_gt_f32_e64 %2, %6, %9\n\tv_cmp_gt_f32_e64 %3, %7, %9\n\tv_cmp_gt_f32_e64 %4, %8, %9\n\t"
        "v_addc_co_u32_e64 %0, %1, %0, %0, %1\n\tv_addc_co_u32_e64 %0, %2, %0, %0, %2\n\tv_addc_co_u32_e64 %0, %3, %0, %0, %3\n\tv_addc_co_u32_e64 %0, %4, %0, %0, %4"
        : "+v"(map), "=&s"(m0), "=&s"(m1), "=&s"(m2), "=&s"(m3) : "v"(a), "v"(b), "v"(c), "v"(d), "v"(thr));
}
#define DSA_LAS __attribute__((address_space(3)))
#define RELU(x) __builtin_amdgcn_fmed3f((x), 0.f, 3.0e38f)

__device__ __forceinline__ void dsa_pass(const bf16_t* __restrict__ Q, const bf16_t* __restrict__ QI, const bf16_t* __restrict__ K, const bf16_t* __restrict__ V, const bf16_t* __restrict__ KI,
                                         const float* __restrict__ WI, bf16_t* __restrict__ O, int b, int c, int pass, bool pre, bool pf, DSA_LAS unsigned char* lds) {
    int tid_ = threadIdx.x; asm volatile("" : "+v"(tid_));
    const int tid = tid_, wid = __builtin_amdgcn_readfirstlane(tid >> 6), lane = tid & 63, kl = lane & 15, g = lane >> 4, half = lane >> 5;
    const unsigned ldsb = (unsigned)(unsigned long long)lds;
    const size_t rb = (size_t)b * 4096;
    const int tw = 64 * c + 16 * pass + 2 * wid;
    DSA_LAS unsigned* list = (DSA_LAS unsigned*)(lds + L_LIST + wid * 2048);
    const DSA_LAS float* biasT = (const DSA_LAS float*)(lds + L_BIAS);
    const int nadm = 64 * (c + 1), ncnt = nadm < 256 ? nadm : 256;
    const int srow = 16 * wid + (lane >> 3), lch = (lane & 7) ^ ((srow >> 1) & 7);
    const bf16_t* kisrc = KI + (rb + srow) * 64 + lch * 8;
    const unsigned kidst = ldsb + L_U + wid * 2048;
    const bf16_t* kisrc2 = KI + (rb + srow + 8) * 64 + (lch ^ 4) * 8;
#define DSA_KIDMA(T_) do { glds16v(kisrc + (size_t)(T_) * 8192, kidst + ((T_) & 3) * 16384); glds16v(kisrc2 + (size_t)(T_) * 8192, kidst + ((T_) & 3) * 16384 + 1024); } while (0)
    if (c < 4) { if (pf) { DSA_KIDMA(0); DSA_KIDMA(1); } }
    if (c >= 4) {
        f32x2 sc2[64];
#define SC(j) sc2[(j) >> 1][(j) & 1]
#pragma unroll
        for (int j = 0; j < 64; ++j) sc2[j] = (f32x2){QNAN, QNAN};
        bf16x8 aq0, aq1; f32x4 w4;
        { const bf16_t* qp = QI + (rb + tw + (kl >> 3)) * 512 + (kl & 7) * 64 + 8 * g; aq0 = *(const bf16x8*)qp; aq1 = *(const bf16x8*)(qp + 32);
          w4 = *(const f32x4*)(WI + (rb + tw + (g >> 1)) * 8 + 4 * (g & 1)); }
        const int rd0 = kl * 128 + ((g ^ ((kl >> 1) & 7)) << 4), rd1 = rd0 ^ 64;
        const int nt = (c + 2) >> 1;
        if (!pre) { DSA_KIDMA(0); DSA_KIDMA(1); }
#pragma unroll
        for (int T = 0; T < 32; ++T) {
            if (T < nt) {
                if ((T & 1) == 0) {
                    asm volatile("s_waitcnt vmcnt(0)" ::: "memory");
                    __builtin_amdgcn_s_barrier(); asm volatile("" ::: "memory");
                    if (T + 2 < nt) DSA_KIDMA(T + 2);
                    if (T + 3 < nt) DSA_KIDMA(T + 3); }
                const DSA_LAS unsigned char* kb = lds + L_U + (T & 3) * 16384;
                bf16x8 fb[8]; f32x4 acc[4], acd[4];
#define DSA_RD(H) _Pragma("unroll") for (int st = 0; st < 4; ++st) { fb[2 * st] = *(const DSA_LAS bf16x8*)(kb + rd0 + (4 * (H) + st) * 2048); fb[2 * st + 1] = *(const DSA_LAS bf16x8*)(kb + rd1 + (4 * (H) + st) * 2048); }
#define DSA_MM(A) _Pragma("unroll") for (int st = 0; st < 4; ++st) A[st] = __builtin_amdgcn_mfma_f32_16x16x32_bf16(aq0, fb[2 * st], (f32x4){0.f, 0.f, 0.f, 0.f}, 0, 0, 0); \
                  _Pragma("unroll") for (int st = 0; st < 4; ++st) A[st] = __builtin_amdgcn_mfma_f32_16x16x32_bf16(aq1, fb[2 * st + 1], A[st], 0, 0, 0);
#define DSA_WS(A, H) _Pragma("unroll") for (int pr = 0; pr < 2; ++pr) { float ps[2]; \
                    _Pragma("unroll") for (int s2 = 0; s2 < 2; ++s2) { const f32x4 a = A[2 * pr + s2]; ps[s2] = (w4[0] * RELU(a[0]) + w4[1] * RELU(a[1])) + (w4[2] * RELU(a[2]) + w4[3] * RELU(a[3])); } \
                    auto r = __builtin_amdgcn_permlane16_swap(__float_as_uint(ps[0]), __float_as_uint(ps[1]), false, false); SC(4 * T + 2 * (H) + pr) = __uint_as_float(r[0]) + __uint_as_float(r[1]); }
                DSA_RD(0) __builtin_amdgcn_sched_barrier(0);
                DSA_MM(acc) __builtin_amdgcn_sched_barrier(0);
                DSA_RD(1) __builtin_amdgcn_sched_barrier(0);
                DSA_WS(acc, 0) __builtin_amdgcn_sched_barrier(0);
                DSA_MM(acd) __builtin_amdgcn_sched_barrier(0);
                DSA_WS(acd, 1) __builtin_amdgcn_sched_barrier(0);
#undef DSA_RD
#undef DSA_MM
#undef DSA_WS
                asm volatile("s_waitcnt lgkmcnt(0)" ::: "memory");
            }
        }
        __builtin_amdgcn_s_barrier();
        if (pf) { DSA_KIDMA(0); DSA_KIDMA(1); }
        if ((c & 1) == 0) {
#pragma unroll
            for (int T = 0; T < 32; ++T) if (T == nt - 1) sc2[2 * T + 1] = (f32x2){QNAN, QNAN};
        }
        const int nregs = 4 * nt;
        float mn = 3.0e38f, mx = -3.0e38f, mnb = 3.0e38f, mxb = -3.0e38f;
#pragma unroll
        for (int blk = 0; blk < 8; ++blk) if (16 * blk < nregs) {
#pragma unroll
            for (int jj = 0; jj < 8; jj += 2) { const f32x2 a = sc2[8 * blk + jj], b2 = sc2[8 * blk + jj + 1];
                asm("v_min3_f32 %0, %0, %1, %2" : "+v"(mn) : "v"(a[0]), "v"(a[1])); asm("v_max3_f32 %0, %0, %1, %2" : "+v"(mx) : "v"(a[0]), "v"(a[1]));
                asm("v_min3_f32 %0, %0, %1, %2" : "+v"(mnb) : "v"(b2[0]), "v"(b2[1])); asm("v_max3_f32 %0, %0, %1, %2" : "+v"(mxb) : "v"(b2[0]), "v"(b2[1])); } }
        mn = fminf(mn, mnb); mx = fmaxf(mx, mxb);
        mn = half_min(mn); mx = half_max(mx);
        constexpr float BIGF = 1.2676506002282294e30f;
        f32x2 big2 = {BIGF, BIGF}; asm volatile("" : "+v"(big2));
        float lo[2], hi[2], thr[2], tie[2]; int chi[2], need[2]; bool done[2];
#pragma unroll
        for (int q = 0; q < 2; ++q) { lo[q] = __int_as_float(__builtin_amdgcn_readlane(__float_as_int(mn), 32 * q)) - 1.0f; hi[q] = __int_as_float(__builtin_amdgcn_readlane(__float_as_int(mx), 32 * q));
            chi[q] = 0; need[q] = 0; done[q] = false; thr[q] = hi[q]; tie[q] = __builtin_nanf(""); }
        for (int it = 0; it < 64; ++it) {
            if (done[0] && done[1]) break;
            float mid[2];
#pragma unroll
            for (int q = 0; q < 2; ++q) { mid[q] = 0.5f * lo[q] + 0.5f * hi[q];
                if (!done[q] && (!(mid[q] > lo[q]) || !(mid[q] < hi[q]))) { done[q] = true; thr[q] = hi[q]; tie[q] = hi[q]; need[q] = 256 - chi[q]; } }
            if (done[0] && done[1]) break;
            const float tv = half ? mid[1] : mid[0]; const float ntb_ = tv * -BIGF; const f32x2 ntb2 = {ntb_, ntb_}; f32x2 ca = {0.f, 0.f}, cb = {0.f, 0.f};
#pragma unroll
            for (int blk = 0; blk < 8; ++blk) if (16 * blk < nregs) {
#pragma unroll
                for (int jj = 0; jj < 8; jj += 4) cntp4(ca, cb, sc2[8 * blk + jj], sc2[8 * blk + jj + 1], sc2[8 * blk + jj + 2], sc2[8 * blk + jj + 3], big2, ntb2); }
            ca += cb; int cv = (int)(ca[0] + ca[1]);
            cv = half_sum(cv);
            const int c0 = __builtin_amdgcn_readlane(cv, 0), c1 = __builtin_amdgcn_readlane(cv, 32);
#pragma unroll
            for (int q = 0; q < 2; ++q) { const int cq = q ? c1 : c0;
                if (!done[q]) { if (cq == 256) { done[q] = true; thr[q] = mid[q]; need[q] = 0; } else if (cq > 256) lo[q] = mid[q]; else { hi[q] = mid[q]; chi[q] = cq; } } }
        }
#pragma unroll
        for (int q = 0; q < 2; ++q) if (!done[q]) { thr[q] = hi[q]; tie[q] = hi[q]; need[q] = 256 - chi[q]; }
        DSA_LAS unsigned* lq = list + half * 256;
        if (need[0] == 0 && need[1] == 0) {
            const float tv = half ? thr[1] : thr[0]; unsigned mk[4] = {0u, 0u, 0u, 0u};
#pragma unroll
            for (int blk = 0; blk < 8; ++blk) {
                if (16 * blk < nregs) {
#pragma unroll
                    for (int jj = 0; jj < 16; jj += 4) selmap4(mk[blk >> 1], SC(16 * blk + jj), SC(16 * blk + jj + 1), SC(16 * blk + jj + 2), SC(16 * blk + jj + 3), tv);
                } else if (blk & 1) mk[blk >> 1] <<= 16;
            }
            const int cv = __builtin_popcount(mk[0]) + __builtin_popcount(mk[1]) + __builtin_popcount(mk[2]) + __builtin_popcount(mk[3]);
            int incl = cv;
#pragma unroll
            for (int o = 1; o < 32; o <<= 1) { const int t = __shfl_up(incl, o, 32); if ((lane & 31) >= o) incl += t; }
            unsigned wp = (unsigned)(unsigned long long)lq + 4u * (unsigned)(incl - cv);
#pragma unroll
            for (int w = 0; w < 4; ++w) if (32 * w < nregs) { unsigned m = mk[w]; const unsigned kb_ = (unsigned)(1024 * w + (lane & 31));
                while (m) { const unsigned lz = (unsigned)__builtin_clz(m); *(DSA_LAS unsigned*)wp = (lz << 5) + kb_; wp += 4u; m ^= 0x80000000u >> lz; } }
        } else {
            const float tv = half ? thr[1] : thr[0], ev = half ? tie[1] : tie[0]; const int nd = half ? need[1] : need[0]; int base = 0, tb = 0;
#pragma unroll
            for (int blk = 0; blk < 8; ++blk) if (16 * blk < nregs) {
#pragma unroll
                for (int jj = 0; jj < 16; ++jj) { const int j = 16 * blk + jj; const float s = SC(j);
                    const bool eq = (s == ev); const unsigned long long meq = __builtin_amdgcn_ballot_w64(eq);
                    const unsigned elo = (unsigned)meq, ehi = (unsigned)(meq >> 32);
                    int pe = __builtin_amdgcn_mbcnt_hi(ehi, __builtin_amdgcn_mbcnt_lo(elo, 0)); if (half) pe -= __builtin_popcount(elo);
                    const bool sel = (s > tv) || (eq && (tb + pe < nd));
                    const unsigned long long ms = __builtin_amdgcn_ballot_w64(sel); const unsigned slo = (unsigned)ms, shi = (unsigned)(ms >> 32);
                    int pp = __builtin_amdgcn_mbcnt_hi(shi, __builtin_amdgcn_mbcnt_lo(slo, 0)); if (half) pp -= __builtin_popcount(slo);
                    const int pos = base + pp;
                    if (sel && pos < 256) lq[pos] = (unsigned)(32 * j + (lane & 31));
                    base += half ? __builtin_popcount(shi) : __builtin_popcount(slo); tb += half ? __builtin_popcount(ehi) : __builtin_popcount(elo); } }
            for (int p = base + (lane & 31); p < 256; p += 32) lq[p] = INVALID_ENTRY;
        }
    } else {
        for (int p = lane; p < 2 * ncnt; p += 64) { const int q = p / ncnt; list[q * 256 + (p - q * ncnt)] = (unsigned)(p - q * ncnt); }
    }
    asm volatile("s_waitcnt lgkmcnt(0)" ::: "memory");
#pragma unroll
    for (int q = 0; q < 2; ++q)
#pragma unroll
        for (int i = 0; i < 4; ++i) { const int p = lane + 64 * i; if (p < ncnt) { const unsigned e = list[q * 256 + p]; if (e != INVALID_ENTRY) list[q * 256 + p] = e | ((unsigned)t5_bucket((int)e - (tw + q)) << 16); } }
    asm volatile("s_waitcnt lgkmcnt(0)" ::: "memory");
    const int nq = ncnt >> 6;
    const int vrow = lane >> 3, vslot = lane & 7;
    const int ls_ = (((vslot >> 1) ^ ((vrow >> 1) & 3)) << 1) | (vslot & 1);
    const int trow = 4 * g + ((lane >> 2) & 3), tp = lane & 3, tx = (trow >> 1) & 3;
    const unsigned vbuf = ldsb + L_U + 65536 + wid * 8192;
    struct StepRegs { bf16x8 k[4][2]; bf16x8 v[8]; bf16x8 q[2]; };
    const char* const Kb_ = (const char*)(K + rb * 64), * const Vb_ = (const char*)(V + rb * 64), * const Qb_ = (const char*)(Q + (rb + tw) * 1024);
    const unsigned koff_ = (unsigned)(16 * g), voff_ = (unsigned)(16 * ls_), qoff_ = (unsigned)(kl * 128 + 16 * g);
#define DSA_STEP_LOAD(R, S) do { const int q_ = (S) / nq, qr_ = (S) - q_ * nq; const DSA_LAS unsigned* lq_ = list + q_ * 256 + 64 * qr_; \
        { const unsigned qo_ = qoff_ + (unsigned)q_ * 2048u; R.q[0] = *(const bf16x8*)(Qb_ + qo_); R.q[1] = *(const bf16x8*)(Qb_ + qo_ + 64u); } \
        _Pragma("unroll") for (int tt = 0; tt < 4; ++tt) { const unsigned ko_ = (lq_[16 * tt + kl] & 0xffffu) * 128u + koff_; R.k[tt][0] = *(const bf16x8*)(Kb_ + ko_); R.k[tt][1] = *(const bf16x8*)(Kb_ + ko_ + 64u); } \
        _Pragma("unroll") for (int i = 0; i < 8; ++i) { const unsigned vo_ = (lq_[8 * i + vrow] & 0xffffu) * 128u + voff_; R.v[i] = *(const bf16x8*)(Vb_ + vo_); } } while (0)
#define DSA_STEP(R, S, VB) do { const int q_ = (S) / nq, qr_ = (S) - q_ * nq; const DSA_LAS unsigned* lq_ = list + q_ * 256 + 64 * qr_; \
        if (qr_ == 0) { m_run = -1.0e30f; l_run = 0.f; _Pragma("unroll") for (int db = 0; db < 4; ++db) o[db] = (f32x4){0.f, 0.f, 0.f, 0.f}; } \
          \
        u32x4 e4[4]; f32x4 bv[4]; \
        _Pragma("unroll") for (int tt = 0; tt < 4; ++tt) e4[tt] = *(const DSA_LAS u32x4*)(lq_ + 16 * tt + 4 * g); \
        _Pragma("unroll") for (int tt = 0; tt < 4; ++tt) _Pragma("unroll") for (int r = 0; r < 4; ++r) bv[tt][r] = biasT[((e4[tt][r] >> 16) & 31u) * 16 + kl]; \
        f32x4 st[4]; \
        _Pragma("unroll") for (int tt = 0; tt < 4; ++tt) { \
            f32x4 a = __builtin_amdgcn_mfma_f32_16x16x32_bf16(R.k[tt][0], R.q[0], (f32x4){0.f, 0.f, 0.f, 0.f}, 0, 0, 0); a = __builtin_amdgcn_mfma_f32_16x16x32_bf16(R.k[tt][1], R.q[1], a, 0, 0, 0); \
            _Pragma("unroll") for (int r = 0; r < 4; ++r) a[r] = (e4[tt][r] >> 16) == 63u ? -1.0e30f : a[r] + bv[tt][r]; \
            st[tt] = a; } \
        float mloc = fmaxf(fmaxf(fmaxf(st[0][0], st[0][1]), fmaxf(st[0][2], st[0][3])), fmaxf(fmaxf(st[1][0], st[1][1]), fmaxf(st[1][2], st[1][3]))); \
        mloc = fmaxf(mloc, fmaxf(fmaxf(fmaxf(st[2][0], st[2][1]), fmaxf(st[2][2], st[2][3])), fmaxf(fmaxf(st[3][0], st[3][1]), fmaxf(st[3][2], st[3][3])))); \
        { auto r16 = __builtin_amdgcn_permlane16_swap(__float_as_uint(mloc), __float_as_uint(mloc), false, false); mloc = fmaxf(__uint_as_float(r16[0]), __uint_as_float(r16[1])); \
          auto r32_ = __builtin_amdgcn_permlane32_swap(__float_as_uint(mloc), __float_as_uint(mloc), false, false); mloc = fmaxf(__uint_as_float(r32_[0]), __uint_as_float(r32_[1])); } \
        const float mnew = fmaxf(m_run, mloc), alpha = __builtin_amdgcn_exp2f(m_run - mnew); m_run = mnew; \
        float ps = 0.f; unsigned pk[4][2]; \
        _Pragma("unroll") for (int tt = 0; tt < 4; ++tt) { f32x4 p; _Pragma("unroll") for (int r = 0; r < 4; ++r) p[r] = __builtin_amdgcn_exp2f(st[tt][r] - mnew); \
            ps += (p[0] + p[1]) + (p[2] + p[3]); pk[tt][0] = pg8::cvt_pk_bf16(p[0], p[1]); pk[tt][1] = pg8::cvt_pk_bf16(p[2], p[3]); } \
        l_run = l_run * alpha + ps; \
        _Pragma("unroll") for (int db = 0; db < 4; ++db) o[db] = o[db] * alpha; \
        { DSA_LAS unsigned char* vw = lds + L_U + 65536 + wid * 8192 + (VB) + vrow * 128 + vslot * 16; \
          _Pragma("unroll") for (int i = 0; i < 8; ++i) *(DSA_LAS bf16x8*)(vw + i * 1024) = R.v[i]; \
          asm volatile("s_waitcnt lgkmcnt(0)" ::: "memory"); } \
        _Pragma("unroll") for (int s2 = 0; s2 < 2; ++s2) { \
            const u32x4 pw = {pk[2 * s2][0], pk[2 * s2][1], pk[2 * s2 + 1][0], pk[2 * s2 + 1][1]}; const bf16x8 pb = __builtin_bit_cast(bf16x8, pw); \
            s16x4 v1[4], v2[4]; \
            _Pragma("unroll") for (int db = 0; db < 4; ++db) { const unsigned ta = vbuf + (VB) + trow * 128 + ((db ^ tx) << 5) + tp * 8; \
                v1[db] = s2 == 0 ? trrdo<0>(ta) : trrdo<4096>(ta); v2[db] = s2 == 0 ? trrdo<2048>(ta) : trrdo<6144>(ta); } \
            asm volatile("s_waitcnt lgkmcnt(0)" : "+v"(v1[0]), "+v"(v1[1]), "+v"(v1[2]), "+v"(v1[3]), "+v"(v2[0]), "+v"(v2[1]), "+v"(v2[2]), "+v"(v2[3]) :: "memory"); \
            _Pragma("unroll") for (int db = 0; db < 4; ++db) { const bf16x8 va = {v1[db][0], v1[db][1], v1[db][2], v1[db][3], v2[db][0], v2[db][1], v2[db][2], v2[db][3]}; \
                o[db] = __builtin_amdgcn_mfma_f32_16x16x32_bf16(va, pb, o[db], 0, 0, 0); } } \
        if (qr_ == nq - 1) { float lt = l_run; \
            { auto r16 = __builtin_amdgcn_permlane16_swap(__float_as_uint(lt), __float_as_uint(lt), false, false); lt = __uint_as_float(r16[0]) + __uint_as_float(r16[1]); \
              auto r32_ = __builtin_amdgcn_permlane32_swap(__float_as_uint(lt), __float_as_uint(lt), false, false); lt = __uint_as_float(r32_[0]) + __uint_as_float(r32_[1]); } \
            const float rl = __builtin_amdgcn_rcpf(lt); bf16_t* op = O + (rb + tw + q_) * 1024 + kl * 64 + 4 * g; \
            _Pragma("unroll") for (int db = 0; db < 4; ++db) { u32x2 w; w.x = pg8::cvt_pk_bf16(o[db][0] * rl, o[db][1] * rl); w.y = pg8::cvt_pk_bf16(o[db][2] * rl, o[db][3] * rl); *(u32x2*)(op + 16 * db) = w; } } \
    } while (0)
    {
        float m_run = -1.0e30f, l_run = 0.f; f32x4 o[4];
#pragma unroll
        for (int db = 0; db < 4; ++db) o[db] = (f32x4){0.f, 0.f, 0.f, 0.f};
        StepRegs RA, RB; const int nsteps = 2 * nq;
        DSA_STEP_LOAD(RA, 0);
#pragma unroll 1
        for (int s = 0; s < nsteps; s += 2) {
            DSA_STEP_LOAD(RB, s + 1);
            asm volatile("" ::: "memory");
            DSA_STEP(RA, s, 0);
            { const int sn_ = s + 2 < nsteps ? s + 2 : nsteps - 1; DSA_STEP_LOAD(RA, sn_); }
            asm volatile("" ::: "memory");
            DSA_STEP(RB, s + 1, 0);
        }
    }
#undef DSA_STEP
#undef DSA_STEP_LOAD
#undef DSA_KIDMA
}

#undef RELU
#undef SC
#undef QNAN
#undef DSA_LAS
#undef DSA_DPP
}
__device__ __forceinline__ void dsa_phase(Frame& F) {
    unsigned char* ws = wsp();
    const dsa::bf16_t* Q = (const dsa::bf16_t*)(ws + WS_AQ); const dsa::bf16_t* QI = (const dsa::bf16_t*)(ws + WS_AQI); const dsa::bf16_t* K = (const dsa::bf16_t*)(ws + WS_AK);
    const dsa::bf16_t* V = (const dsa::bf16_t*)(ws + WS_AV); const dsa::bf16_t* KI = (const dsa::bf16_t*)(ws + WS_AKI); const float* WI = (const float*)(ws + WS_AWI); dsa::bf16_t* O = (dsa::bf16_t*)(ws + WS_OB);
    { int t_ = threadIdx.x; asm volatile("" : "+v"(t_)); const float* rbias = inp(1); LAS float* bt = (LAS float*)(F.lds + dsa::L_BIAS); if (t_ < 512) bt[t_] = rbias[t_] * dsa::LOG2E; }
    __syncthreads();
    for (int pr = F.vcu; pr < NB * 32; pr += F.G) { const int b = pr >> 5, c0 = pr & 31;
        bool pre = false;
        for (int k = 0; k < 2; ++k) { const int c = k == 0 ? c0 : 63 - c0;
            for (int pass = 0; pass < 4; ++pass) { const bool last = (k == 1 && pass == 3); const int cn = (pass == 3) ? 63 - c0 : c; const bool pf = !last && cn >= 4;
                dsa::dsa_pass(Q, QI, K, V, KI, WI, O, b, c, pass, pre, pf, F.lds); pre = pf; } }
        __syncthreads(); }
    __syncthreads();
}

__device__ __forceinline__ void mla_phase(Frame& F, int j) {
    unsigned char* ws = wsp();
    const pg8::bf16_t* QB = (const pg8::bf16_t*)(ws + WS_QB); const pg8::bf16_t* KB = (const pg8::bf16_t*)(ws + WS_KB); const pg8::bf16_t* VB = (const pg8::bf16_t*)(ws + WS_VB); pg8::bf16_t* OB = (pg8::bf16_t*)(ws + WS_OB);
    const float* qgain = inp(16) + j * 96; const float* cosT = (const float*)(ws + WS_ROPE); const float* sinT = cosT + SEQ * 16;
    int ring = 0; bool pre = false;
    for (int item = F.vcu; item < NB * 16 * 8; item += F.G) { const int bh = item >> 3, s = item & 7, b = bh >> 4, h = bh & 15; const size_t rb = (size_t)b * SEQ;
        const pg8::bf16_t* Kc = KB + (size_t)bh * SEQ * 96; const pg8::bf16_t* Vc = VB + (size_t)bh * SEQ * 64;
        for (int k = 0; k < 2; ++k) { const int qb = k == 0 ? s : 15 - s;
            const pg8::bf16_t* Kn = Kc; const pg8::bf16_t* Vn = Vc;
            if (k == 1) { const int ni = item + F.G; if (ni < NB * 16 * 8) { const int bh2 = ni >> 3; Kn = KB + (size_t)bh2 * SEQ * 96; Vn = VB + (size_t)bh2 * SEQ * 64; } else { Kn = nullptr; Vn = nullptr; } }
            mla::attn_unit(QB + rb * 1536 + h * 96, Kc, Vc, OB + rb * 1024 + h * 64, qgain, cosT, sinT, qb, (char*)F.lds, Kn, Vn, pre, ring); pre = Kn != nullptr; } }
}

#ifndef PROBE_BAR2
#define PROBE_BAR2 0
#endif
#ifndef REP_DSA
#define REP_DSA 1
#endif
#ifndef REP_MLA
#define REP_MLA 1
#endif
#ifndef REP_UP
#define REP_UP 1
#endif
#ifndef DSA_ENABLED
#define DSA_ENABLED 0
#endif
struct Args { const float* in[21]; float* out; unsigned char* ws; };
__global__ void __launch_bounds__(NWAVES * 64, 2) yoco_fwd(Args args) {
    extern __shared__ __attribute__((aligned(16))) unsigned char lds[];
    Frame F;
    F.lds = (LAS unsigned char*)lds;
    F.MISC = (volatile LAS unsigned*)(F.lds + MISC_OFF);
    F.tid = threadIdx.x; F.lane = F.tid & 63; F.wave = __builtin_amdgcn_readfirstlane(F.tid >> 6);
    F.G = gridDim.x; { const int bx = blockIdx.x; F.vcu = (F.G % 8 == 0) ? (bx % 8) * (F.G / 8) + bx / 8 : bx; }
    F.gw = F.vcu * NWAVES + F.wave;
    F.ctl = (gu32*)(wsp() + WS_CTL);
#define ws wsp()
    for (int u = F.tid; u < (LDS_BYTES - LDSCTL_OFF) / 4; u += NWAVES * 64) ((LAS unsigned*)(F.lds + LDSCTL_OFF))[u] = 0u;
    __syncthreads();
    (void)xcd_barrier_post((unsigned*)(wsp() + WS_CTL) + CW_BAR, F.MISC + 8);
#define GRID_BAR() do { XcdBarrier bar_; bar_.bar = (unsigned*)(wsp() + WS_CTL) + CW_BAR; bar_.x = xb_xcc_id(); bar_.st = F.MISC + 8; xcd_barrier(bar_); if (PROBE_BAR2) xcd_barrier(bar_); } while (0)
    typedef pg8::bf16_t hb_t;

    p0_prologue(F);
    GRID_BAR();

    for (int L = 0; L < 2; ++L) {
        bool mixed = false;
        if (L < 2) {
            { pg8::Gemm g{(const hb_t*)(ws + WS_HB), (const hb_t*)(ws + WS_WIN) + (size_t)L * WIN_ELEMS, M, NIN, D}; pg8::StaticOrder S; S.init(M, NIN, F.G, (int)blockIdx.x);
              pg8::EpiInproj E{L};
              pg8::gemm_phase<pg8::EpiInproj, pg8::StaticOrder, PG8_ALIGN, PG8_SP2>(F.lds + RING_OFF, g, S, E); }
            GRID_BAR();
            for (int rep_ = 0; rep_ < REP_DSA; ++rep_) dsa_phase(F);
            GRID_BAR();
            mixed = true;
        }
        if (mixed) {
            const hb_t* Wo = L < 2 ? (const hb_t*)(ws + WS_WOA) + (size_t)L * D * D : (const hb_t*)(ws + WS_WOB) + (size_t)(L - 2) * D * D;
            pg8::Gemm g{(const hb_t*)(ws + WS_OB), Wo, M, D, D}; pg8::StaticOrder S; S.init(M, D, F.G, (int)blockIdx.x);
            pg8::EpiResidT<1, 0> E{1, 0};
            pg8::gemm_phase<pg8::EpiResidT<1, 0>, pg8::StaticOrder, PG8_ALIGN, PG8_SP2>(F.lds + RING_OFF, g, S, E);
            GRID_BAR();
        }
        { pg8::Gemm g{(const hb_t*)(ws + WS_HB), (const hb_t*)(ws + WS_WUP) + (size_t)L * D * FF, M, FF, D}; pg8::StaticOrder S; S.init(M, FF, F.G, (int)blockIdx.x);
          pg8::EpiUp E{0, (int)(WS_KB / MiB)};
          pg8::gemm_phase<pg8::EpiUp, pg8::StaticOrder, PG8_ALIGN, PG8_SP2>(F.lds + RING_OFF, g, S, E); }
        GRID_BAR();
        { pg8::Gemm g{(const hb_t*)(ws + WS_KB), (const hb_t*)(ws + WS_WDN) + (size_t)L * D * FF, M, D, FF}; pg8::StaticOrder S; S.init(M, D, F.G, (int)blockIdx.x);
          pg8::EpiResidT<0, 1> E{1, 0};
          pg8::gemm_phase<pg8::EpiResidT<0, 1>, pg8::StaticOrder, PG8_ALIGN, PG8_SP2>(F.lds + RING_OFF, g, S, E); }
        GRID_BAR();
    }
    for (int L = 2; L < 4; ++L) {
        bool mixed = false;
        if (L >= 2) {
            const int j = L - 2;
            if (j == 0) { pg8::Gemm g{(const hb_t*)(ws + WS_HB), (const hb_t*)(ws + WS_WKVQ), M, NKVQ, D}; pg8::StaticOrder S; S.init(M, NKVQ, F.G, (int)blockIdx.x);
              pg8::EpiKvq<0> E{};
              pg8::gemm_phase<pg8::EpiKvq<0>, pg8::StaticOrder, PG8_ALIGN, PG8_SP2>(F.lds + RING_OFF, g, S, E); }
            else { pg8::Gemm g{(const hb_t*)(ws + WS_HB), (const hb_t*)(ws + WS_WDQ1), M, NDQ1, D}; pg8::StaticOrder S; S.init(M, NDQ1, F.G, (int)blockIdx.x);
              pg8::EpiKvq<1> E{};
              pg8::gemm_phase<pg8::EpiKvq<1>, pg8::StaticOrder, PG8_ALIGN, PG8_SP2>(F.lds + RING_OFF, g, S, E); }
            GRID_BAR();
            if (j == 0) {
                int Kk = KVLORA; asm volatile("" : "+s"(Kk));
                pg8::Gemm g{(const hb_t*)(ws + WS_CKV), (const hb_t*)(ws + WS_WUKV), M, NUKV, Kk}; pg8::StaticOrder S; S.init(M, NUKV, F.G, (int)blockIdx.x);
                pg8::EpiUkv E{};
                pg8::gemm_phase<pg8::EpiUkv, pg8::StaticOrder, PG8_ALIGN, PG8_SP2>(F.lds + RING_OFF, g, S, E); }
            { int Kk = QLORA; asm volatile("" : "+s"(Kk)); pg8::Gemm g{(const hb_t*)(ws + WS_QL), (const hb_t*)(ws + WS_WUQ) + (size_t)j * WUQ_ELEMS, M, NUQ, Kk}; pg8::StaticOrder S; S.init(M, NUQ, F.G, (int)blockIdx.x);
              pg8::EpiUq E{};
              pg8::gemm_phase<pg8::EpiUq, pg8::StaticOrder, PG8_ALIGN, PG8_SP2>(F.lds + RING_OFF, g, S, E); }
            GRID_BAR();
            for (int rep_ = 0; rep_ < REP_MLA; ++rep_) mla_phase(F, j);
            GRID_BAR();
            mixed = true;
        }
        if (mixed) {
            const hb_t* Wo = L < 2 ? (const hb_t*)(ws + WS_WOA) + (size_t)L * D * D : (const hb_t*)(ws + WS_WOB) + (size_t)(L - 2) * D * D;
            pg8::Gemm g{(const hb_t*)(ws + WS_OB), Wo, M, D, D}; pg8::StaticOrder S; S.init(M, D, F.G, (int)blockIdx.x);
            pg8::EpiResidT<1, 0> E{1, 0};
            pg8::gemm_phase<pg8::EpiResidT<1, 0>, pg8::StaticOrder, PG8_ALIGN, PG8_SP2>(F.lds + RING_OFF, g, S, E);
            GRID_BAR();
        }
        const int nhalf = L == 3 ? 1 : 2, Mrows = L == 3 ? M : MH, hid_mib = L == 3 ? (int)(WS_KB / MiB) : (int)(WS_HID / MiB);
        for (int hf = 0; hf < nhalf; ++hf) {
            const size_t r0 = (size_t)hf * MH;
            for (int rep_ = 0; rep_ < REP_UP; ++rep_)
            { pg8::Gemm g{(const hb_t*)(ws + WS_HB) + r0 * D, (const hb_t*)(ws + WS_WUP) + (size_t)L * D * FF, Mrows, FF, D}; pg8::StaticOrder S; S.init(Mrows, FF, F.G, (int)blockIdx.x);
              pg8::EpiUp E{(int)r0, hid_mib};
              pg8::gemm_phase<pg8::EpiUp, pg8::StaticOrder, PG8_ALIGN, PG8_SP2>(F.lds + RING_OFF, g, S, E); }
            GRID_BAR();
            { pg8::Gemm g{(const hb_t*)(ws + (size_t)hid_mib * MiB), (const hb_t*)(ws + WS_WDN) + (size_t)L * D * FF, Mrows, D, FF}; pg8::StaticOrder S; S.init(Mrows, D, F.G, (int)blockIdx.x);
              pg8::EpiResidT<0, 1> E{L == 3 ? 2 : 1, (int)r0};
              pg8::gemm_phase<pg8::EpiResidT<0, 1>, pg8::StaticOrder, PG8_ALIGN, PG8_SP2>(F.lds + RING_OFF, g, S, E); }
            if (L != 3) GRID_BAR();
        }
        }
#undef ws
}
extern "C" void kernel_launch(void* const* d_in, const int* in_sizes, int n_in, void* d_out, int out_size, void* d_ws, size_t ws_size, hipStream_t stream) {
    static int grid = 0;
    if (grid == 0) {
        if (n_in != 21 || in_sizes[0] != M * D || out_size != M * D || ws_size < WS_END) { fprintf(stderr, "kernel_launch: unexpected shapes: n_in %d in0 %d out %d ws %zu\n", n_in, n_in > 0 ? in_sizes[0] : -1, out_size, ws_size); grid = -1; return; }
        int dev = 0, cus = 0, per_cu = 0;
        if (hipGetDevice(&dev) != hipSuccess || hipDeviceGetAttribute(&cus, hipDeviceAttributeMultiprocessorCount, dev) != hipSuccess) { grid = -1; return; }
        if (hipFuncSetAttribute((const void*)yoco_fwd, hipFuncAttributeMaxDynamicSharedMemorySize, LDS_BYTES) != hipSuccess) { fprintf(stderr, "kernel_launch: hipFuncSetAttribute failed\n"); grid = -1; return; }
        if (hipOccupancyMaxActiveBlocksPerMultiprocessor(&per_cu, (const void*)yoco_fwd, NWAVES * 64, LDS_BYTES) != hipSuccess || per_cu < 1) { fprintf(stderr, "kernel_launch: occupancy query reports %d\n", per_cu); }
        (void)hipGetLastError();
        grid = cus;
    }
    if (grid < 0) return;
    if (hipMemsetAsync((char*)d_ws + WS_CTL, 0, CTL_ZERO_BYTES, stream) != hipSuccess) return;
    Args a{};
    for (int i = 0; i < 21; ++i) a.in[i] = (const float*)d_in[i];
    a.out = (float*)d_out; a.ws = (unsigned char*)d_ws;
    hipLaunchKernelGGL(yoco_fwd, dim3(grid), dim3(NWAVES * 64), LDS_BYTES, stream, a);
}
```

```cpp
#include <hip/hip_runtime.h>
#include <cstdio>
#include <cstdint>

#ifndef PG8_SP2
#define PG8_SP2 true
#endif
#ifndef PG8_ALIGN
#define PG8_ALIGN true
#endif
constexpr int NWAVES = 8;
constexpr int NB = 8, SEQ = 4096, M = NB * SEQ, D = 1024, FF = 4096, MH = M / 2;
constexpr int A_IN = 1736, NIN = 1792;
constexpr int NKVQ = 768, NUKV = 2048, NDQ1 = 512, NUQ = 1536, QLORA = 384, KVLORA = 256;
constexpr size_t MiB = 1u << 20;
constexpr size_t WS_CTL = 0, CTL_ZERO_BYTES = 1 * MiB;
constexpr size_t WS_WIN = 1 * MiB, WS_WOA = 8 * MiB, WS_WKVQ = 12 * MiB, WS_WUKV = 14 * MiB, WS_WDQ1 = 15 * MiB, WS_WUQ = 16 * MiB, WS_WOB = 19 * MiB, WS_WUP = 23 * MiB, WS_WDN = 55 * MiB;
constexpr size_t WS_SSQH = 87 * MiB, WS_SSQCKV = 89 * MiB, WS_SSQQL = 89 * MiB + 512 * 1024, WS_SSQKR = 90 * MiB + 512 * 1024, WS_KROPE = 91 * MiB, WS_ROPE = 95 * MiB;
constexpr size_t WS_HB = 96 * MiB, WS_KB = 160 * MiB, WS_VB = 256 * MiB, WS_X = 320 * MiB;
constexpr size_t WS_HID = WS_X, WS_QB = WS_X, WS_OB = 416 * MiB, WS_QL = 416 * MiB, WS_CKV = 448 * MiB, WS_SSQB = 480 * MiB, WS_END = 482 * MiB;
constexpr size_t WS_AQ = WS_X, WS_AQI = 384 * MiB, WS_AK = 160 * MiB, WS_AV = 164 * MiB, WS_AKI = 168 * MiB, WS_AWI = 172 * MiB;
constexpr size_t WIN_ELEMS = (size_t)NIN * D, WUQ_ELEMS = (size_t)NUQ * QLORA;
constexpr int CW_TMO = 0, CW_CODE = 1, CW_BAR = 4096;
constexpr int RING_OFF = 0, RING_BYTES = 131072;
constexpr int LDSCTL_OFF = 151552, MISC_OFF = LDSCTL_OFF + 320;
constexpr int LDS_BYTES = 155648;
#define GAS __attribute__((address_space(1)))
#define LAS __attribute__((address_space(3)))
typedef unsigned short bf16;
typedef unsigned v4u __attribute__((ext_vector_type(4)));
typedef float f32x4 __attribute__((ext_vector_type(4)));
typedef short bf16x8 __attribute__((ext_vector_type(8)));
typedef GAS unsigned gu32;
typedef GAS unsigned long long gu64;
#define RLX_AGENT __ATOMIC_RELAXED, __HIP_MEMORY_SCOPE_AGENT
#define LDS_WAIT() asm volatile("s_waitcnt lgkmcnt(0)" ::: "memory")
#define VM_WAIT() asm volatile("s_waitcnt vmcnt(0)" ::: "memory")

typedef const float* cfp_t;
__device__ __forceinline__ cfp_t inp(int i) { return ((volatile cfp_t __attribute__((address_space(4)))*)__builtin_amdgcn_kernarg_segment_ptr())[i]; }
__device__ __forceinline__ float* outp() { return (float*)((volatile cfp_t __attribute__((address_space(4)))*)__builtin_amdgcn_kernarg_segment_ptr())[21]; }
__device__ __forceinline__ unsigned char* wsp() { return (unsigned char*)((volatile cfp_t __attribute__((address_space(4)))*)__builtin_amdgcn_kernarg_segment_ptr())[22]; }
namespace pg8 {
#define PG8_LAS __attribute__((address_space(3)))
typedef unsigned short bf16_t;
typedef short bf16x8 __attribute__((ext_vector_type(8)));
typedef float f32x4 __attribute__((ext_vector_type(4)));
typedef unsigned u32x4 __attribute__((ext_vector_type(4)));
constexpr int BM = 256, BK = 64, HALF = 128, HTB = HALF * BK * 2  , STAGE_BYTES = 8 * HTB, NXCD = 8, WGM = 8;

__host__ __device__ __forceinline__ int lds_byte(int r, int c) { const int st = (r >> 4) * 2 + (c >> 5), rr = r & 15, cc = c & 31, ob = rr * 64 + cc * 2; return st * 1024 + (ob ^ (((ob >> 9) & 1) << 5)); }
__host__ __device__ __forceinline__ void stage_rc(int b, int& R, int& C) { const int st = b / 1024, sb = b % 1024, swz = sb ^ (((sb >> 9) & 1) << 5); R = (st >> 1) * 16 + swz / 64; C = (st & 1) * 32 + (swz % 64) / 2; }
__host__ __device__ __forceinline__ int perm32(int rho) { const int n = rho >> 4, i = rho & 15; return 8 * (i >> 2) + 4 * n + (i & 3); }

struct Unit { int pm, pn; };
struct Gemm { const bf16_t* A; const bf16_t* Bt; int M, N, K; };

struct StaticOrder {
    int nM, nN, nwg, G, c;
    __host__ __device__ void init(int M, int N, int G_, int c_) { nM = M / BM; nN = N / BM; nwg = nM * nN; G = G_; c = c_; }
    __host__ __device__ bool next(int i, Unit& u) const {
        const long L = (long)i * G + c; if (L >= nwg) return false;
        int wgid = (int)L; { const int q = nwg / NXCD, r = nwg % NXCD, xcd = wgid % NXCD, off = wgid / NXCD; wgid = (xcd < r ? xcd * (q + 1) : r * (q + 1) + (xcd - r) * q) + off; }
        const int nig = WGM * nN, gid = wgid / nig, fm = gid * WGM, gsz = (nM - fm) < WGM ? (nM - fm) : WGM;
        u.pm = fm + ((wgid % nig) % gsz); u.pn = (wgid % nig) / gsz; return true;
    }
    __device__ __forceinline__ void a_ready(const Unit&) const {}
    __device__ __forceinline__ void done(const Unit&) const {}
};


typedef float f32x2 __attribute__((ext_vector_type(2)));
typedef __bf16 bf16x2_t __attribute__((ext_vector_type(2)));
__device__ __forceinline__ unsigned cvt_pk_bf16(float lo, float hi) { f32x2 v = {lo, hi}; bf16x2_t b = __builtin_convertvector(v, bf16x2_t); return __builtin_bit_cast(unsigned, b); }
__device__ __forceinline__ u32x4 pack8(f32x4 a, f32x4 b) { u32x4 w; w.x = cvt_pk_bf16(a[0], a[1]); w.y = cvt_pk_bf16(a[2], a[3]); w.z = cvt_pk_bf16(b[0], b[1]); w.w = cvt_pk_bf16(b[2], b[3]); return w; }
__device__ __forceinline__ float sum4sq(f32x4 a) { return (a[0] * a[0] + a[1] * a[1]) + (a[2] * a[2] + a[3] * a[3]); }
__device__ __forceinline__ float red_fq(float s) { const unsigned u = __float_as_uint(s); auto a = __builtin_amdgcn_permlane16_swap(u, u, false, false); const float t = __uint_as_float(a[0]) + __uint_as_float(a[1]);
    const unsigned w = __float_as_uint(t); auto b = __builtin_amdgcn_permlane32_swap(w, w, false, false); return __uint_as_float(b[0]) + __uint_as_float(b[1]); }
constexpr float RMS_EPS = 1e-6f;
__device__ __forceinline__ float rstd16(const float* ssq, int row, int fq, float inv_n) { const f32x4 v = *(const f32x4*)(ssq + (size_t)row * 16 + 4 * fq); return __builtin_amdgcn_rsqf(red_fq((v[0] + v[1]) + (v[2] + v[3])) * inv_n + RMS_EPS); }
__device__ __forceinline__ float rstd4(const float* ssq, int row, int fq, float inv_n) { return __builtin_amdgcn_rsqf(red_fq(ssq[(size_t)row * 4 + fq]) * inv_n + RMS_EPS); }
__device__ __forceinline__ float rstd6(const float* ssq, int row, int fq, float inv_n) { const f32x2 v = *(const f32x2*)(ssq + (size_t)row * 8 + 2 * fq); return __builtin_amdgcn_rsqf(red_fq(fq < 3 ? v[0] + v[1] : 0.f) * inv_n + RMS_EPS); }

__device__ __forceinline__ void rstd16x8(const float* ssq, int rowb, int fq, float inv_n, float (&rs)[2][4]) { f32x4 v[2][4];
#pragma unroll
    for (int ai = 0; ai < 2; ++ai)
#pragma unroll
        for (int m = 0; m < 4; ++m) v[ai][m] = *(const f32x4*)(ssq + (size_t)(rowb + ai * HALF + m * 16) * 16 + 4 * fq);
    asm volatile("" : "+v"(v[0][0]), "+v"(v[0][1]), "+v"(v[0][2]), "+v"(v[0][3]), "+v"(v[1][0]), "+v"(v[1][1]), "+v"(v[1][2]), "+v"(v[1][3]));
#pragma unroll
    for (int ai = 0; ai < 2; ++ai)
#pragma unroll
        for (int m = 0; m < 4; ++m) rs[ai][m] = __builtin_amdgcn_rsqf(red_fq((v[ai][m][0] + v[ai][m][1]) + (v[ai][m][2] + v[ai][m][3])) * inv_n + RMS_EPS); }
__device__ __forceinline__ void rstd6x8(const float* ssq, int rowb, int fq, float inv_n, float (&rs)[2][4]) { f32x2 v[2][4];
#pragma unroll
    for (int ai = 0; ai < 2; ++ai)
#pragma unroll
        for (int m = 0; m < 4; ++m) v[ai][m] = *(const f32x2*)(ssq + (size_t)(rowb + ai * HALF + m * 16) * 8 + 2 * fq);
    asm volatile("" : "+v"(v[0][0]), "+v"(v[0][1]), "+v"(v[0][2]), "+v"(v[0][3]), "+v"(v[1][0]), "+v"(v[1][1]), "+v"(v[1][2]), "+v"(v[1][3]));
#pragma unroll
    for (int ai = 0; ai < 2; ++ai)
#pragma unroll
        for (int m = 0; m < 4; ++m) rs[ai][m] = __builtin_amdgcn_rsqf(red_fq(fq < 3 ? v[ai][m][0] + v[ai][m][1] : 0.f) * inv_n + RMS_EPS); }
template <int SB_, int SCALE_> struct EpiResidT {
    static constexpr bool PERM = true, AFTER_DRAIN = false; static constexpr int sb = SB_, scale = SCALE_;
    int mode, r0;
    __device__ __forceinline__ void operator()(const f32x4 (&acc)[2][2][4][2], const Unit& u, int wr, int wc, int fr, int fq) const {
        { int t_ = threadIdx.x; asm volatile("" : "+v"(t_)); fr = t_ & 15; fq = (t_ >> 4) & 3; }
        const int col = u.pn * BM + wc * 64 + fq * 8;
        const float* xin = inp(0) + (size_t)r0 * 1024; float* out = outp() + (size_t)r0 * 1024; bf16_t* hb = (bf16_t*)(wsp() + WS_HB) + (size_t)r0 * 1024; float* ssq = (float*)(wsp() + (sb ? WS_SSQB : WS_SSQH)) + (size_t)r0 * 16;
#pragma unroll
        for (int ai = 0; ai < 2; ++ai) {
            float rs2[4] = {1.f, 1.f, 1.f, 1.f}; u32x4 rb[4][2];
            if (scale) { const float* sq = (const float*)(wsp() + WS_SSQB) + (size_t)r0 * 16; f32x4 sv[4];
#pragma unroll
                for (int m = 0; m < 4; ++m) sv[m] = *(const f32x4*)(sq + (size_t)(u.pm * BM + ai * HALF + wr * 64 + m * 16 + fr) * 16 + 4 * fq);
#pragma unroll
                for (int m = 0; m < 4; ++m) { const size_t off = (size_t)(u.pm * BM + ai * HALF + wr * 64 + m * 16 + fr) * 1024 + col;
#pragma unroll
                    for (int bj = 0; bj < 2; ++bj) rb[m][bj] = *(const u32x4*)(hb + off + bj * 32); }
                asm volatile("" : "+v"(sv[0]), "+v"(sv[1]), "+v"(sv[2]), "+v"(sv[3]), "+v"(rb[0][0]), "+v"(rb[0][1]), "+v"(rb[1][0]), "+v"(rb[1][1]), "+v"(rb[2][0]), "+v"(rb[2][1]), "+v"(rb[3][0]), "+v"(rb[3][1]));
#pragma unroll
                for (int m = 0; m < 4; ++m) { const float r_ = __builtin_amdgcn_rsqf(red_fq((sv[m][0] + sv[m][1]) + (sv[m][2] + sv[m][3])) * (1.f / 1024.f) + RMS_EPS); rs2[m] = r_ * r_ * 2.81474976710656e14f; } }
            else {
#pragma unroll
                for (int m = 0; m < 4; ++m) { const size_t off = (size_t)(u.pm * BM + ai * HALF + wr * 64 + m * 16 + fr) * 1024 + col;
#pragma unroll
                    for (int bj = 0; bj < 2; ++bj) rb[m][bj] = *(const u32x4*)(hb + off + bj * 32); }
                asm volatile("" : "+v"(rb[0][0]), "+v"(rb[0][1]), "+v"(rb[1][0]), "+v"(rb[1][1]), "+v"(rb[2][0]), "+v"(rb[2][1]), "+v"(rb[3][0]), "+v"(rb[3][1])); }
#pragma unroll
            for (int m = 0; m < 4; ++m) { const int row = u.pm * BM + ai * HALF + wr * 64 + m * 16 + fr; const size_t off = (size_t)row * 1024 + col; float s = 0.f;
#pragma unroll
                for (int bj = 0; bj < 2; ++bj) { const float sc_ = rs2[m]; const u32x4 w = rb[m][bj];
                    const f32x4 r0v = {__uint_as_float(w.x << 16), __uint_as_float(w.x & 0xffff0000u), __uint_as_float(w.y << 16), __uint_as_float(w.y & 0xffff0000u)};
                    const f32x4 r1v = {__uint_as_float(w.z << 16), __uint_as_float(w.z & 0xffff0000u), __uint_as_float(w.w << 16), __uint_as_float(w.w & 0xffff0000u)};
                    const f32x4 a = r0v + acc[ai][bj][m][0] * sc_, b = r1v + acc[ai][bj][m][1] * sc_;
                    if (mode == 2) { *(f32x4*)(out + off + bj * 32) = a; *(f32x4*)(out + off + bj * 32 + 4) = b; }
                    else { *(u32x4*)(hb + off + bj * 32) = pack8(a, b); s += sum4sq(a) + sum4sq(b); } }
                if (mode != 2) { s = red_fq(s); if (fq == 0) ssq[(size_t)row * 16 + u.pn * 4 + wc] = s; } }
        }
    }
};
using EpiResid = EpiResidT<0, 0>;
struct EpiUp {
    static constexpr bool PERM = true, AFTER_DRAIN = false;
    int r0, hid_mib;
    __device__ __forceinline__ void operator()(const f32x4 (&acc)[2][2][4][2], const Unit& u, int wr, int wc, int fr, int fq) const {
        { int t_ = threadIdx.x; asm volatile("" : "+v"(t_)); fr = t_ & 15; fq = (t_ >> 4) & 3; }
        const int col = u.pn * BM + wc * 64 + fq * 8;
        bf16_t* hid = (bf16_t*)(wsp() + (size_t)hid_mib * 1048576);
#pragma unroll
        for (int ai = 0; ai < 2; ++ai)
#pragma unroll
            for (int m = 0; m < 4; ++m) { const int row = u.pm * BM + ai * HALF + wr * 64 + m * 16 + fr;
#pragma unroll
                for (int bj = 0; bj < 2; ++bj) { f32x4 a, b; const f32x2 k2 = {5.9604644775390625e-08f, 5.9604644775390625e-08f};
#pragma unroll
                    for (int hh = 0; hh < 2; ++hh) { const f32x4 s = acc[ai][bj][m][hh]; f32x2 lo = {s[0], s[1]}, hi = {s[2], s[3]};
                        asm("v_pk_mul_f32 %0, %1, %2 clamp" : "=v"(lo) : "v"(lo), "v"(k2)); asm("v_pk_mul_f32 %0, %1, %2 clamp" : "=v"(hi) : "v"(hi), "v"(k2));
                        lo = lo * lo; hi = hi * hi; const f32x4 q = {lo[0], lo[1], hi[0], hi[1]}; if (hh == 0) a = q; else b = q; }
                    *(u32x4*)(hid + (size_t)row * 4096 + col + bj * 32) = pack8(a, b); } }
    }
};
__device__ __forceinline__ void pg8_glds16(const char* sbase, unsigned voff, unsigned lds_dst) { unsigned keep;
    asm volatile("s_mov_b32 %0, m0\n\ts_mov_b32 m0, %3\n\ts_nop 0\n\tglobal_load_lds_dwordx4 %2, %1\n\ts_mov_b32 m0, %0" : "=&s"(keep) : "s"(sbase), "v"(voff), "s"(lds_dst) : "memory"); }

template <int pn_off> struct EpiKvq {
    static constexpr bool PERM = true, AFTER_DRAIN = false;
    __device__ __forceinline__ void operator()(const f32x4 (&acc)[2][2][4][2], const Unit& u, int wr, int wc, int fr, int fq) const {
        { int t_ = threadIdx.x; asm volatile("" : "+v"(t_)); fr = t_ & 15; fq = (t_ >> 4) & 3; }
        const int vpn = u.pn + pn_off; unsigned char* ws = wsp();
        const float* ssqh = (const float*)(ws + WS_SSQH); bf16_t* ckv = (bf16_t*)(ws + WS_CKV); bf16_t* ql = (bf16_t*)(ws + WS_QL); float* krope = (float*)(ws + WS_KROPE); float* ssq_ckv = (float*)(ws + WS_SSQCKV); float* ssq_ql = (float*)(ws + WS_SSQQL); float* ssq_kr = (float*)(ws + WS_SSQKR);
        float rsv[2][4];
        rstd16x8(ssqh, u.pm * BM + wr * 64 + fr, fq, 1.f / 1024.f, rsv);
#pragma unroll
        for (int ai = 0; ai < 2; ++ai)
#pragma unroll
            for (int m = 0; m < 4; ++m) { const int row = u.pm * BM + ai * HALF + wr * 64 + m * 16 + fr; const float rs = rsv[ai][m];
                const f32x4 a0 = acc[ai][0][m][0] * rs, b0 = acc[ai][0][m][1] * rs, a1 = acc[ai][1][m][0] * rs, b1 = acc[ai][1][m][1] * rs;
                if (vpn == 0) { bf16_t* p = ckv + (size_t)row * 256 + wc * 64 + fq * 8; *(u32x4*)p = pack8(a0, b0); *(u32x4*)(p + 32) = pack8(a1, b1);
                    const float s = red_fq((sum4sq(a0) + sum4sq(b0)) + (sum4sq(a1) + sum4sq(b1))); if (fq == 0) ssq_ckv[(size_t)row * 4 + wc] = s; }
                else if (vpn == 1 || wc < 2) { bf16_t* p = ql + (size_t)row * 384 + (vpn - 1) * 256 + wc * 64 + fq * 8; *(u32x4*)p = pack8(a0, b0); *(u32x4*)(p + 32) = pack8(a1, b1);
                    const float s = red_fq((sum4sq(a0) + sum4sq(b0)) + (sum4sq(a1) + sum4sq(b1))); if (fq == 0) ssq_ql[(size_t)row * 8 + (vpn - 1) * 4 + wc] = s; }
                else if (wc == 2 && pn_off == 0) { float* p = krope + (size_t)row * 32 + fq * 8; *(f32x4*)p = a0; *(f32x4*)(p + 4) = b0;
                    const float s = red_fq(sum4sq(a0) + sum4sq(b0)); if (fq == 0) ssq_kr[row] = s; } }
    }
};
struct EpiUkv {
    static constexpr bool PERM = true, AFTER_DRAIN = false;
    __device__ __forceinline__ void operator()(const f32x4 (&acc)[2][2][4][2], const Unit& u, int wr, int wc, int fr, int fq) const {
        { int t_ = threadIdx.x; asm volatile("" : "+v"(t_)); fr = t_ & 15; fq = (t_ >> 4) & 3; }
        const int G = u.pn * 4 + wc, head = G >> 1; const bool isv = (G & 1) != 0; unsigned char* ws = wsp();
        const float* ssq_ckv = (const float*)(ws + WS_SSQCKV); const float* ssq_kr = (const float*)(ws + WS_SSQKR); const float* krope = (const float*)(ws + WS_KROPE); const float* kgain = inp(11); const float* cosT = (const float*)(ws + WS_ROPE); const float* sinT = cosT + SEQ * 16; bf16_t* kb = (bf16_t*)(ws + WS_KB); bf16_t* vb = (bf16_t*)(ws + WS_VB);
        f32x4 g0a, g0b, g1a, g1b, gr1, gr2;
        if (!isv) { g0a = *(const f32x4*)(kgain + fq * 8); g0b = *(const f32x4*)(kgain + fq * 8 + 4); g1a = *(const f32x4*)(kgain + 32 + fq * 8); g1b = *(const f32x4*)(kgain + 36 + fq * 8);
            gr1 = *(const f32x4*)(kgain + 64 + 4 * fq); gr2 = *(const f32x4*)(kgain + 80 + 4 * fq); }
        const int rowb = u.pm * BM + wr * 64 + fr;
        float rsv[2][4], skr[2][4];
        { float v[2][4];
#pragma unroll
          for (int ai = 0; ai < 2; ++ai)
#pragma unroll
              for (int m = 0; m < 4; ++m) { v[ai][m] = ssq_ckv[(size_t)(rowb + ai * HALF + m * 16) * 4 + fq]; skr[ai][m] = isv ? 0.f : ssq_kr[rowb + ai * HALF + m * 16]; }
          asm volatile("" : "+v"(v[0][0]), "+v"(v[0][1]), "+v"(v[0][2]), "+v"(v[0][3]), "+v"(v[1][0]), "+v"(v[1][1]), "+v"(v[1][2]), "+v"(v[1][3]),
                            "+v"(skr[0][0]), "+v"(skr[0][1]), "+v"(skr[0][2]), "+v"(skr[0][3]), "+v"(skr[1][0]), "+v"(skr[1][1]), "+v"(skr[1][2]), "+v"(skr[1][3]));
#pragma unroll
          for (int ai = 0; ai < 2; ++ai)
#pragma unroll
              for (int m = 0; m < 4; ++m) rsv[ai][m] = __builtin_amdgcn_rsqf(red_fq(v[ai][m]) * (1.f / 256.f) + RMS_EPS); }
#pragma unroll
        for (int ai = 0; ai < 2; ++ai)
#pragma unroll
            for (int m = 0; m < 4; ++m) { const int row = rowb + ai * HALF + m * 16; const float rs = rsv[ai][m];
                f32x4 kx1, kx2, cc, ss;
                if (!isv) { const int pos = row & 4095;
                    kx1 = *(const f32x4*)(krope + (size_t)row * 32 + 4 * fq); kx2 = *(const f32x4*)(krope + (size_t)row * 32 + 16 + 4 * fq);
                    cc = *(const f32x4*)(cosT + pos * 16 + 4 * fq); ss = *(const f32x4*)(sinT + pos * 16 + 4 * fq);
                    asm volatile("" : "+v"(kx1), "+v"(kx2), "+v"(cc), "+v"(ss)); }
                const f32x4 a0 = acc[ai][0][m][0] * rs, b0 = acc[ai][0][m][1] * rs, a1 = acc[ai][1][m][0] * rs, b1 = acc[ai][1][m][1] * rs;
                if (isv) { bf16_t* p = vb + ((((size_t)(row >> 12) * 16 + head) << 12) + (row & 4095)) * 64 + fq * 8; *(u32x4*)p = pack8(a0, b0); *(u32x4*)(p + 32) = pack8(a1, b1); }
                else { const float s = red_fq((sum4sq(a0) + sum4sq(b0)) + (sum4sq(a1) + sum4sq(b1))) + skr[ai][m]; const float rk = __builtin_amdgcn_rsqf(s * (1.f / 96.f) + RMS_EPS);
                    bf16_t* p = kb + ((((size_t)(row >> 12) * 16 + head) << 12) + (row & 4095)) * 96; *(u32x4*)(p + fq * 8) = pack8(a0 * g0a * rk, b0 * g0b * rk); *(u32x4*)(p + 32 + fq * 8) = pack8(a1 * g1a * rk, b1 * g1b * rk);
                    const f32x4 x1 = kx1 * gr1 * rk, x2 = kx2 * gr2 * rk;
                    const f32x4 o1 = x1 * cc - x2 * ss, o2 = x2 * cc + x1 * ss;
                    typedef unsigned u32x2v __attribute__((ext_vector_type(2)));
                    u32x2v w1, w2; w1.x = cvt_pk_bf16(o1[0], o1[1]); w1.y = cvt_pk_bf16(o1[2], o1[3]); w2.x = cvt_pk_bf16(o2[0], o2[1]); w2.y = cvt_pk_bf16(o2[2], o2[3]);
                    *(u32x2v*)(p + 64 + 4 * fq) = w1; *(u32x2v*)(p + 80 + 4 * fq) = w2; } }
    }
};
struct EpiUq {
    static constexpr bool PERM = true, AFTER_DRAIN = false;
    __device__ __forceinline__ void operator()(const f32x4 (&acc)[2][2][4][2], const Unit& u, int wr, int wc, int fr, int fq) const {
        { int t_ = threadIdx.x; asm volatile("" : "+v"(t_)); fr = t_ & 15; fq = (t_ >> 4) & 3; }
        const int col = u.pn * BM + wc * 64 + fq * 8; const float* ssq_ql = (const float*)(wsp() + WS_SSQQL); bf16_t* qb = (bf16_t*)(wsp() + WS_QB);
        float rsv[2][4];
        rstd6x8(ssq_ql, u.pm * BM + wr * 64 + fr, fq, 1.f / 384.f, rsv);
#pragma unroll
        for (int ai = 0; ai < 2; ++ai)
#pragma unroll
            for (int m = 0; m < 4; ++m) { const int row = u.pm * BM + ai * HALF + wr * 64 + m * 16 + fr; const float rs = rsv[ai][m];
                bf16_t* p = qb + (size_t)row * 1536 + col; *(u32x4*)p = pack8(acc[ai][0][m][0] * rs, acc[ai][0][m][1] * rs); *(u32x4*)(p + 32) = pack8(acc[ai][1][m][0] * rs, acc[ai][1][m][1] * rs); }
    }
};

struct EpiInproj {
    static constexpr bool PERM = true, AFTER_DRAIN = false;
    int layer;
    __device__ __forceinline__ void operator()(const f32x4 (&acc)[2][2][4][2], const Unit& u, int wr, int wc, int fr, int fq) const {
        { int t_ = threadIdx.x; asm volatile("" : "+v"(t_)); fr = t_ & 15; fq = (t_ >> 4) & 3; }
        unsigned char* ws = wsp(); const float* ssqh = (const float*)(ws + WS_SSQH);
        const bool isq = u.pn < 4, isk = (u.pn == 4 && wc == 0), normed = isq || isk;
        f32x4 g0a = {1.f, 1.f, 1.f, 1.f}, g0b = g0a, g1a = g0a, g1b = g0a;
        if (normed) { const float* gp = (isq ? inp(4) : inp(5)) + layer * 64 + fq * 8; const float sc = isq ? 0.125f * 1.4426950408889634f : 1.f;
            g0a = *(const f32x4*)gp * sc; g0b = *(const f32x4*)(gp + 4) * sc; g1a = *(const f32x4*)(gp + 32) * sc; g1b = *(const f32x4*)(gp + 36) * sc; }
        bf16_t* dst; int ld;
        if (isq) { dst = (bf16_t*)(ws + WS_AQ) + (u.pn * 4 + wc) * 64; ld = 1024; }
        else if (u.pn == 4) { dst = (bf16_t*)(ws + (wc == 0 ? WS_AK : wc == 1 ? WS_AV : WS_AKI)); ld = 64; }
        else { dst = (bf16_t*)(ws + WS_AQI) + ((u.pn - 5) * 4 + wc) * 64; ld = 512; }
        const bool iswi = (u.pn == 4 && wc == 3);
        float rsv[2][4];
        rstd16x8(ssqh, u.pm * BM + wr * 64 + fr, fq, 1.f / 1024.f, rsv);
#pragma unroll
        for (int ai = 0; ai < 2; ++ai)
#pragma unroll
            for (int m = 0; m < 4; ++m) { const int row = u.pm * BM + ai * HALF + wr * 64 + m * 16 + fr; const float rs = rsv[ai][m];
                f32x4 a0 = acc[ai][0][m][0] * rs, b0 = acc[ai][0][m][1] * rs, a1 = acc[ai][1][m][0] * rs, b1 = acc[ai][1][m][1] * rs;
                if (iswi) { if (fq == 0) { float* p = (float*)(ws + WS_AWI) + (size_t)row * 8; *(f32x4*)p = a0; *(f32x4*)(p + 4) = b0; } }
                else { if (normed) { const float s = red_fq((sum4sq(a0) + sum4sq(b0)) + (sum4sq(a1) + sum4sq(b1))); const float rq = __builtin_amdgcn_rsqf(s * (1.f / 64.f) + RMS_EPS);
                        a0 = a0 * g0a * rq; b0 = b0 * g0b * rq; a1 = a1 * g1a * rq; b1 = b1 * g1b * rq; }
                    bf16_t* p = dst + (size_t)row * ld + fq * 8; *(u32x4*)p = pack8(a0, b0); *(u32x4*)(p + 32) = pack8(a1, b1); } }
    }
};
template <class Epi, class Sched, bool ALIGN_EPI = false, bool SP2 = false>
__device__ __forceinline__ void gemm_phase(PG8_LAS unsigned char* lds, const Gemm g, const Sched& S, const Epi& E) {
    int tid_ = threadIdx.x; asm volatile("" : "+v"(tid_));
    const int tid = tid_, wid = __builtin_amdgcn_readfirstlane(tid >> 6), lane = tid & 63, wr = wid >> 2, wc = wid & 3, fr = lane & 15, fq = lane >> 4;
    const int K = g.K, nt = K / BK;
    unsigned voffA[2], voffB[2];
#pragma unroll
    for (int i = 0; i < 2; ++i) { int R, C; stage_rc(tid * 16 + i * 8192, R, C); const int Rb = Epi::PERM ? ((R & ~31) + perm32(R & 31)) : R;
        voffA[i] = (unsigned)(R * K + C) * 2u; voffB[i] = (unsigned)(Rb * K + C) * 2u; }
    const size_t kstep = (size_t)(BK * 2);
    const size_t hstep = (size_t)HALF * K * 2;
    const size_t tstep = 2 * hstep;
    const unsigned ldsw = (unsigned)wid * 1024u;
    const unsigned ldsb = (unsigned)__builtin_amdgcn_readfirstlane((int)((unsigned)(unsigned long long)lds + ldsw));
    const int aoff = lds_byte(wr * 64 + fr, fq * 8), boff = lds_byte(wc * 32 + fr, fq * 8);
#define PG8_SA(b, h) (((b) * 2 + (h)) * HTB)
#define PG8_SB(b, h) ((4 + (b) * 2 + (h)) * HTB)
#define PG8_STAGE(bufoff, gbase, voff) do { _Pragma("unroll") for (int _i = 0; _i < 2; ++_i) \
        pg8_glds16((const char*)(gbase), (voff)[_i], ldsb + (unsigned)((bufoff) + _i * 8192)); } while (0)
#define PG8_LDA(dst, b, h) do { _Pragma("unroll") for (int m = 0; m < 4; ++m) _Pragma("unroll") for (int k = 0; k < 2; ++k) dst[m][k] = *(const PG8_LAS bf16x8*)(lds + PG8_SA(b, h) + aoff + m * 2048 + k * 1024); } while (0)
#define PG8_LDB(dst, b, h) do { _Pragma("unroll") for (int n = 0; n < 2; ++n) _Pragma("unroll") for (int k = 0; k < 2; ++k) dst[n][k] = *(const PG8_LAS bf16x8*)(lds + PG8_SB(b, h) + boff + n * 2048 + k * 1024); } while (0)
#define PG8_MMA(ai, bj, At, Bt) do { __builtin_amdgcn_s_setprio(1); _Pragma("unroll") for (int m = 0; m < 4; ++m) _Pragma("unroll") for (int n = 0; n < 2; ++n) _Pragma("unroll") for (int k = 0; k < 2; ++k) \
        acc[ai][bj][m][n] = __builtin_amdgcn_mfma_f32_16x16x32_bf16(Bt[n][k], At[m][k], acc[ai][bj][m][n], 0, 0, 0); __builtin_amdgcn_s_setprio(0); } while (0)
#define PG8_WAIT_V(n) asm volatile("s_waitcnt vmcnt(" #n ")" ::: "memory")
#define PG8_WAIT_L(n) asm volatile("s_waitcnt lgkmcnt(" #n ")" ::: "memory")
#define PG8_BAR __builtin_amdgcn_s_barrier()
#define PG8_SCHED __builtin_amdgcn_sched_barrier(0)
    Unit cur, nxt; int ui = 0;
    if (!S.next(0, cur)) return;
    f32x4 acc[2][2][4][2];
#pragma unroll
    for (int a = 0; a < 2; ++a)
#pragma unroll
        for (int b = 0; b < 2; ++b)
#pragma unroll
            for (int m = 0; m < 4; ++m)
#pragma unroll
                for (int n = 0; n < 2; ++n) acc[a][b][m][n] = (f32x4){0.f, 0.f, 0.f, 0.f};
    bf16x8 At[4][2], B0[2][2], B1[2][2];
    const char* cA = (const char*)g.A + (size_t)cur.pm * tstep; const char* cB = (const char*)g.Bt + (size_t)cur.pn * tstep;
    S.a_ready(cur);
    if constexpr (SP2) {
        PG8_STAGE(PG8_SB(0, 0), cB, voffB); PG8_STAGE(PG8_SB(0, 1), cB + hstep, voffB); PG8_STAGE(PG8_SA(0, 0), cA, voffA); PG8_STAGE(PG8_SA(0, 1), cA + hstep, voffA);
        if (wr == 1) PG8_BAR;
        PG8_WAIT_V(2); PG8_BAR;
        PG8_STAGE(PG8_SB(1, 0), cB + kstep, voffB); PG8_STAGE(PG8_SA(1, 0), cA + kstep, voffA); PG8_STAGE(PG8_SB(1, 1), cB + hstep + kstep, voffB);
        PG8_WAIT_V(6); PG8_BAR;
    } else {
        PG8_STAGE(PG8_SB(0, 0), cB, voffB); PG8_STAGE(PG8_SA(0, 0), cA, voffA); PG8_STAGE(PG8_SB(0, 1), cB + hstep, voffB); PG8_STAGE(PG8_SA(0, 1), cA + hstep, voffA);
        if (wr == 1) PG8_BAR;
        PG8_WAIT_V(4); PG8_BAR;
        PG8_STAGE(PG8_SB(1, 0), cB + kstep, voffB); PG8_STAGE(PG8_SA(1, 0), cA + kstep, voffA); PG8_STAGE(PG8_SB(1, 1), cB + hstep + kstep, voffB);
        PG8_WAIT_V(6); PG8_BAR;
    }
    for (;;) {
        const bool has_next = S.next(ui + 1, nxt);
        const char* nA = has_next ? (const char*)g.A + (size_t)nxt.pm * tstep : cA; const char* nB = has_next ? (const char*)g.Bt + (size_t)nxt.pn * tstep : cB;
        for (int t = 0; t < nt; t += 2) {
            const bool last = (t == nt - 2);
            const char* a1 = cA + (size_t)(t + 1) * kstep;
            const char* a2 = last ? nA : cA + (size_t)(t + 2) * kstep; const char* b2 = last ? nB : cB + (size_t)(t + 2) * kstep;
            const char* a3 = a2 + kstep; const char* b3 = b2 + kstep;
            if (last && has_next) S.a_ready(nxt);
            if constexpr (SP2) {
            PG8_LDB(B0, 0, 0); PG8_LDB(B1, 0, 1); PG8_SCHED; PG8_LDA(At, 0, 0); PG8_STAGE(PG8_SA(1, 1), a1 + hstep, voffA);
            PG8_WAIT_V(8); PG8_WAIT_L(0); PG8_BAR; PG8_MMA(0, 0, At, B0); PG8_MMA(0, 1, At, B1); PG8_BAR; PG8_SCHED;
            PG8_LDA(At, 0, 1); PG8_STAGE(PG8_SB(0, 0), b2, voffB); PG8_STAGE(PG8_SB(0, 1), b2 + hstep, voffB); PG8_STAGE(PG8_SA(0, 0), a2, voffA);
            PG8_WAIT_V(8); PG8_WAIT_L(0); PG8_BAR; PG8_MMA(1, 0, At, B0); PG8_MMA(1, 1, At, B1); PG8_BAR; PG8_SCHED;
            PG8_LDB(B0, 1, 0); PG8_LDB(B1, 1, 1); PG8_SCHED; PG8_LDA(At, 1, 0); PG8_STAGE(PG8_SA(0, 1), a2 + hstep, voffA);
            PG8_WAIT_V(8); PG8_WAIT_L(0); PG8_BAR; PG8_MMA(0, 0, At, B0); PG8_MMA(0, 1, At, B1); PG8_BAR; PG8_SCHED;
            PG8_LDA(At, 1, 1); PG8_STAGE(PG8_SB(1, 0), b3, voffB); PG8_STAGE(PG8_SB(1, 1), b3 + hstep, voffB); PG8_STAGE(PG8_SA(1, 0), a3, voffA);
            PG8_WAIT_V(8); PG8_WAIT_L(0); PG8_BAR; PG8_MMA(1, 0, At, B0); PG8_MMA(1, 1, At, B1); PG8_BAR; PG8_SCHED;
            } else {
            PG8_LDB(B0, 0, 0); PG8_SCHED; PG8_LDA(At, 0, 0); PG8_STAGE(PG8_SA(1, 1), a1 + hstep, voffA);
            PG8_WAIT_L(8); PG8_BAR; PG8_WAIT_L(0); PG8_MMA(0, 0, At, B0); PG8_BAR; PG8_SCHED;
            PG8_LDB(B1, 0, 1); PG8_STAGE(PG8_SB(0, 0), b2, voffB);
            PG8_BAR; PG8_WAIT_L(0); PG8_MMA(0, 1, At, B1); PG8_BAR;
            PG8_LDA(At, 0, 1); PG8_STAGE(PG8_SA(0, 0), a2, voffA);
            PG8_BAR; PG8_WAIT_L(0); PG8_MMA(1, 0, At, B0); PG8_BAR; PG8_SCHED;
            PG8_STAGE(PG8_SB(0, 1), b2 + hstep, voffB);
            PG8_WAIT_V(6); PG8_BAR; PG8_MMA(1, 1, At, B1); PG8_BAR;
            PG8_LDB(B0, 1, 0); PG8_SCHED; PG8_LDA(At, 1, 0); PG8_STAGE(PG8_SA(0, 1), a2 + hstep, voffA);
            PG8_WAIT_L(8); PG8_BAR; PG8_WAIT_L(0); PG8_MMA(0, 0, At, B0); PG8_BAR; PG8_SCHED;
            PG8_LDB(B1, 1, 1); PG8_STAGE(PG8_SB(1, 0), b3, voffB);
            PG8_BAR; PG8_WAIT_L(0); PG8_MMA(0, 1, At, B1); PG8_BAR;
            PG8_LDA(At, 1, 1); PG8_STAGE(PG8_SA(1, 0), a3, voffA);
            PG8_BAR; PG8_WAIT_L(0); PG8_MMA(1, 0, At, B0); PG8_BAR; PG8_SCHED;
            PG8_STAGE(PG8_SB(1, 1), b3 + hstep, voffB);
            PG8_WAIT_V(6); PG8_BAR; PG8_MMA(1, 1, At, B1); PG8_BAR;
            }
        }
        if constexpr (ALIGN_EPI) { if (wr == 0) PG8_BAR; }
        if constexpr (!Epi::AFTER_DRAIN) { E(acc, cur, wr, wc, fr, fq); S.done(cur); }
        if (!has_next) break;
#pragma unroll
        for (int a = 0; a < 2; ++a)
#pragma unroll
            for (int b = 0; b < 2; ++b)
#pragma unroll
                for (int m = 0; m < 4; ++m)
#pragma unroll
                    for (int n = 0; n < 2; ++n) acc[a][b][m][n] = (f32x4){0.f, 0.f, 0.f, 0.f};
        cur = nxt; cA = nA; cB = nB; ++ui;
        if constexpr (ALIGN_EPI) { if (wr == 1) PG8_BAR; }
    }
    PG8_WAIT_V(0);
    if constexpr (!ALIGN_EPI) { if (wr == 0) PG8_BAR; }
    PG8_BAR;
    if constexpr (Epi::AFTER_DRAIN) { E.fused(acc, cur, wr, wc, fr, fq, lds, wid, lane); S.done(cur); }
#undef PG8_SA
#undef PG8_SB
#undef PG8_STAGE
#undef PG8_LDA
#undef PG8_LDB
#undef PG8_MMA
#undef PG8_WAIT_V
#undef PG8_WAIT_L
#undef PG8_BAR
#undef PG8_SCHED
}
}
__device__ __forceinline__ unsigned long long rt() { return __builtin_amdgcn_s_memrealtime(); }
__device__ __forceinline__ unsigned f2bf(float f) { unsigned u = __builtin_bit_cast(unsigned, f); return (u + 0x7fffu + ((u >> 16) & 1u)) >> 16; }
__device__ __forceinline__ unsigned pk2(float lo, float hi) { return f2bf(lo) | (f2bf(hi) << 16); }

#define XB_TMO      128
#define XB_XCNT(j)  (256  + 64 * (j))
#define XB_XSUB(j)  (1280 + 64 * (j))
#define XB_XGEN(j)  (2304 + 64 * (j))
#define XB_TOP      3328
#define XB_TOPGEN   3392
#define XCD_BAR_WORDS 3456
#define XB_SPIN_CAP (1u << 18)

__device__ __forceinline__ unsigned xb_ld(unsigned* p)              { return __hip_atomic_load(p, __ATOMIC_RELAXED, __HIP_MEMORY_SCOPE_AGENT); }
__device__ __forceinline__ unsigned xb_add(unsigned* p, unsigned v) { return __hip_atomic_fetch_add(p, v, __ATOMIC_RELAXED, __HIP_MEMORY_SCOPE_AGENT); }
__device__ __forceinline__ unsigned xb_xcc_id() { return (unsigned)__builtin_amdgcn_s_getreg((3 << 11) | 20) & 0xFu; }
#define XB_SPIN(cond, bar) do { unsigned _sp = 0; while (cond) { __builtin_amdgcn_s_sleep(1); \
    if ((++_sp & 255u) == 0u) { if (xb_ld(&(bar)[XB_TMO])) break; if (_sp > XB_SPIN_CAP) { atomicAdd(&(bar)[XB_TMO], 1u); break; } } } } while (0)

struct XcdBarrier {
    unsigned* bar; unsigned x;
    volatile LAS unsigned* st;
};

__device__ __forceinline__ XcdBarrier xcd_barrier_post(unsigned* bar, volatile LAS unsigned* st) {
    XcdBarrier b; b.bar = bar; b.x = xb_xcc_id(); b.st = st;
    if (threadIdx.x == 0) (void)xb_add(&bar[XB_XCNT(b.x)], 1u);
    return b;
}
__device__ __forceinline__ void xcd_barrier_complete(unsigned* bar, unsigned x, unsigned& nloc, unsigned& nx) {
    const unsigned G = gridDim.x * gridDim.y * gridDim.z;
    unsigned sum, cnt, mine, sp = 0u;
    for (;;) {
        sum = 0u; cnt = 0u; mine = 0u;
#pragma unroll
        for (unsigned j = 0; j < 16; ++j) { const unsigned c = xb_ld(&bar[XB_XCNT(j)]); sum += c; cnt += (c > 0u) ? 1u : 0u; }
        if (sum == G) break;
        __builtin_amdgcn_s_sleep(1);
        if ((++sp & 255u) == 0u) { if (xb_ld(&bar[XB_TMO])) break; if (sp > XB_SPIN_CAP) { atomicAdd(&bar[XB_TMO], 1u); break; } }
    }
    mine = xb_ld(&bar[XB_XCNT(x)]);
    nloc = mine > 0u ? mine : 1u; nx = cnt > 0u ? cnt : 1u;
}

__device__ __forceinline__ void xcd_barrier(const XcdBarrier& b) {
    asm volatile("s_waitcnt vmcnt(0)" ::: "memory");
    __syncthreads();
    if (threadIdx.x == 0) {
        unsigned* bar = b.bar;
        __builtin_amdgcn_s_waitcnt(0);
        unsigned nloc = b.st[0], nx = b.st[1];
        if (nloc == 0u) { xcd_barrier_complete(bar, b.x, nloc, nx); b.st[0] = nloc; b.st[1] = nx; }
        const unsigned old = xb_add(&bar[XB_XSUB(b.x)], 1u);
        const unsigned gen = old / nloc;
        if (old + 1u == (gen + 1u) * nloc) {
            __builtin_amdgcn_fence(__ATOMIC_RELEASE, "agent");
            asm volatile("s_waitcnt vmcnt(0)" ::: "memory");
            const unsigned og = xb_add(&bar[XB_TOP], 1u);
            const unsigned tg = og / nx;
            if (og + 1u == (tg + 1u) * nx) xb_add(&bar[XB_TOPGEN], 1u);
            else XB_SPIN(xb_ld(&bar[XB_TOPGEN]) == tg, bar);
            __builtin_amdgcn_fence(__ATOMIC_ACQUIRE, "agent");
            xb_add(&bar[XB_XGEN(b.x)], 1u);
            asm volatile("s_waitcnt vmcnt(0)" ::: "memory");
        } else {
            XB_SPIN(xb_ld(&bar[XB_XGEN(b.x)]) == gen, bar);
            __builtin_amdgcn_fence(__ATOMIC_ACQUIRE, "agent");
            asm volatile("s_waitcnt vmcnt(0)" ::: "memory");
        }
    }
    __syncthreads();
}


struct Frame {
    LAS unsigned char* lds;
    volatile LAS unsigned* MISC;
    gu32* ctl;
    int tid, lane, wave;
    int vcu, G, gw;
};
__device__ __forceinline__ float wave_sum(float v) {
#pragma unroll
    for (int o = 1; o < 64; o <<= 1) v += __shfl_xor(v, o);
    return v;
}
__device__ __forceinline__ int phys_row(int lc) { return (lc & ~255) + 128 * ((lc >> 5) & 1) + 32 * ((lc >> 6) & 3) + (lc & 31); }
__device__ __forceinline__ void tr_item128(const float* W, int ldw, int c0, int nvalid, const float* gain, bf16* WT, int Kd, int lc0, int k0, int lane) {
    const int h = lane >> 5, c = lane & 31; const bool act = 4 * c < nvalid;
    if (act) { const int prow = phys_row(lc0 + 4 * c), kb = k0 + 32 * h;
#pragma unroll
        for (int half = 0; half < 2; ++half) { f32x4 v[16];
#pragma unroll
            for (int i = 0; i < 16; ++i) v[i] = W ? __builtin_nontemporal_load((const GAS f32x4*)(W + (size_t)(kb + 16 * half + i) * ldw + c0 + 4 * c)) : (f32x4){0.f, 0.f, 0.f, 0.f};
            if (gain) {
#pragma unroll
                for (int q = 0; q < 4; ++q) { const f32x4 gv = *(const GAS f32x4*)(gain + kb + 16 * half + 4 * q);
#pragma unroll
                    for (int e = 0; e < 4; ++e) v[4 * q + e] = v[4 * q + e] * gv[e]; } }
#pragma unroll
            for (int e = 0; e < 4; ++e) { v4u o0, o1;
                o0.x = pk2(v[0][e], v[1][e]); o0.y = pk2(v[2][e], v[3][e]); o0.z = pk2(v[4][e], v[5][e]); o0.w = pk2(v[6][e], v[7][e]);
                o1.x = pk2(v[8][e], v[9][e]); o1.y = pk2(v[10][e], v[11][e]); o1.z = pk2(v[12][e], v[13][e]); o1.w = pk2(v[14][e], v[15][e]);
                bf16* dst = WT + (size_t)(prow + e) * Kd + kb + 16 * half; *(GAS v4u*)dst = o0; *(GAS v4u*)(dst + 8) = o1; } } }
}
__device__ __forceinline__ void conv_seg(Frame& F, int& rot, const float* W, int ldw, int c0, int ncols, const float* gain, bf16* WT, int Kd, int lc0) {
    const int ng = (ncols + 127) / 128, nk = Kd / 64, nit = ng * nk, NGW = F.G * NWAVES;
    int it = F.gw - rot; if (it < 0) it += NGW;
    for (; it < nit; it += NGW) { const int g = it % ng, kb = it / ng; int nv = ncols - 128 * g; nv = nv > 128 ? 128 : nv;
        tr_item128(W, ldw, c0 + 128 * g, nv, gain, WT, Kd, lc0 + 128 * g, 64 * kb, F.lane); }
    rot = (rot + nit) % NGW;
}
__device__ __forceinline__ void p0_prologue(Frame& F) {
    int rot = 0;
#define ws wsp()
    const int NGW = F.G * NWAVES;
    { bf16* hb = (bf16*)(ws + WS_HB); float* ssq = (float*)(ws + WS_SSQH); const float* x = inp(0);
      for (int r = 2 * F.gw; r < M; r += 2 * NGW) { f32x4 v[2][4]; float s[2];
#pragma unroll
          for (int rr = 0; rr < 2; ++rr) { const GAS f32x4* xr = (const GAS f32x4*)(x + (size_t)(r + rr) * D) + F.lane;
#pragma unroll
              for (int j = 0; j < 4; ++j) v[rr][j] = __builtin_nontemporal_load(xr + 64 * j); }
#pragma unroll
          for (int rr = 0; rr < 2; ++rr) { float t = 0.f;
#pragma unroll
              for (int j = 0; j < 4; ++j) t += (v[rr][j].x * v[rr][j].x + v[rr][j].y * v[rr][j].y) + (v[rr][j].z * v[rr][j].z + v[rr][j].w * v[rr][j].w);
              s[rr] = wave_sum(t);
              GAS unsigned long long* o8 = (GAS unsigned long long*)(hb + (size_t)(r + rr) * D) + F.lane;
#pragma unroll
              for (int j = 0; j < 4; ++j) o8[64 * j] = (unsigned long long)pk2(v[rr][j].x, v[rr][j].y) | ((unsigned long long)pk2(v[rr][j].z, v[rr][j].w) << 32);
              if (F.lane < 16) ssq[(size_t)(r + rr) * 16 + F.lane] = F.lane == 0 ? s[rr] : 0.f; } } }
    { float* ct = (float*)(ws + WS_ROPE); float* st = ct + SEQ * 16;
      for (int e = F.vcu * 512 + F.tid; e < SEQ * 16; e += F.G * 512) { const int pos = e >> 4, i = e & 15;
          const double invd = i == 0 ? 1.0 : i == 1 ? 0.5623413251903491 : i == 2 ? 0.31622776601683794 : i == 3 ? 0.17782794100389226 : i == 4 ? 0.1 : i == 5 ? 0.056234132519034905 : i == 6 ? 0.03162277660168379 : i == 7 ? 0.01778279410038923 :
                              i == 8 ? 0.01 : i == 9 ? 0.005623413251903491 : i == 10 ? 0.003162277660168379 : i == 11 ? 0.001778279410038923 : i == 12 ? 0.001 : i == 13 ? 0.0005623413251903491 : i == 14 ? 0.00031622776601683794 : 0.00017782794100389227;
          const float angf = (float)pos * (float)invd; const double a = (double)angf;
          const double nq = __builtin_rint(a * 0.6366197723675814); const double r = (a - nq * 1.5707963267948966) - nq * 6.123233995736766e-17; const double r2 = r * r;
          const double sn = r * (1.0 + r2 * (-1.0 / 6 + r2 * (1.0 / 120 + r2 * (-1.0 / 5040 + r2 * (1.0 / 362880 + r2 * (-1.0 / 39916800 + r2 * (1.0 / 6227020800.0)))))));
          const double cs = 1.0 + r2 * (-0.5 + r2 * (1.0 / 24 + r2 * (-1.0 / 720 + r2 * (1.0 / 40320 + r2 * (-1.0 / 3628800 + r2 * (1.0 / 479001600.0 + r2 * (-1.0 / 87178291200.0)))))));
          const int q = (int)nq & 3; const double c = q == 0 ? cs : q == 1 ? -sn : q == 2 ? -cs : sn, s = q == 0 ? sn : q == 1 ? cs : q == 2 ? -sn : -cs;
          ct[e] = (float)c; st[e] = (float)s; } }
    for (int i = 0; i < 2; ++i) { const float* W = inp(3) + (size_t)i * D * A_IN; const float* g = inp(2) + i * D; bf16* WT = (bf16*)(ws + WS_WIN) + (size_t)i * WIN_ELEMS;
        conv_seg(F, rot, W, A_IN, 0, 1152, g, WT, D, 0);
        conv_seg(F, rot, W, A_IN, 1664, 64, g, WT, D, 1152);
        conv_seg(F, rot, W, A_IN, 1728, 8, g, WT, D, 1216);
        conv_seg(F, rot, nullptr, 0, 0, 56, nullptr, WT, D, 1224);
        conv_seg(F, rot, W, A_IN, 1152, 512, g, WT, D, 1280);
        conv_seg(F, rot, inp(6) + (size_t)i * D * D, D, 0, D, nullptr, (bf16*)(ws + WS_WOA) + (size_t)i * D * D, D, 0); }
    { bf16* WT = (bf16*)(ws + WS_WKVQ);
      conv_seg(F, rot, inp(8), 288, 0, 256, inp(7), WT, D, 0);
      conv_seg(F, rot, inp(13), QLORA, 0, QLORA, inp(12), WT, D, 256);
      conv_seg(F, rot, inp(8), 288, 256, 32, inp(7), WT, D, 640);
      conv_seg(F, rot, nullptr, 0, 0, 96, nullptr, WT, D, 672); }
    conv_seg(F, rot, inp(10), NUKV, 0, NUKV, inp(9), (bf16*)(ws + WS_WUKV), KVLORA, 0);
    { bf16* WT = (bf16*)(ws + WS_WDQ1);
      conv_seg(F, rot, inp(13) + (size_t)D * QLORA, QLORA, 0, QLORA, inp(12) + D, WT, D, 0);
      conv_seg(F, rot, nullptr, 0, 0, 128, nullptr, WT, D, 384); }
    for (int j = 0; j < 2; ++j) {
        conv_seg(F, rot, inp(15) + (size_t)j * QLORA * NUQ, NUQ, 0, NUQ, inp(14) + j * QLORA, (bf16*)(ws + WS_WUQ) + (size_t)j * WUQ_ELEMS, QLORA, 0);
        conv_seg(F, rot, inp(17) + (size_t)j * D * D, D, 0, D, nullptr, (bf16*)(ws + WS_WOB) + (size_t)j * D * D, D, 0); }
    for (int L = 0; L < 4; ++L) {
        conv_seg(F, rot, inp(19) + (size_t)L * D * FF, FF, 0, FF, inp(18) + L * D, (bf16*)(ws + WS_WUP) + (size_t)L * D * FF, D, 0);
        conv_seg(F, rot, inp(20) + (size_t)L * D * FF, D, 0, D, nullptr, (bf16*)(ws + WS_WDN) + (size_t)L * D * FF, FF, 0); }
#undef ws
}
namespace mla {
using bf16x8 = __attribute__((ext_vector_type(8))) short;
using s16x4  = __attribute__((ext_vector_type(4))) short;
using f32x16 = __attribute__((ext_vector_type(16))) float;
using u32x4  = __attribute__((ext_vector_type(4))) unsigned;
typedef __attribute__((address_space(3))) const char* lds_cptr;
typedef short v4i16_t __attribute__((ext_vector_type(4)));
constexpr int NW = 8, QBLK = 32, KVBLK = 64, LDQ = 1536, LDK = 96, LDV = 64, LDO = 1024, SEQL = 4096;
constexpr float SCALE = 0.10206207261596575f;
constexpr float THRL = 8.f;
constexpr int SHM_K = KVBLK * 96 * 2, SHM_V = KVBLK * 64 * 2;
constexpr int NSLOT = 5, SLOTB = SHM_K + SHM_V;
constexpr int LDS_OST = NSLOT * SLOTB, LDS_WS = LDS_OST + NW * 4096;
constexpr int SHM_ATTN = LDS_WS + NW * 256;
#define SBAR() __builtin_amdgcn_sched_barrier(0)
#define PIN(x) asm volatile("" : "+v"(x))
#define MFMA(a, b, c) __builtin_amdgcn_mfma_f32_32x32x16_bf16((a), (b), (c), 0, 0, 0)
__device__ __forceinline__ int crow(int r, int hi) { return (r & 3) + 8 * (r >> 2) + 4 * hi; }
__device__ __forceinline__ unsigned cvtpk(float lo, float hi) { return pg8::cvt_pk_bf16(lo, hi); }
__device__ __forceinline__ float bf2f(short s) { return __uint_as_float(((unsigned)(unsigned short)s) << 16); }
__device__ __forceinline__ void kload2(bf16x8* kf, lds_cptr kp, int d0) { kf[2 * d0] = *(const __attribute__((address_space(3))) bf16x8*)(kp + d0 * 2048); kf[2 * d0 + 1] = *(const __attribute__((address_space(3))) bf16x8*)(kp + d0 * 2048 + 512); }
__device__ __forceinline__ s16x4 vtr(lds_cptr p) { return __builtin_bit_cast(s16x4, __builtin_amdgcn_ds_read_tr16_b64_v4i16((__attribute__((address_space(3))) v4i16_t*)p)); }
#define MX3(a, b, c) __builtin_fmaxf(__builtin_fmaxf((a), (b)), (c))
__device__ __forceinline__ float rowmax(const f32x16& p0, const f32x16& p1) {
  float a = MX3(p0[0], p0[1], p1[0]), b = MX3(p0[2], p0[3], p1[1]); a = MX3(a, p1[2], p1[3]);
#pragma unroll
  for (int r = 4; r < 16; r += 4) { a = MX3(a, p0[r], p0[r + 1]); b = MX3(b, p0[r + 2], p0[r + 3]); a = MX3(a, p1[r], p1[r + 1]); b = MX3(b, p1[r + 2], p1[r + 3]); }
  float m = __builtin_fmaxf(a, b); auto rr = __builtin_amdgcn_permlane32_swap(__float_as_uint(m), __float_as_uint(m), false, false);
  return __builtin_fmaxf(__uint_as_float(rr[0]), __uint_as_float(rr[1])); }

__device__ __forceinline__ void attn_unit(const pg8::bf16_t* __restrict__ Qh, const pg8::bf16_t* __restrict__ Kh, const pg8::bf16_t* __restrict__ Vh, pg8::bf16_t* __restrict__ Oh,
                                          const float* __restrict__ qgain, const float* __restrict__ cosT, const float* __restrict__ sinT, int qb, char* lds,
                                          const pg8::bf16_t* __restrict__ Kn, const pg8::bf16_t* __restrict__ Vn, bool pre, int& ring) {
  int tid_ = threadIdx.x; asm volatile("" : "+v"(tid_));
  const int tid = tid_, wid = __builtin_amdgcn_readfirstlane(tid >> 6), lane = tid & 63, r32 = lane & 31, hi = lane >> 5;
  float* wsf = (float*)(lds + LDS_WS) + wid * 64;
  float m_reg = 0.f, l_reg = 0.f; f32x16 o[2]; o[0] = f32x16{}; o[1] = f32x16{}; bf16x8 qr[6];
  f32x16 negm = f32x16{}; PIN(negm);
  const int q0 = qb * 256, qrow = q0 + wid * QBLK + r32;
  const int NT = 4 * qb + 4, cqw = 4 * qb + (wid >> 1);
  const unsigned kvo0 = (unsigned)(lane * (LDK * 2) + wid * 16), kvo1 = (unsigned)(lane * (LDK * 2) + (8 + (wid & 3)) * 16);
  const unsigned vvo = (unsigned)((16 * (wid & 3) + (lane >> 2)) * (LDV * 2) + (wid >> 2) * 64 + (lane & 3) * 16);
  const unsigned lds0 = (unsigned)(uintptr_t)lds;
#define DMA(t, sl) do { const bool nx_ = (t) >= NT && Kn != nullptr; const int tt_ = (t) < NT ? (t) : (nx_ ? (t) - NT : NT - 1); const unsigned sl_ = lds0 + (sl);     \
    const char* kb_ = (const char*)(nx_ ? Kn : Kh) + (size_t)tt_ * (KVBLK * LDK * 2); const char* vb_ = (const char*)(nx_ ? Vn : Vh) + (size_t)tt_ * (KVBLK * LDV * 2);  \
    pg8::pg8_glds16(kb_, kvo0, sl_ + wid * 1024); pg8::pg8_glds16(kb_, kvo1, sl_ + (8 + (wid & 3)) * 1024); pg8::pg8_glds16(vb_, vvo, sl_ + SHM_K + wid * 1024); } while (0)
#define VMWAIT(n) asm volatile("s_waitcnt vmcnt(" #n ")" ::: "memory")
#define BAR() __builtin_amdgcn_s_barrier()
  const lds_cptr vp0 = (lds_cptr)lds + SHM_K + ((lane >> 4) & 1) * 32 + (lane & 3) * 8 + (4 * hi + ((lane & 15) >> 2)) * 64;
  const lds_cptr kp0 = (lds_cptr)lds + hi * 1024 + r32 * 16;
#define WRAP(x) ((x) >= NSLOT * SLOTB ? (x) - NSLOT * SLOTB : (x))
  const int s0_ = ring, s1_ = WRAP(s0_ + SLOTB), s2_ = WRAP(s1_ + SLOTB), s3_ = WRAP(s2_ + SLOTB), s4_ = WRAP(s3_ + SLOTB);
  if (!pre) { DMA(0, s0_); DMA(1, s1_); DMA(2, s2_); }
  {
    const pg8::bf16_t* Qw = Qh + (size_t)qrow * LDQ + hi * 8; float qf[6][8]; float ss = 0.f;
#pragma unroll
    for (int d0 = 0; d0 < 6; ++d0) { const bf16x8 raw = *reinterpret_cast<const bf16x8*>(Qw + d0 * 16);
#pragma unroll
      for (int j = 0; j < 8; ++j) { qf[d0][j] = bf2f(raw[j]); ss += qf[d0][j] * qf[d0][j]; } }
    { auto rr = __builtin_amdgcn_permlane32_swap(__float_as_uint(ss), __float_as_uint(ss), false, false); ss = __uint_as_float(rr[0]) + __uint_as_float(rr[1]); }
    const float rq = __builtin_amdgcn_rsqf(ss * (1.f / 96.f) + 1e-6f);
#pragma unroll
    for (int d0 = 0; d0 < 6; ++d0)
#pragma unroll
      for (int j = 0; j < 8; ++j) qf[d0][j] *= (rq * (SCALE * 1.4426950408889634f)) * qgain[d0 * 16 + hi * 8 + j];
#pragma unroll
    for (int j = 0; j < 8; ++j) { const float c = cosT[qrow * 16 + hi * 8 + j], s = sinT[qrow * 16 + hi * 8 + j]; const float x1 = qf[4][j], x2 = qf[5][j];
      qf[4][j] = x1 * c - x2 * s; qf[5][j] = x2 * c + x1 * s; }
#pragma unroll
    for (int d0 = 0; d0 < 6; ++d0) { u32x4 w = {cvtpk(qf[d0][0], qf[d0][1]), cvtpk(qf[d0][2], qf[d0][3]), cvtpk(qf[d0][4], qf[d0][5]), cvtpk(qf[d0][6], qf[d0][7])}; qr[d0] = __builtin_bit_cast(bf16x8, w); }
  }
  bool resc = false;
  f32x16 pA0, pA1, pB0, pB1; bf16x8 kf[12]; s16x4 vlo[4], vhi[4]; u32x4 pw0, pw1, pw2, pw3;
  int sl_prev = s0_, sl_cur = s1_, sl_next = s2_;
#define ROT() do { sl_prev = sl_cur; sl_cur = sl_next; sl_next = (sl_next == (NSLOT - 1) * SLOTB) ? 0 : sl_next + SLOTB; } while (0)
#define EX(v) __builtin_amdgcn_exp2f(v)
#define RESC() do { if (resc) { _Pragma("unroll") for (int d_ = 0; d_ < 2; ++d_) _Pragma("unroll") for (int r = 0; r < 16; ++r) o[d_][r] *= wsf[crow(r, hi)]; } } while (0)
#define DECIDE(C0, C1) do { const float pm_ = rowmax(C0, C1); resc = false;                                                              \
    if (__builtin_expect(__any(pm_ > THRL), 0)) { const float dl = __builtin_fmaxf(pm_, 0.f); m_reg += dl; const float nm_ = -m_reg;      \
      asm volatile("s_nop 15\n\ts_nop 7" ::: "memory");           \
      _Pragma("unroll") for (int r = 0; r < 16; ++r) { float a_ = C0[r], b_ = C1[r], c_ = negm[r];               \
        asm volatile("v_sub_f32 %0, %0, %3\n\tv_sub_f32 %1, %1, %3\n\tv_mov_b32 %2, %4" : "+v"(a_), "+v"(b_), "+v"(c_) : "v"(dl), "v"(nm_)); C0[r] = a_; C1[r] = b_; negm[r] = c_; } \
      const float f = __builtin_amdgcn_exp2f(-dl); l_reg *= f; if (hi == 0) wsf[r32] = f; resc = true; }                                  \
    PIN(negm); } while (0)
  VMWAIT(0); BAR();
  DMA(3, s3_);
  _Pragma("unroll") for (int d0 = 0; d0 < 6; ++d0) kload2(kf, kp0 + s0_, d0);
  pA0 = MFMA(kf[0], qr[0], negm); pA1 = MFMA(kf[1], qr[0], negm);
  _Pragma("unroll") for (int d0 = 1; d0 < 6; ++d0) { pA0 = MFMA(kf[2 * d0], qr[d0], pA0); pA1 = MFMA(kf[2 * d0 + 1], qr[d0], pA1); }
  DECIDE(pA0, pA1);
  _Pragma("unroll") for (int r = 0; r < 16; ++r) pA0[r] = EX(pA0[r]);
  _Pragma("unroll") for (int r = 0; r < 8; ++r) pA1[r] = EX(pA1[r]);
  _Pragma("unroll") for (int d0 = 0; d0 < 3; ++d0) kload2(kf, kp0 + s1_, d0);
  BAR(); RESC();
  DMA(4, s4_);
#define PKW(P, i) cvtpk(P[i], P[i + 1])
#define PAF(k) __builtin_bit_cast(bf16x8, pw##k)
#define VFR(s) (bf16x8){vlo[s][0], vlo[s][1], vlo[s][2], vlo[s][3], vhi[s][0], vhi[s][1], vhi[s][2], vhi[s][3]}
#define VRD(s, i) do { vlo[s] = vtr(vp_ + (((i) >> 2) * 4096 + ((i) & 3) * 1024)); vhi[s] = vtr(vp_ + (((i) >> 2) * 4096 + ((i) & 3) * 1024 + 512)); } while (0)
#define KRDN(d0) do { kload2(kf, kp0 + sl_next, d0); SBAR(); } while (0)
#define KRDC(d0) do { kload2(kf, kp0 + sl_cur, d0); SBAR(); } while (0)
#define STEP(C0, C1, P0, P1, t) do { SBAR(); const lds_cptr vp_ = vp0 + sl_prev; float sacc = 0.f; \
    KRDC(3); C0 = MFMA(kf[0], qr[0], negm); P1[8] = EX(P1[8]); PIN(P1); sacc += P0[0]; sacc += P0[1]; sacc += P0[2]; pw0[0] = PKW(P0, 0); PIN(pw0); PIN(sacc); SBAR(); \
    KRDC(4); C1 = MFMA(kf[1], qr[0], negm); P1[9] = EX(P1[9]); PIN(P1); sacc += P0[3]; sacc += P0[4]; sacc += P0[5]; pw0[1] = PKW(P0, 2); PIN(pw0); PIN(sacc); SBAR(); \
    KRDC(5); C0 = MFMA(kf[2], qr[1], C0); P1[10] = EX(P1[10]); PIN(P1); sacc += P0[6]; sacc += P0[7]; sacc += P0[8]; pw0[2] = PKW(P0, 4); pw2[0] = PKW(P1, 0); PIN(pw0); PIN(pw2); PIN(sacc); SBAR(); \
    C1 = MFMA(kf[3], qr[1], C1); P1[11] = EX(P1[11]); PIN(P1); sacc += P0[9]; sacc += P0[10]; sacc += P0[11]; pw0[3] = PKW(P0, 6); pw2[1] = PKW(P1, 2); PIN(pw0); PIN(pw2); PIN(sacc); SBAR(); \
    C0 = MFMA(kf[4], qr[2], C0); P1[12] = EX(P1[12]); PIN(P1); sacc += P0[12]; sacc += P0[13]; sacc += P0[14]; pw1[0] = PKW(P0, 8); pw2[2] = PKW(P1, 4); PIN(pw1); PIN(pw2); PIN(sacc); SBAR(); \
    C1 = MFMA(kf[5], qr[2], C1); P1[13] = EX(P1[13]); PIN(P1); sacc += P0[15]; sacc += P1[0]; sacc += P1[1]; pw1[1] = PKW(P0, 10); pw2[3] = PKW(P1, 6); PIN(pw1); PIN(pw2); PIN(sacc); SBAR(); \
    C0 = MFMA(kf[6], qr[3], C0); P1[14] = EX(P1[14]); PIN(P1); sacc += P1[2]; sacc += P1[3]; sacc += P1[4]; pw1[2] = PKW(P0, 12); PIN(pw1); PIN(sacc); SBAR(); \
    C1 = MFMA(kf[7], qr[3], C1); P1[15] = EX(P1[15]); PIN(P1); sacc += P1[5]; sacc += P1[6]; sacc += P1[7]; pw1[3] = PKW(P0, 14); PIN(pw1); PIN(sacc); SBAR(); \
    VRD(0, 0); SBAR(); C0 = MFMA(kf[8], qr[4], C0); sacc += P1[8]; sacc += P1[9]; sacc += P1[10]; pw3[0] = PKW(P1, 8); PIN(pw3); PIN(sacc); SBAR(); \
    VRD(1, 4); SBAR(); C1 = MFMA(kf[9], qr[4], C1); sacc += P1[11]; sacc += P1[12]; sacc += P1[13]; pw3[1] = PKW(P1, 10); PIN(pw3); PIN(sacc); SBAR(); \
    VRD(2, 1); SBAR(); C0 = MFMA(kf[10], qr[5], C0); sacc += P1[14]; sacc += P1[15]; pw3[2] = PKW(P1, 12); PIN(pw3); PIN(sacc); SBAR(); \
    VRD(3, 5); SBAR(); C1 = MFMA(kf[11], qr[5], C1); pw3[3] = PKW(P1, 14); PIN(pw3); PIN(sacc); SBAR(); \
    l_reg += sacc; \
    if ((t) > cqw) { asm volatile("" ::: "memory"); _Pragma("unroll") for (int r = 0; r < 16; ++r) { C0[r] = -1e30f; C1[r] = -1e30f; } PIN(C0); PIN(C1); }     \
    DECIDE(C0, C1); SBAR(); \
    o[0] = MFMA(PAF(0), VFR(0), o[0]); VRD(0, 2); C0[0] = EX(C0[0]); C0[1] = EX(C0[1]); C0[2] = EX(C0[2]); PIN(C0); SBAR(); \
    KRDN(0); o[1] = MFMA(PAF(0), VFR(1), o[1]); VRD(1, 6); C0[3] = EX(C0[3]); C0[4] = EX(C0[4]); C0[5] = EX(C0[5]); PIN(C0); SBAR(); \
    o[0] = MFMA(PAF(1), VFR(2), o[0]); VRD(2, 3); C0[6] = EX(C0[6]); C0[7] = EX(C0[7]); C0[8] = EX(C0[8]); PIN(C0); SBAR(); \
    KRDN(1); o[1] = MFMA(PAF(1), VFR(3), o[1]); VRD(3, 7); C0[9] = EX(C0[9]); C0[10] = EX(C0[10]); C0[11] = EX(C0[11]); PIN(C0); SBAR(); \
    o[0] = MFMA(PAF(2), VFR(0), o[0]); C0[12] = EX(C0[12]); C0[13] = EX(C0[13]); C0[14] = EX(C0[14]); PIN(C0); SBAR(); \
    KRDN(2); o[1] = MFMA(PAF(2), VFR(1), o[1]); C0[15] = EX(C0[15]); C1[0] = EX(C1[0]); C1[1] = EX(C1[1]); PIN(C0); PIN(C1); SBAR(); \
    o[0] = MFMA(PAF(3), VFR(2), o[0]); C1[2] = EX(C1[2]); C1[3] = EX(C1[3]); C1[4] = EX(C1[4]); PIN(C0); PIN(C1); SBAR(); \
    o[1] = MFMA(PAF(3), VFR(3), o[1]); C1[5] = EX(C1[5]); C1[6] = EX(C1[6]); C1[7] = EX(C1[7]); PIN(C0); PIN(C1); SBAR(); \
    } while (0)
  for (int t = 1; t + 1 < NT; t += 2) {
    STEP(pB0, pB1, pA0, pA1, t);     VMWAIT(3); BAR(); RESC(); DMA(t + 4, sl_prev); ROT();
    STEP(pA0, pA1, pB0, pB1, t + 1); VMWAIT(3); BAR(); RESC(); DMA(t + 5, sl_prev); ROT();
  }
  STEP(pB0, pB1, pA0, pA1, NT - 1); RESC();
  { _Pragma("unroll") for (int r = 8; r < 16; ++r) pB1[r] = EX(pB1[r]);
    float sacc = 0.f;
#pragma unroll
    for (int r = 0; r < 16; ++r) sacc += pB0[r];
#pragma unroll
    for (int r = 0; r < 16; ++r) sacc += pB1[r];
    l_reg += sacc;
    pw0 = (u32x4){PKW(pB0, 0), PKW(pB0, 2), PKW(pB0, 4), PKW(pB0, 6)}; pw1 = (u32x4){PKW(pB0, 8), PKW(pB0, 10), PKW(pB0, 12), PKW(pB0, 14)};
    pw2 = (u32x4){PKW(pB1, 0), PKW(pB1, 2), PKW(pB1, 4), PKW(pB1, 6)}; pw3 = (u32x4){PKW(pB1, 8), PKW(pB1, 10), PKW(pB1, 12), PKW(pB1, 14)};
    const lds_cptr vp_ = vp0 + sl_cur;
    VRD(0, 0); VRD(1, 4); VRD(2, 1); VRD(3, 5);
    o[0] = MFMA(PAF(0), VFR(0), o[0]); o[1] = MFMA(PAF(0), VFR(1), o[1]); o[0] = MFMA(PAF(1), VFR(2), o[0]); o[1] = MFMA(PAF(1), VFR(3), o[1]);
    VRD(0, 2); VRD(1, 6); VRD(2, 3); VRD(3, 7);
    o[0] = MFMA(PAF(2), VFR(0), o[0]); o[1] = MFMA(PAF(2), VFR(1), o[1]); o[0] = MFMA(PAF(3), VFR(2), o[0]); o[1] = MFMA(PAF(3), VFR(3), o[1]); }
  { auto rr = __builtin_amdgcn_permlane32_swap(__float_as_uint(l_reg), __float_as_uint(l_reg), false, false); l_reg = __uint_as_float(rr[0]) + __uint_as_float(rr[1]); }
  if (hi == 0) wsf[32 + r32] = l_reg; asm volatile("s_waitcnt lgkmcnt(0)" ::: "memory");
  float rli[16];
#pragma unroll
  for (int r = 0; r < 16; ++r) rli[r] = __builtin_amdgcn_rcpf(wsf[32 + crow(r, hi)]);
  pg8::bf16_t* Ow = Oh + (size_t)(q0 + wid * QBLK) * LDO; unsigned short* stg = (unsigned short*)(lds + LDS_OST) + wid * 2048;
#pragma unroll
  for (int r = 0; r < 16; ++r) { const int orow = crow(r, hi);
#pragma unroll
    for (int d0 = 0; d0 < 2; ++d0) stg[orow * 64 + d0 * 32 + r32] = (unsigned short)(cvtpk(o[d0][r] * rli[r], 0.f) & 0xffffu); }
  asm volatile("s_waitcnt lgkmcnt(0)" ::: "memory");
#pragma unroll
  for (int i = 0; i < 4; ++i) { const int row = i * 8 + (lane >> 3), ch = lane & 7; *(u32x4*)(Ow + (size_t)row * LDO + ch * 8) = *(const u32x4*)(stg + row * 64 + ch * 8); }
  ring = sl_next;
  asm volatile("s_waitcnt vmcnt(0) lgkmcnt(0)" ::: "memory"); BAR();
#undef DMA
#undef WRAP
#undef VMWAIT
#undef BAR
#undef ROT
#undef EX
#undef RESC
#undef DECIDE
#undef PKW
#undef PAF
#undef VFR
#undef VRD
#undef KRDN
#undef KRDC
#undef STEP
}
#undef SBAR
#undef PIN
#undef MFMA
#undef MX3
}

namespace dsa {
using bf16x8 = __attribute__((ext_vector_type(8))) short;
using s16x4  = __attribute__((ext_vector_type(4))) short;
using f32x4  = __attribute__((ext_vector_type(4))) float;
using u32x4  = __attribute__((ext_vector_type(4))) unsigned;
using u32x2  = __attribute__((ext_vector_type(2))) unsigned;
typedef unsigned short bf16_t;
constexpr int L_LIST = 0, L_BIAS = 16384, L_U = 18432, L_END = L_U + 131072;
constexpr float LOG2E = 1.4426950408889634f;
constexpr unsigned INVALID_ENTRY = 0x003f0000u;
__device__ __forceinline__ void glds16v(const void* gsrc, unsigned lds_dst) { unsigned keep;
    asm volatile("s_mov_b32 %0, m0\n\ts_mov_b32 m0, %2\n\ts_nop 0\n\tglobal_load_lds_dwordx4 %1, off\n\ts_mov_b32 m0, %0" : "=&s"(keep) : "v"(gsrc), "s"(lds_dst) : "memory"); }
__device__ __forceinline__ int t5_bucket(int rel) {
    const int n = rel < 0 ? -rel : rel; int b = n;
    if (n >= 8) { const int e = 31 - __builtin_clz(n); int v = 8 + 2 * (e - 3) + ((n * n) >= (2 << (2 * e)) ? 1 : 0); b = v > 15 ? 15 : v; }
    return b + (rel > 0 ? 16 : 0);
}
template <int OFF> __device__ __forceinline__ s16x4 trrdo(unsigned addr) { s16x4 r; asm volatile("ds_read_b64_tr_b16 %0, %1 offset:%2" : "=v"(r) : "v"(addr), "i"(OFF) : "memory"); return r; }
#define DSA_DPP(v, ctrl) __builtin_amdgcn_update_dpp(0, (v), (ctrl), 0xf, 0xf, true)
__device__ __forceinline__ int half_sum(int v) { v += DSA_DPP(v, 0xB1); v += DSA_DPP(v, 0x4E); v += DSA_DPP(v, 0x141); v += DSA_DPP(v, 0x140);
    auto r = __builtin_amdgcn_permlane16_swap((unsigned)v, (unsigned)v, false, false); return (int)(r[0] + r[1]); }
__device__ __forceinline__ float half_min(float x) { int v = __float_as_int(x);
#define DSA_STEP(ctrl) v = __float_as_int(fminf(__int_as_float(v), __int_as_float(DSA_DPP(v, ctrl))))
    DSA_STEP(0xB1); DSA_STEP(0x4E); DSA_STEP(0x141); DSA_STEP(0x140);
#undef DSA_STEP
    auto r = __builtin_amdgcn_permlane16_swap((unsigned)v, (unsigned)v, false, false); return fminf(__uint_as_float(r[0]), __uint_as_float(r[1])); }
__device__ __forceinline__ float half_max(float x) { int v = __float_as_int(x);
#define DSA_STEP(ctrl) v = __float_as_int(fmaxf(__int_as_float(v), __int_as_float(DSA_DPP(v, ctrl))))
    DSA_STEP(0xB1); DSA_STEP(0x4E); DSA_STEP(0x141); DSA_STEP(0x140);
#undef DSA_STEP
    auto r = __builtin_amdgcn_permlane16_swap((unsigned)v, (unsigned)v, false, false); return fmaxf(__uint_as_float(r[0]), __uint_as_float(r[1])); }
__device__ __forceinline__ void cnt4(int& cnt, float a, float b, float c, float d, float thr) {
    unsigned long long m0, m1, m2, m3;
    asm("v_cmp_gt_f32_e64 %1, %5, %9\n\tv_cmp_gt_f32_e64 %2, %6, %9\n\tv_cmp_gt_f32_e64 %3, %7, %9\n\tv_cmp_gt_f32_e64 %4, %8, %9\n\t"
        "v_addc_co_u32_e64 %0, %1, %0, 0, %1\n\tv_addc_co_u32_e64 %0, %2, %0, 0, %2\n\tv_addc_co_u32_e64 %0, %3, %0, 0, %3\n\tv_addc_co_u32_e64 %0, %4, %0, 0, %4"
        : "+v"(cnt), "=&s"(m0), "=&s"(m1), "=&s"(m2), "=&s"(m3) : "v"(a), "v"(b), "v"(c), "v"(d), "v"(thr));
}
using f32x2 = __attribute__((ext_vector_type(2))) float;
#define QNAN __builtin_nanf("")
__device__ __forceinline__ void cntp4(f32x2& ca, f32x2& cb, f32x2 s0, f32x2 s1, f32x2 s2, f32x2 s3, f32x2 big, f32x2 ntb) {
    f32x2 c0, c1, c2, c3;
    asm("v_pk_fma_f32 %2, %6, %10, %11 clamp\n\tv_pk_fma_f32 %3, %7, %10, %11 clamp\n\tv_pk_fma_f32 %4, %8, %10, %11 clamp\n\tv_pk_fma_f32 %5, %9, %10, %11 clamp\n\t"
        "v_pk_add_f32 %0, %0, %2\n\tv_pk_add_f32 %1, %1, %3\n\tv_pk_add_f32 %0, %0, %4\n\tv_pk_add_f32 %1, %1, %5"
        : "+v"(ca), "+v"(cb), "=&v"(c0), "=&v"(c1), "=&v"(c2), "=&v"(c3) : "v"(s0), "v"(s1), "v"(s2), "v"(s3), "v"(big), "v"(ntb)); }
__device__ __forceinline__ void selmap4(unsigned& map, float a, float b, float c, float d, float thr) {
    unsigned long long m0, m1, m2, m3;
    asm("v_cmp_gt_f32_e64 %1, %5, %9\n\tv_cmp_gt_f32_e64 %2, %6, %9\n\tv_cmp_gt_f32_e64 %3, %7, %9\n\tv_cmp_gt_f32_e64 %4, %8, %9\n\t"
        "v_addc_co_u32_e64 %0, %1, %0, %0, %1\n\tv_addc_co_u32_e64 %0, %2, %0, %0, %2\n\tv_addc_co_u32_e64 %0, %3, %0, %0, %3\n\tv_addc_co_u32_e64 %0, %4, %0, %0, %4"
        : "+v"(map), "=&s"(m0), "=&s"(m1), "=&s"(m2), "=&s"(m3) : "v"(a), "v"(b), "v"(c), "v"(d), "v"(thr));
}
#define DSA_LAS __attribute__((address_space(3)))
#define RELU(x) __builtin_amdgcn_fmed3f((x), 0.f, 3.0e38f)

__device__ __forceinline__ void dsa_pass(const bf16_t* __restrict__ Q, const bf16_t* __restrict__ QI, const bf16_t* __restrict__ K, const bf16_t* __restrict__ V, const bf16_t* __restrict__ KI,
                                         const float* __restrict__ WI, bf16_t* __restrict__ O, int b, int c, int pass, bool pre, bool pf, DSA_LAS unsigned char* lds) {
    int tid_ = threadIdx.x; asm volatile("" : "+v"(tid_));
    const int tid = tid_, wid = __builtin_amdgcn_readfirstlane(tid >> 6), lane = tid & 63, kl = lane & 15, g = lane >> 4, half = lane >> 5;
    const unsigned ldsb = (unsigned)(unsigned long long)lds;
    const size_t rb = (size_t)b * 4096;
    const int tw = 64 * c + 16 * pass + 2 * wid;
    DSA_LAS unsigned* list = (DSA_LAS unsigned*)(lds + L_LIST + wid * 2048);
    const DSA_LAS float* biasT = (const DSA_LAS float*)(lds + L_BIAS);
    const int nadm = 64 * (c + 1), ncnt = nadm < 256 ? nadm : 256;
    const int srow = 16 * wid + (lane >> 3), lch = (lane & 7) ^ ((srow >> 1) & 7);
    const bf16_t* kisrc = KI + (rb + srow) * 64 + lch * 8;
    const unsigned kidst = ldsb + L_U + wid * 2048;
    const bf16_t* kisrc2 = KI + (rb + srow + 8) * 64 + (lch ^ 4) * 8;
#define DSA_KIDMA(T_) do { glds16v(kisrc + (size_t)(T_) * 8192, kidst + ((T_) & 3) * 16384); glds16v(kisrc2 + (size_t)(T_) * 8192, kidst + ((T_) & 3) * 16384 + 1024); } while (0)
    if (c < 4) { if (pf) { DSA_KIDMA(0); DSA_KIDMA(1); } }
    if (c >= 4) {
        f32x2 sc2[64];
#define SC(j) sc2[(j) >> 1][(j) & 1]
#pragma unroll
        for (int j = 0; j < 64; ++j) sc2[j] = (f32x2){QNAN, QNAN};
        bf16x8 aq0, aq1; f32x4 w4;
        { const bf16_t* qp = QI + (rb + tw + (kl >> 3)) * 512 + (kl & 7) * 64 + 8 * g; aq0 = *(const bf16x8*)qp; aq1 = *(const bf16x8*)(qp + 32);
          w4 = *(const f32x4*)(WI + (rb + tw + (g >> 1)) * 8 + 4 * (g & 1)); }
        const int rd0 = kl * 128 + ((g ^ ((kl >> 1) & 7)) << 4), rd1 = rd0 ^ 64;
        const int nt = (c + 2) >> 1;
        if (!pre) { DSA_KIDMA(0); DSA_KIDMA(1); }
#pragma unroll
        for (int T = 0; T < 32; ++T) {
            if (T < nt) {
                if ((T & 1) == 0) {
                    asm volatile("s_waitcnt vmcnt(0)" ::: "memory");
                    __builtin_amdgcn_s_barrier(); asm volatile("" ::: "memory");
                    if (T + 2 < nt) DSA_KIDMA(T + 2);
                    if (T + 3 < nt) DSA_KIDMA(T + 3); }
                const DSA_LAS unsigned char* kb = lds + L_U + (T & 3) * 16384;
                bf16x8 fb[8]; f32x4 acc[4], acd[4];
#define DSA_RD(H) _Pragma("unroll") for (int st = 0; st < 4; ++st) { fb[2 * st] = *(const DSA_LAS bf16x8*)(kb + rd0 + (4 * (H) + st) * 2048); fb[2 * st + 1] = *(const DSA_LAS bf16x8*)(kb + rd1 + (4 * (H) + st) * 2048); }
#define DSA_MM(A) _Pragma("unroll") for (int st = 0; st < 4; ++st) A[st] = __builtin_amdgcn_mfma_f32_16x16x32_bf16(aq0, fb[2 * st], (f32x4){0.f, 0.f, 0.f, 0.f}, 0, 0, 0); \
                  _Pragma("unroll") for (int st = 0; st < 4; ++st) A[st] = __builtin_amdgcn_mfma_f32_16x16x32_bf16(aq1, fb[2 * st + 1], A[st], 0, 0, 0);
#define DSA_WS(A, H) _Pragma("unroll") for (int pr = 0; pr < 2; ++pr) { float ps[2]; \
                    _Pragma("unroll") for (int s2 = 0; s2 < 2; ++s2) { const f32x4 a = A[2 * pr + s2]; ps[s2] = (w4[0] * RELU(a[0]) + w4[1] * RELU(a[1])) + (w4[2] * RELU(a[2]) + w4[3] * RELU(a[3])); } \
                    auto r = __builtin_amdgcn_permlane16_swap(__float_as_uint(ps[0]), __float_as_uint(ps[1]), false, false); SC(4 * T + 2 * (H) + pr) = __uint_as_float(r[0]) + __uint_as_float(r[1]); }
                DSA_RD(0) __builtin_amdgcn_sched_barrier(0);
                DSA_MM(acc) __builtin_amdgcn_sched_barrier(0);
                DSA_RD(1) __builtin_amdgcn_sched_barrier(0);
                DSA_WS(acc, 0) __builtin_amdgcn_sched_barrier(0);
                DSA_MM(acd) __builtin_amdgcn_sched_barrier(0);
                DSA_WS(acd, 1) __builtin_amdgcn_sched_barrier(0);
#undef DSA_RD
#undef DSA_MM
#undef DSA_WS
                asm volatile("s_waitcnt lgkmcnt(0)" ::: "memory");
            }
        }
        __builtin_amdgcn_s_barrier();
        if (pf) { DSA_KIDMA(0); DSA_KIDMA(1); }
        if ((c & 1) == 0) {
#pragma unroll
            for (int T = 0; T < 32; ++T) if (T == nt - 1) sc2[2 * T + 1] = (f32x2){QNAN, QNAN};
        }
        const int nregs = 4 * nt;
        float mn = 3.0e38f, mx = -3.0e38f, mnb = 3.0e38f, mxb = -3.0e38f;
#pragma unroll
        for (int blk = 0; blk < 8; ++blk) if (16 * blk < nregs) {
#pragma unroll
            for (int jj = 0; jj < 8; jj += 2) { const f32x2 a = sc2[8 * blk + jj], b2 = sc2[8 * blk + jj + 1];
                asm("v_min3_f32 %0, %0, %1, %2" : "+v"(mn) : "v"(a[0]), "v"(a[1])); asm("v_max3_f32 %0, %0, %1, %2" : "+v"(mx) : "v"(a[0]), "v"(a[1]));
                asm("v_min3_f32 %0, %0, %1, %2" : "+v"(mnb) : "v"(b2[0]), "v"(b2[1])); asm("v_max3_f32 %0, %0, %1, %2" : "+v"(mxb) : "v"(b2[0]), "v"(b2[1])); } }
        mn = fminf(mn, mnb); mx = fmaxf(mx, mxb);
        mn = half_min(mn); mx = half_max(mx);
        constexpr float BIGF = 1.2676506002282294e30f;
        f32x2 big2 = {BIGF, BIGF}; asm volatile("" : "+v"(big2));
        float lo[2], hi[2], thr[2], tie[2], clo[2]; int chi[2], need[2]; bool done[2];
#pragma unroll
        for (int q = 0; q < 2; ++q) { lo[q] = __int_as_float(__builtin_amdgcn_readlane(__float_as_int(mn), 32 * q)) - 1.0f; hi[q] = __int_as_float(__builtin_amdgcn_readlane(__float_as_int(mx), 32 * q));
            chi[q] = 0; clo[q] = (float)((c + 1) * 64); need[q] = 0; done[q] = false; thr[q] = hi[q]; tie[q] = __builtin_nanf(""); }
        for (int it = 0; it < 76; ++it) {
            if (done[0] && done[1]) break;
            float mid[2];
#pragma unroll
            for (int q = 0; q < 2; ++q) { mid[q] = 0.5f * lo[q] + 0.5f * hi[q];
                if (it >= 3 && it < 12) { float f = (clo[q] - 256.f) * __builtin_amdgcn_rcpf(clo[q] - (float)chi[q]); f = __builtin_fminf(__builtin_fmaxf(f, 0.0625f), 0.9375f);
                    const float im = lo[q] + (hi[q] - lo[q]) * f; if (im > lo[q] && im < hi[q]) mid[q] = im; }
                if (!done[q] && (!(mid[q] > lo[q]) || !(mid[q] < hi[q]))) { done[q] = true; thr[q] = hi[q]; tie[q] = hi[q]; need[q] = 256 - chi[q]; } }
            if (done[0] && done[1]) break;
            const float tv = half ? mid[1] : mid[0]; const float ntb_ = tv * -BIGF; const f32x2 ntb2 = {ntb_, ntb_}; f32x2 ca = {0.f, 0.f}, cb = {0.f, 0.f};
#pragma unroll
            for (int blk = 0; blk < 8; ++blk) if (16 * blk < nregs) {
#pragma unroll
                for (int jj = 0; jj < 8; jj += 4) cntp4(ca, cb, sc2[8 * blk + jj], sc2[8 * blk + jj + 1], sc2[8 * blk + jj + 2], sc2[8 * blk + jj + 3], big2, ntb2); }
            ca += cb; int cv = (int)(ca[0] + ca[1]);
            cv = half_sum(cv);
            const int c0 = __builtin_amdgcn_readlane(cv, 0), c1 = __builtin_amdgcn_readlane(cv, 32);
#pragma unroll
            for (int q = 0; q < 2; ++q) { const int cq = q ? c1 : c0;
                if (!done[q]) { if (cq == 256) { done[q] = true; thr[q] = mid[q]; need[q] = 0; } else if (cq > 256) { lo[q] = mid[q]; clo[q] = (float)cq; } else { hi[q] = mid[q]; chi[q] = cq; } } }
        }
#pragma unroll
        for (int q = 0; q < 2; ++q) if (!done[q]) { thr[q] = hi[q]; tie[q] = hi[q]; need[q] = 256 - chi[q]; }
        DSA_LAS unsigned* lq = list + half * 256;
        if (need[0] == 0 && need[1] == 0) {
            const float tv = half ? thr[1] : thr[0]; unsigned mk[4] = {0u, 0u, 0u, 0u};
#pragma unroll
            for (int blk = 0; blk < 8; ++blk) {
                if (16 * blk < nregs) {
#pragma unroll
                    for (int jj = 0; jj < 16; jj += 4) selmap4(mk[blk >> 1], SC(16 * blk + jj), SC(16 * blk + jj + 1), SC(16 * blk + jj + 2), SC(16 * blk + jj + 3), tv);
                } else if (blk & 1) mk[blk >> 1] <<= 16;
            }
            const int cv = __builtin_popcount(mk[0]) + __builtin_popcount(mk[1]) + __builtin_popcount(mk[2]) + __builtin_popcount(mk[3]);
            int incl = cv;
#pragma unroll
            for (int o = 1; o < 32; o <<= 1) { const int t = __shfl_up(incl, o, 32); if ((lane & 31) >= o) incl += t; }
            unsigned wp = (unsigned)(unsigned long long)lq + 4u * (unsigned)(incl - cv);
#pragma unroll
            for (int w = 0; w < 4; ++w) if (32 * w < nregs) { unsigned m = mk[w]; const unsigned kb_ = (unsigned)(1024 * w + (lane & 31));
                while (m) { const unsigned lz = (unsigned)__builtin_clz(m); *(DSA_LAS unsigned*)wp = (lz << 5) + kb_; wp += 4u; m ^= 0x80000000u >> lz; } }
        } else {
            const float tv = half ? thr[1] : thr[0], ev = half ? tie[1] : tie[0]; const int nd = half ? need[1] : need[0]; int base = 0, tb = 0;
#pragma unroll
            for (int blk = 0; blk < 8; ++blk) if (16 * blk < nregs) {
#pragma unroll
                for (int jj = 0; jj < 16; ++jj) { const int j = 16 * blk + jj; const float s = SC(j);
                    const bool eq = (s == ev); const unsigned long long meq = __builtin_amdgcn_ballot_w64(eq);
                    const unsigned elo = (unsigned)meq, ehi = (unsigned)(meq >> 32);
                    int pe = __builtin_amdgcn_mbcnt_hi(ehi, __builtin_amdgcn_mbcnt_lo(elo, 0)); if (half) pe -= __builtin_popcount(elo);
                    const bool sel = (s > tv) || (eq && (tb + pe < nd));
                    const unsigned long long ms = __builtin_amdgcn_ballot_w64(sel); const unsigned slo = (unsigned)ms, shi = (unsigned)(ms >> 32);
                    int pp = __builtin_amdgcn_mbcnt_hi(shi, __builtin_amdgcn_mbcnt_lo(slo, 0)); if (half) pp -= __builtin_popcount(slo);
                    const int pos = base + pp;
                    if (sel && pos < 256) lq[pos] = (unsigned)(32 * j + (lane & 31));
                    base += half ? __builtin_popcount(shi) : __builtin_popcount(slo); tb += half ? __builtin_popcount(ehi) : __builtin_popcount(elo); } }
            for (int p = base + (lane & 31); p < 256; p += 32) lq[p] = INVALID_ENTRY;
        }
    } else {
        for (int p = lane; p < 2 * ncnt; p += 64) { const int q = p / ncnt; list[q * 256 + (p - q * ncnt)] = (unsigned)(p - q * ncnt); }
    }
    asm volatile("s_waitcnt lgkmcnt(0)" ::: "memory");
#pragma unroll
    for (int q = 0; q < 2; ++q)
#pragma unroll
        for (int i = 0; i < 4; ++i) { const int p = lane + 64 * i; if (p < ncnt) { const unsigned e = list[q * 256 + p]; if (e != INVALID_ENTRY) list[q * 256 + p] = e | ((unsigned)t5_bucket((int)e - (tw + q)) << 16); } }
    asm volatile("s_waitcnt lgkmcnt(0)" ::: "memory");
    const int nq = ncnt >> 6;
    const int vrow = lane >> 3, vslot = lane & 7;
    const int ls_ = (((vslot >> 1) ^ ((vrow >> 1) & 3)) << 1) | (vslot & 1);
    const int trow = 4 * g + ((lane >> 2) & 3), tp = lane & 3, tx = (trow >> 1) & 3;
    const unsigned vbuf = ldsb + L_U + 65536 + wid * 8192;
    struct StepRegs { bf16x8 k[4][2]; bf16x8 v[8]; bf16x8 q[2]; };
    const char* const Kb_ = (const char*)(K + rb * 64), * const Vb_ = (const char*)(V + rb * 64), * const Qb_ = (const char*)(Q + (rb + tw) * 1024);
    const unsigned koff_ = (unsigned)(16 * g), voff_ = (unsigned)(16 * ls_), qoff_ = (unsigned)(kl * 128 + 16 * g);
#define DSA_STEP_LOAD(R, S) do { const int q_ = (S) / nq, qr_ = (S) - q_ * nq; const DSA_LAS unsigned* lq_ = list + q_ * 256 + 64 * qr_; \
        { const unsigned qo_ = qoff_ + (unsigned)q_ * 2048u; R.q[0] = *(const bf16x8*)(Qb_ + qo_); R.q[1] = *(const bf16x8*)(Qb_ + qo_ + 64u); } \
        _Pragma("unroll") for (int tt = 0; tt < 4; ++tt) { const unsigned ko_ = (lq_[16 * tt + kl] & 0xffffu) * 128u + koff_; R.k[tt][0] = *(const bf16x8*)(Kb_ + ko_); R.k[tt][1] = *(const bf16x8*)(Kb_ + ko_ + 64u); } \
        _Pragma("unroll") for (int i = 0; i < 8; ++i) { const unsigned vo_ = (lq_[8 * i + vrow] & 0xffffu) * 128u + voff_; R.v[i] = *(const bf16x8*)(Vb_ + vo_); } } while (0)
#define DSA_STEP(R, S, VB) do { const int q_ = (S) / nq, qr_ = (S) - q_ * nq; const DSA_LAS unsigned* lq_ = list + q_ * 256 + 64 * qr_; \
        if (qr_ == 0) { m_run = -1.0e30f; l_run = 0.f; _Pragma("unroll") for (int db = 0; db < 4; ++db) o[db] = (f32x4){0.f, 0.f, 0.f, 0.f}; } \
          \
        u32x4 e4[4]; f32x4 bv[4]; \
        _Pragma("unroll") for (int tt = 0; tt < 4; ++tt) e4[tt] = *(const DSA_LAS u32x4*)(lq_ + 16 * tt + 4 * g); \
        _Pragma("unroll") for (int tt = 0; tt < 4; ++tt) _Pragma("unroll") for (int r = 0; r < 4; ++r) bv[tt][r] = biasT[((e4[tt][r] >> 16) & 31u) * 16 + kl]; \
        f32x4 st[4]; \
        _Pragma("unroll") for (int tt = 0; tt < 4; ++tt) { \
            f32x4 a = __builtin_amdgcn_mfma_f32_16x16x32_bf16(R.k[tt][0], R.q[0], (f32x4){0.f, 0.f, 0.f, 0.f}, 0, 0, 0); a = __builtin_amdgcn_mfma_f32_16x16x32_bf16(R.k[tt][1], R.q[1], a, 0, 0, 0); \
            _Pragma("unroll") for (int r = 0; r < 4; ++r) a[r] = (e4[tt][r] >> 16) == 63u ? -1.0e30f : a[r] + bv[tt][r]; \
            st[tt] = a; } \
        float mloc = fmaxf(fmaxf(fmaxf(st[0][0], st[0][1]), fmaxf(st[0][2], st[0][3])), fmaxf(fmaxf(st[1][0], st[1][1]), fmaxf(st[1][2], st[1][3]))); \
        mloc = fmaxf(mloc, fmaxf(fmaxf(fmaxf(st[2][0], st[2][1]), fmaxf(st[2][2], st[2][3])), fmaxf(fmaxf(st[3][0], st[3][1]), fmaxf(st[3][2], st[3][3])))); \
        { auto r16 = __builtin_amdgcn_permlane16_swap(__float_as_uint(mloc), __float_as_uint(mloc), false, false); mloc = fmaxf(__uint_as_float(r16[0]), __uint_as_float(r16[1])); \
          auto r32_ = __builtin_amdgcn_permlane32_swap(__float_as_uint(mloc), __float_as_uint(mloc), false, false); mloc = fmaxf(__uint_as_float(r32_[0]), __uint_as_float(r32_[1])); } \
        const float mnew = fmaxf(m_run, mloc), alpha = __builtin_amdgcn_exp2f(m_run - mnew); m_run = mnew; \
        float ps = 0.f; unsigned pk[4][2]; \
        _Pragma("unroll") for (int tt = 0; tt < 4; ++tt) { f32x4 p; _Pragma("unroll") for (int r = 0; r < 4; ++r) p[r] = __builtin_amdgcn_exp2f(st[tt][r] - mnew); \
            ps += (p[0] + p[1]) + (p[2] + p[3]); pk[tt][0] = pg8::cvt_pk_bf16(p[0], p[1]); pk[tt][1] = pg8::cvt_pk_bf16(p[2], p[3]); } \
        l_run = l_run * alpha + ps; \
        _Pragma("unroll") for (int db = 0; db < 4; ++db) o[db] = o[db] * alpha; \
        { DSA_LAS unsigned char* vw = lds + L_U + 65536 + wid * 8192 + (VB) + vrow * 128 + vslot * 16; \
          _Pragma("unroll") for (int i = 0; i < 8; ++i) *(DSA_LAS bf16x8*)(vw + i * 1024) = R.v[i]; \
          asm volatile("s_waitcnt lgkmcnt(0)" ::: "memory"); } \
        _Pragma("unroll") for (int s2 = 0; s2 < 2; ++s2) { \
            const u32x4 pw = {pk[2 * s2][0], pk[2 * s2][1], pk[2 * s2 + 1][0], pk[2 * s2 + 1][1]}; const bf16x8 pb = __builtin_bit_cast(bf16x8, pw); \
            s16x4 v1[4], v2[4]; \
            _Pragma("unroll") for (int db = 0; db < 4; ++db) { const unsigned ta = vbuf + (VB) + trow * 128 + ((db ^ tx) << 5) + tp * 8; \
                v1[db] = s2 == 0 ? trrdo<0>(ta) : trrdo<4096>(ta); v2[db] = s2 == 0 ? trrdo<2048>(ta) : trrdo<6144>(ta); } \
            asm volatile("s_waitcnt lgkmcnt(0)" : "+v"(v1[0]), "+v"(v1[1]), "+v"(v1[2]), "+v"(v1[3]), "+v"(v2[0]), "+v"(v2[1]), "+v"(v2[2]), "+v"(v2[3]) :: "memory"); \
            _Pragma("unroll") for (int db = 0; db < 4; ++db) { const bf16x8 va = {v1[db][0], v1[db][1], v1[db][2], v1[db][3], v2[db][0], v2[db][1], v2[db][2], v2[db][3]}; \
                o[db] = __builtin_amdgcn_mfma_f32_16x16x32_bf16(va, pb, o[db], 0, 0, 0); } } \
        if (qr_ == nq - 1) { float lt = l_run; \
            { auto r16 = __builtin_amdgcn_permlane16_swap(__float_as_uint(lt), __float_as_uint(lt), false, false); lt = __uint_as_float(r16[0]) + __uint_as_float(r16[1]); \
              auto r32_ = __builtin_amdgcn_permlane32_swap(__float_as_uint(lt), __float_as_uint(lt), false, false); lt = __uint_as_float(r32_[0]) + __uint_as_float(r32_[1]); } \
            const float rl = __builtin_amdgcn_rcpf(lt); bf16_t* op = O + (rb + tw + q_) * 1024 + kl * 64 + 4 * g; \
            _Pragma("unroll") for (int db = 0; db < 4; ++db) { u32x2 w; w.x = pg8::cvt_pk_bf16(o[db][0] * rl, o[db][1] * rl); w.y = pg8::cvt_pk_bf16(o[db][2] * rl, o[db][3] * rl); *(u32x2*)(op + 16 * db) = w; } } \
    } while (0)
    {
        float m_run = -1.0e30f, l_run = 0.f; f32x4 o[4];
#pragma unroll
        for (int db = 0; db < 4; ++db) o[db] = (f32x4){0.f, 0.f, 0.f, 0.f};
        StepRegs RA, RB; const int nsteps = 2 * nq;
        DSA_STEP_LOAD(RA, 0);
#pragma unroll 1
        for (int s = 0; s < nsteps; s += 2) {
            DSA_STEP_LOAD(RB, s + 1);
            asm volatile("" ::: "memory");
            DSA_STEP(RA, s, 0);
            { const int sn_ = s + 2 < nsteps ? s + 2 : nsteps - 1; DSA_STEP_LOAD(RA, sn_); }
            asm volatile("" ::: "memory");
            DSA_STEP(RB, s + 1, 0);
        }
    }
#undef DSA_STEP
#undef DSA_STEP_LOAD
#undef DSA_KIDMA
}

#undef RELU
#undef SC
#undef QNAN
#undef DSA_LAS
#undef DSA_DPP
}
__device__ __forceinline__ void dsa_phase(Frame& F) {
    unsigned char* ws = wsp();
    const dsa::bf16_t* Q = (const dsa::bf16_t*)(ws + WS_AQ); const dsa::bf16_t* QI = (const dsa::bf16_t*)(ws + WS_AQI); const dsa::bf16_t* K = (const dsa::bf16_t*)(ws + WS_AK);
    const dsa::bf16_t* V = (const dsa::bf16_t*)(ws + WS_AV); const dsa::bf16_t* KI = (const dsa::bf16_t*)(ws + WS_AKI); const float* WI = (const float*)(ws + WS_AWI); dsa::bf16_t* O = (dsa::bf16_t*)(ws + WS_OB);
    { int t_ = threadIdx.x; asm volatile("" : "+v"(t_)); const float* rbias = inp(1); LAS float* bt = (LAS float*)(F.lds + dsa::L_BIAS); if (t_ < 512) bt[t_] = rbias[t_] * dsa::LOG2E; }
    __syncthreads();
    for (int pr = F.vcu; pr < NB * 32; pr += F.G) { const int b = pr >> 5, c0 = pr & 31;
        bool pre = false;
        for (int k = 0; k < 2; ++k) { const int c = k == 0 ? c0 : 63 - c0;
            for (int pass = 0; pass < 4; ++pass) { const bool last = (k == 1 && pass == 3); const int cn = (pass == 3) ? 63 - c0 : c; const bool pf = !last && cn >= 4;
                dsa::dsa_pass(Q, QI, K, V, KI, WI, O, b, c, pass, pre, pf, F.lds); pre = pf; } }
        __syncthreads(); }
    __syncthreads();
}

__device__ __forceinline__ void mla_phase(Frame& F, int j) {
    unsigned char* ws = wsp();
    const pg8::bf16_t* QB = (const pg8::bf16_t*)(ws + WS_QB); const pg8::bf16_t* KB = (const pg8::bf16_t*)(ws + WS_KB); const pg8::bf16_t* VB = (const pg8::bf16_t*)(ws + WS_VB); pg8::bf16_t* OB = (pg8::bf16_t*)(ws + WS_OB);
    const float* qgain = inp(16) + j * 96; const float* cosT = (const float*)(ws + WS_ROPE); const float* sinT = cosT + SEQ * 16;
    int ring = 0; bool pre = false;
    for (int item = F.vcu; item < NB * 16 * 8; item += F.G) { const int bh = item >> 3, s = item & 7, b = bh >> 4, h = bh & 15; const size_t rb = (size_t)b * SEQ;
        const pg8::bf16_t* Kc = KB + (size_t)bh * SEQ * 96; const pg8::bf16_t* Vc = VB + (size_t)bh * SEQ * 64;
        for (int k = 0; k < 2; ++k) { const int qb = k == 0 ? s : 15 - s;
            const pg8::bf16_t* Kn = Kc; const pg8::bf16_t* Vn = Vc;
            if (k == 1) { const int ni = item + F.G; if (ni < NB * 16 * 8) { const int bh2 = ni >> 3; Kn = KB + (size_t)bh2 * SEQ * 96; Vn = VB + (size_t)bh2 * SEQ * 64; } else { Kn = nullptr; Vn = nullptr; } }
            mla::attn_unit(QB + rb * 1536 + h * 96, Kc, Vc, OB + rb * 1024 + h * 64, qgain, cosT, sinT, qb, (char*)F.lds, Kn, Vn, pre, ring); pre = Kn != nullptr; } }
}

#ifndef PROBE_BAR2
#define PROBE_BAR2 0
#endif
#ifndef REP_DSA
#define REP_DSA 1
#endif
#ifndef REP_MLA
#define REP_MLA 1
#endif
#ifndef REP_UP
#define REP_UP 1
#endif
#ifndef DSA_ENABLED
#define DSA_ENABLED 0
#endif
struct Args { const float* in[21]; float* out; unsigned char* ws; };
__global__ void __launch_bounds__(NWAVES * 64, 2) yoco_fwd(Args args) {
    extern __shared__ __attribute__((aligned(16))) unsigned char lds[];
    Frame F;
    F.lds = (LAS unsigned char*)lds;
    F.MISC = (volatile LAS unsigned*)(F.lds + MISC_OFF);
    F.tid = threadIdx.x; F.lane = F.tid & 63; F.wave = __builtin_amdgcn_readfirstlane(F.tid >> 6);
    F.G = gridDim.x; { const int bx = blockIdx.x; F.vcu = (F.G % 8 == 0) ? (bx % 8) * (F.G / 8) + bx / 8 : bx; }
    F.gw = F.vcu * NWAVES + F.wave;
    F.ctl = (gu32*)(wsp() + WS_CTL);
#define ws wsp()
    for (int u = F.tid; u < (LDS_BYTES - LDSCTL_OFF) / 4; u += NWAVES * 64) ((LAS unsigned*)(F.lds + LDSCTL_OFF))[u] = 0u;
    __syncthreads();
    (void)xcd_barrier_post((unsigned*)(wsp() + WS_CTL) + CW_BAR, F.MISC + 8);
#define GRID_BAR() do { XcdBarrier bar_; bar_.bar = (unsigned*)(wsp() + WS_CTL) + CW_BAR; bar_.x = xb_xcc_id(); bar_.st = F.MISC + 8; xcd_barrier(bar_); if (PROBE_BAR2) xcd_barrier(bar_); } while (0)
    typedef pg8::bf16_t hb_t;

    p0_prologue(F);
    GRID_BAR();

    for (int L = 0; L < 2; ++L) {
        bool mixed = false;
        if (L < 2) {
            { pg8::Gemm g{(const hb_t*)(ws + WS_HB), (const hb_t*)(ws + WS_WIN) + (size_t)L * WIN_ELEMS, M, NIN, D}; pg8::StaticOrder S; S.init(M, NIN, F.G, (int)blockIdx.x);
              pg8::EpiInproj E{L};
              pg8::gemm_phase<pg8::EpiInproj, pg8::StaticOrder, PG8_ALIGN, PG8_SP2>(F.lds + RING_OFF, g, S, E); }
            GRID_BAR();
            for (int rep_ = 0; rep_ < REP_DSA; ++rep_) dsa_phase(F);
            GRID_BAR();
            mixed = true;
        }
        if (mixed) {
            const hb_t* Wo = L < 2 ? (const hb_t*)(ws + WS_WOA) + (size_t)L * D * D : (const hb_t*)(ws + WS_WOB) + (size_t)(L - 2) * D * D;
            pg8::Gemm g{(const hb_t*)(ws + WS_OB), Wo, M, D, D}; pg8::StaticOrder S; S.init(M, D, F.G, (int)blockIdx.x);
            pg8::EpiResidT<1, 0> E{1, 0};
            pg8::gemm_phase<pg8::EpiResidT<1, 0>, pg8::StaticOrder, PG8_ALIGN, PG8_SP2>(F.lds + RING_OFF, g, S, E);
            GRID_BAR();
        }
        { pg8::Gemm g{(const hb_t*)(ws + WS_HB), (const hb_t*)(ws + WS_WUP) + (size_t)L * D * FF, M, FF, D}; pg8::StaticOrder S; S.init(M, FF, F.G, (int)blockIdx.x);
          pg8::EpiUp E{0, (int)(WS_KB / MiB)};
          pg8::gemm_phase<pg8::EpiUp, pg8::StaticOrder, PG8_ALIGN, PG8_SP2>(F.lds + RING_OFF, g, S, E); }
        GRID_BAR();
        { pg8::Gemm g{(const hb_t*)(ws + WS_KB), (const hb_t*)(ws + WS_WDN) + (size_t)L * D * FF, M, D, FF}; pg8::StaticOrder S; S.init(M, D, F.G, (int)blockIdx.x);
          pg8::EpiResidT<0, 1> E{1, 0};
          pg8::gemm_phase<pg8::EpiResidT<0, 1>, pg8::StaticOrder, PG8_ALIGN, PG8_SP2>(F.lds + RING_OFF, g, S, E); }
        GRID_BAR();
    }
    for (int L = 2; L < 4; ++L) {
        bool mixed = false;
        if (L >= 2) {
            const int j = L - 2;
            if (j == 0) { pg8::Gemm g{(const hb_t*)(ws + WS_HB), (const hb_t*)(ws + WS_WKVQ), M, NKVQ, D}; pg8::StaticOrder S; S.init(M, NKVQ, F.G, (int)blockIdx.x);
              pg8::EpiKvq<0> E{};
              pg8::gemm_phase<pg8::EpiKvq<0>, pg8::StaticOrder, PG8_ALIGN, PG8_SP2>(F.lds + RING_OFF, g, S, E); }
            else { pg8::Gemm g{(const hb_t*)(ws + WS_HB), (const hb_t*)(ws + WS_WDQ1), M, NDQ1, D}; pg8::StaticOrder S; S.init(M, NDQ1, F.G, (int)blockIdx.x);
              pg8::EpiKvq<1> E{};
              pg8::gemm_phase<pg8::EpiKvq<1>, pg8::StaticOrder, PG8_ALIGN, PG8_SP2>(F.lds + RING_OFF, g, S, E); }
            GRID_BAR();
            if (j == 0) {
                int Kk = KVLORA; asm volatile("" : "+s"(Kk));
                pg8::Gemm g{(const hb_t*)(ws + WS_CKV), (const hb_t*)(ws + WS_WUKV), M, NUKV, Kk}; pg8::StaticOrder S; S.init(M, NUKV, F.G, (int)blockIdx.x);
                pg8::EpiUkv E{};
                pg8::gemm_phase<pg8::EpiUkv, pg8::StaticOrder, PG8_ALIGN, PG8_SP2>(F.lds + RING_OFF, g, S, E); }
            { int Kk = QLORA; asm volatile("" : "+s"(Kk)); pg8::Gemm g{(const hb_t*)(ws + WS_QL), (const hb_t*)(ws + WS_WUQ) + (size_t)j * WUQ_ELEMS, M, NUQ, Kk}; pg8::StaticOrder S; S.init(M, NUQ, F.G, (int)blockIdx.x);
              pg8::EpiUq E{};
              pg8::gemm_phase<pg8::EpiUq, pg8::StaticOrder, PG8_ALIGN, PG8_SP2>(F.lds + RING_OFF, g, S, E); }
            GRID_BAR();
            for (int rep_ = 0; rep_ < REP_MLA; ++rep_) mla_phase(F, j);
            GRID_BAR();
            mixed = true;
        }
        if (mixed) {
            const hb_t* Wo = L < 2 ? (const hb_t*)(ws + WS_WOA) + (size_t)L * D * D : (const hb_t*)(ws + WS_WOB) + (size_t)(L - 2) * D * D;
            pg8::Gemm g{(const hb_t*)(ws + WS_OB), Wo, M, D, D}; pg8::StaticOrder S; S.init(M, D, F.G, (int)blockIdx.x);
            pg8::EpiResidT<1, 0> E{1, 0};
            pg8::gemm_phase<pg8::EpiResidT<1, 0>, pg8::StaticOrder, PG8_ALIGN, PG8_SP2>(F.lds + RING_OFF, g, S, E);
            GRID_BAR();
        }
        const int nhalf = L == 3 ? 1 : 2, Mrows = L == 3 ? M : MH, hid_mib = L == 3 ? (int)(WS_KB / MiB) : (int)(WS_HID / MiB);
        for (int hf = 0; hf < nhalf; ++hf) {
            const size_t r0 = (size_t)hf * MH;
            for (int rep_ = 0; rep_ < REP_UP; ++rep_)
            { pg8::Gemm g{(const hb_t*)(ws + WS_HB) + r0 * D, (const hb_t*)(ws + WS_WUP) + (size_t)L * D * FF, Mrows, FF, D}; pg8::StaticOrder S; S.init(Mrows, FF, F.G, (int)blockIdx.x);
              pg8::EpiUp E{(int)r0, hid_mib};
              pg8::gemm_phase<pg8::EpiUp, pg8::StaticOrder, PG8_ALIGN, PG8_SP2>(F.lds + RING_OFF, g, S, E); }
            GRID_BAR();
            { pg8::Gemm g{(const hb_t*)(ws + (size_t)hid_mib * MiB), (const hb_t*)(ws + WS_WDN) + (size_t)L * D * FF, Mrows, D, FF}; pg8::StaticOrder S; S.init(Mrows, D, F.G, (int)blockIdx.x);
              pg8::EpiResidT<0, 1> E{L == 3 ? 2 : 1, (int)r0};
              pg8::gemm_phase<pg8::EpiResidT<0, 1>, pg8::StaticOrder, PG8_ALIGN, PG8_SP2>(F.lds + RING_OFF, g, S, E); }
            if (L != 3) GRID_BAR();
        }
        }
#undef ws
}
extern "C" void kernel_launch(void* const* d_in, const int* in_sizes, int n_in, void* d_out, int out_size, void* d_ws, size_t ws_size, hipStream_t stream) {
    static int grid = 0;
    if (grid == 0) {
        if (n_in != 21 || in_sizes[0] != M * D || out_size != M * D || ws_size < WS_END) { fprintf(stderr, "kernel_launch: unexpected shapes: n_in %d in0 %d out %d ws %zu\n", n_in, n_in > 0 ? in_sizes[0] : -1, out_size, ws_size); grid = -1; return; }
        int dev = 0, cus = 0, per_cu = 0;
        if (hipGetDevice(&dev) != hipSuccess || hipDeviceGetAttribute(&cus, hipDeviceAttributeMultiprocessorCount, dev) != hipSuccess) { grid = -1; return; }
        if (hipFuncSetAttribute((const void*)yoco_fwd, hipFuncAttributeMaxDynamicSharedMemorySize, LDS_BYTES) != hipSuccess) { fprintf(stderr, "kernel_launch: hipFuncSetAttribute failed\n"); grid = -1; return; }
        if (hipOccupancyMaxActiveBlocksPerMultiprocessor(&per_cu, (const void*)yoco_fwd, NWAVES * 64, LDS_BYTES) != hipSuccess || per_cu < 1) { fprintf(stderr, "kernel_launch: occupancy query reports %d\n", per_cu); }
        (void)hipGetLastError();
        grid = cus;
    }
    if (grid < 0) return;
    if (hipMemsetAsync((char*)d_ws + WS_CTL, 0, CTL_ZERO_BYTES, stream) != hipSuccess) return;
    Args a{};
    for (int i = 0; i < 21; ++i) a.in[i] = (const float*)d_in[i];
    a.out = (float*)d_out; a.ws = (unsigned char*)d_ws;
    hipLaunchKernelGGL(yoco_fwd, dim3(grid), dim3(NWAVES * 64), LDS_BYTES, stream, a);
}
```

```cpp
#include <hip/hip_runtime.h>
#include <cstdio>
#include <cstdint>

#ifndef PG8_SP2
#define PG8_SP2 true
#endif
#ifndef PG8_ALIGN
#define PG8_ALIGN true
#endif
constexpr int NWAVES = 8;
constexpr int NB = 8, SEQ = 4096, M = NB * SEQ, D = 1024, FF = 4096, MH = M / 2;
constexpr int A_IN = 1736, NIN = 1792;
constexpr int NKVQ = 768, NUKV = 2048, NDQ1 = 512, NUQ = 1536, QLORA = 384, KVLORA = 256;
constexpr size_t MiB = 1u << 20;
constexpr size_t WS_CTL = 0, CTL_ZERO_BYTES = 1 * MiB;
constexpr size_t WS_WIN = 1 * MiB, WS_WOA = 8 * MiB, WS_WKVQ = 12 * MiB, WS_WUKV = 14 * MiB, WS_WDQ1 = 15 * MiB, WS_WUQ = 16 * MiB, WS_WOB = 19 * MiB, WS_WUP = 23 * MiB, WS_WDN = 55 * MiB;
constexpr size_t WS_SSQH = 87 * MiB, WS_SSQCKV = 89 * MiB, WS_SSQQL = 89 * MiB + 512 * 1024, WS_SSQKR = 90 * MiB + 512 * 1024, WS_KROPE = 91 * MiB, WS_ROPE = 95 * MiB;
constexpr size_t WS_HB = 96 * MiB, WS_KB = 160 * MiB, WS_VB = 256 * MiB, WS_X = 320 * MiB;
constexpr size_t WS_HID = WS_X, WS_QB = WS_X, WS_OB = 416 * MiB, WS_QL = 416 * MiB, WS_CKV = 448 * MiB, WS_SSQB = 480 * MiB, WS_END = 482 * MiB;
constexpr size_t WS_AQ = WS_X, WS_AQI = 384 * MiB, WS_AK = 160 * MiB, WS_AV = 164 * MiB, WS_AKI = 168 * MiB, WS_AWI = 172 * MiB;
constexpr size_t WIN_ELEMS = (size_t)NIN * D, WUQ_ELEMS = (size_t)NUQ * QLORA;
constexpr int CW_TMO = 0, CW_CODE = 1, CW_BAR = 4096;
constexpr int RING_OFF = 0, RING_BYTES = 131072;
constexpr int LDSCTL_OFF = 151552, MISC_OFF = LDSCTL_OFF + 320;
constexpr int LDS_BYTES = 155648;
#define GAS __attribute__((address_space(1)))
#define LAS __attribute__((address_space(3)))
typedef unsigned short bf16;
typedef unsigned v4u __attribute__((ext_vector_type(4)));
typedef float f32x4 __attribute__((ext_vector_type(4)));
typedef short bf16x8 __attribute__((ext_vector_type(8)));
typedef GAS unsigned gu32;
typedef GAS unsigned long long gu64;
#define RLX_AGENT __ATOMIC_RELAXED, __HIP_MEMORY_SCOPE_AGENT
#define LDS_WAIT() asm volatile("s_waitcnt lgkmcnt(0)" ::: "memory")
#define VM_WAIT() asm volatile("s_waitcnt vmcnt(0)" ::: "memory")

typedef const float* cfp_t;
__device__ __forceinline__ cfp_t inp(int i) { return ((volatile cfp_t __attribute__((address_space(4)))*)__builtin_amdgcn_kernarg_segment_ptr())[i]; }
__device__ __forceinline__ float* outp() { return (float*)((volatile cfp_t __attribute__((address_space(4)))*)__builtin_amdgcn_kernarg_segment_ptr())[21]; }
__device__ __forceinline__ unsigned char* wsp() { return (unsigned char*)((volatile cfp_t __attribute__((address_space(4)))*)__builtin_amdgcn_kernarg_segment_ptr())[22]; }
namespace pg8 {
#define PG8_LAS __attribute__((address_space(3)))
typedef unsigned short bf16_t;
typedef short bf16x8 __attribute__((ext_vector_type(8)));
typedef float f32x4 __attribute__((ext_vector_type(4)));
typedef unsigned u32x4 __attribute__((ext_vector_type(4)));
constexpr int BM = 256, BK = 64, HALF = 128, HTB = HALF * BK * 2  , STAGE_BYTES = 8 * HTB, NXCD = 8, WGM = 8;

__host__ __device__ __forceinline__ int lds_byte(int r, int c) { const int st = (r >> 4) * 2 + (c >> 5), rr = r & 15, cc = c & 31, ob = rr * 64 + cc * 2; return st * 1024 + (ob ^ (((ob >> 9) & 1) << 5)); }
__host__ __device__ __forceinline__ void stage_rc(int b, int& R, int& C) { const int st = b / 1024, sb = b % 1024, swz = sb ^ (((sb >> 9) & 1) << 5); R = (st >> 1) * 16 + swz / 64; C = (st & 1) * 32 + (swz % 64) / 2; }
__host__ __device__ __forceinline__ int perm32(int rho) { const int n = rho >> 4, i = rho & 15; return 8 * (i >> 2) + 4 * n + (i & 3); }

struct Unit { int pm, pn; };
struct Gemm { const bf16_t* A; const bf16_t* Bt; int M, N, K; };

struct StaticOrder {
    int nM, nN, nwg, G, c;
    __host__ __device__ void init(int M, int N, int G_, int c_) { nM = M / BM; nN = N / BM; nwg = nM * nN; G = G_; c = c_; }
    __host__ __device__ bool next(int i, Unit& u) const {
        const long L = (long)i * G + c; if (L >= nwg) return false;
        int wgid = (int)L; { const int q = nwg / NXCD, r = nwg % NXCD, xcd = wgid % NXCD, off = wgid / NXCD; wgid = (xcd < r ? xcd * (q + 1) : r * (q + 1) + (xcd - r) * q) + off; }
        const int nig = WGM * nN, gid = wgid / nig, fm = gid * WGM, gsz = (nM - fm) < WGM ? (nM - fm) : WGM;
        u.pm = fm + ((wgid % nig) % gsz); u.pn = (wgid % nig) / gsz; return true;
    }
    __device__ __forceinline__ void a_ready(const Unit&) const {}
    __device__ __forceinline__ void done(const Unit&) const {}
};


typedef float f32x2 __attribute__((ext_vector_type(2)));
typedef __bf16 bf16x2_t __attribute__((ext_vector_type(2)));
__device__ __forceinline__ unsigned cvt_pk_bf16(float lo, float hi) { f32x2 v = {lo, hi}; bf16x2_t b = __builtin_convertvector(v, bf16x2_t); return __builtin_bit_cast(unsigned, b); }
__device__ __forceinline__ u32x4 pack8(f32x4 a, f32x4 b) { u32x4 w; w.x = cvt_pk_bf16(a[0], a[1]); w.y = cvt_pk_bf16(a[2], a[3]); w.z = cvt_pk_bf16(b[0], b[1]); w.w = cvt_pk_bf16(b[2], b[3]); return w; }
__device__ __forceinline__ float sum4sq(f32x4 a) { return (a[0] * a[0] + a[1] * a[1]) + (a[2] * a[2] + a[3] * a[3]); }
__device__ __forceinline__ float red_fq(float s) { const unsigned u = __float_as_uint(s); auto a = __builtin_amdgcn_permlane16_swap(u, u, false, false); const float t = __uint_as_float(a[0]) + __uint_as_float(a[1]);
    const unsigned w = __float_as_uint(t); auto b = __builtin_amdgcn_permlane32_swap(w, w, false, false); return __uint_as_float(b[0]) + __uint_as_float(b[1]); }
constexpr float RMS_EPS = 1e-6f;
__device__ __forceinline__ float rstd16(const float* ssq, int row, int fq, float inv_n) { const f32x4 v = *(const f32x4*)(ssq + (size_t)row * 16 + 4 * fq); return __builtin_amdgcn_rsqf(red_fq((v[0] + v[1]) + (v[2] + v[3])) * inv_n + RMS_EPS); }
__device__ __forceinline__ float rstd4(const float* ssq, int row, int fq, float inv_n) { return __builtin_amdgcn_rsqf(red_fq(ssq[(size_t)row * 4 + fq]) * inv_n + RMS_EPS); }
__device__ __forceinline__ float rstd6(const float* ssq, int row, int fq, float inv_n) { const f32x2 v = *(const f32x2*)(ssq + (size_t)row * 8 + 2 * fq); return __builtin_amdgcn_rsqf(red_fq(fq < 3 ? v[0] + v[1] : 0.f) * inv_n + RMS_EPS); }

__device__ __forceinline__ void rstd16x8(const float* ssq, int rowb, int fq, float inv_n, float (&rs)[2][4]) { f32x4 v[2][4];
#pragma unroll
    for (int ai = 0; ai < 2; ++ai)
#pragma unroll
        for (int m = 0; m < 4; ++m) v[ai][m] = *(const f32x4*)(ssq + (size_t)(rowb + ai * HALF + m * 16) * 16 + 4 * fq);
    asm volatile("" : "+v"(v[0][0]), "+v"(v[0][1]), "+v"(v[0][2]), "+v"(v[0][3]), "+v"(v[1][0]), "+v"(v[1][1]), "+v"(v[1][2]), "+v"(v[1][3]));
#pragma unroll
    for (int ai = 0; ai < 2; ++ai)
#pragma unroll
        for (int m = 0; m < 4; ++m) rs[ai][m] = __builtin_amdgcn_rsqf(red_fq((v[ai][m][0] + v[ai][m][1]) + (v[ai][m][2] + v[ai][m][3])) * inv_n + RMS_EPS); }
__device__ __forceinline__ void rstd6x8(const float* ssq, int rowb, int fq, float inv_n, float (&rs)[2][4]) { f32x2 v[2][4];
#pragma unroll
    for (int ai = 0; ai < 2; ++ai)
#pragma unroll
        for (int m = 0; m < 4; ++m) v[ai][m] = *(const f32x2*)(ssq + (size_t)(rowb + ai * HALF + m * 16) * 8 + 2 * fq);
    asm volatile("" : "+v"(v[0][0]), "+v"(v[0][1]), "+v"(v[0][2]), "+v"(v[0][3]), "+v"(v[1][0]), "+v"(v[1][1]), "+v"(v[1][2]), "+v"(v[1][3]));
#pragma unroll
    for (int ai = 0; ai < 2; ++ai)
#pragma unroll
        for (int m = 0; m < 4; ++m) rs[ai][m] = __builtin_amdgcn_rsqf(red_fq(fq < 3 ? v[ai][m][0] + v[ai][m][1] : 0.f) * inv_n + RMS_EPS); }
template <int SB_, int SCALE_> struct EpiResidT {
    static constexpr bool PERM = true, AFTER_DRAIN = false; static constexpr int sb = SB_, scale = SCALE_;
    int mode, r0;
    __device__ __forceinline__ void operator()(const f32x4 (&acc)[2][2][4][2], const Unit& u, int wr, int wc, int fr, int fq) const {
        { int t_ = threadIdx.x; asm volatile("" : "+v"(t_)); fr = t_ & 15; fq = (t_ >> 4) & 3; }
        const int col = u.pn * BM + wc * 64 + fq * 8;
        const float* xin = inp(0) + (size_t)r0 * 1024; float* out = outp() + (size_t)r0 * 1024; bf16_t* hb = (bf16_t*)(wsp() + WS_HB) + (size_t)r0 * 1024; float* ssq = (float*)(wsp() + (sb ? WS_SSQB : WS_SSQH)) + (size_t)r0 * 16;
        if (scale == 0) {
        u32x4 rb[2][4][2];
#pragma unroll
        for (int ai = 0; ai < 2; ++ai)
#pragma unroll
            for (int m = 0; m < 4; ++m) { const size_t off = (size_t)(u.pm * BM + ai * HALF + wr * 64 + m * 16 + fr) * 1024 + col;
#pragma unroll
                for (int bj = 0; bj < 2; ++bj) rb[ai][m][bj] = *(const u32x4*)(hb + off + bj * 32); }
        asm volatile("" ::: "memory");
#pragma unroll
        for (int ai = 0; ai < 2; ++ai) {
            asm volatile("" : "+v"(rb[ai][0][0]), "+v"(rb[ai][0][1]), "+v"(rb[ai][1][0]), "+v"(rb[ai][1][1]), "+v"(rb[ai][2][0]), "+v"(rb[ai][2][1]), "+v"(rb[ai][3][0]), "+v"(rb[ai][3][1]));
#pragma unroll
            for (int m = 0; m < 4; ++m) { const int row = u.pm * BM + ai * HALF + wr * 64 + m * 16 + fr; const size_t off = (size_t)row * 1024 + col; float s = 0.f;
#pragma unroll
                for (int bj = 0; bj < 2; ++bj) { const u32x4 w = rb[ai][m][bj];
                    const f32x4 r0v = {__uint_as_float(w.x << 16), __uint_as_float(w.x & 0xffff0000u), __uint_as_float(w.y << 16), __uint_as_float(w.y & 0xffff0000u)};
                    const f32x4 r1v = {__uint_as_float(w.z << 16), __uint_as_float(w.z & 0xffff0000u), __uint_as_float(w.w << 16), __uint_as_float(w.w & 0xffff0000u)};
                    const f32x4 a = r0v + acc[ai][bj][m][0], b = r1v + acc[ai][bj][m][1];
                    if (mode == 2) { *(f32x4*)(out + off + bj * 32) = a; *(f32x4*)(out + off + bj * 32 + 4) = b; }
                    else { *(u32x4*)(hb + off + bj * 32) = pack8(a, b); s += sum4sq(a) + sum4sq(b); } }
                if (mode != 2) { s = red_fq(s); if (fq == 0) ssq[(size_t)row * 16 + u.pn * 4 + wc] = s; } }
        }
        } else {
#pragma unroll
        for (int ai = 0; ai < 2; ++ai) {
            float rs2[4] = {1.f, 1.f, 1.f, 1.f}; u32x4 rb[4][2];
            if (scale) { const float* sq = (const float*)(wsp() + WS_SSQB) + (size_t)r0 * 16; f32x4 sv[4];
#pragma unroll
                for (int m = 0; m < 4; ++m) sv[m] = *(const f32x4*)(sq + (size_t)(u.pm * BM + ai * HALF + wr * 64 + m * 16 + fr) * 16 + 4 * fq);
#pragma unroll
                for (int m = 0; m < 4; ++m) { const size_t off = (size_t)(u.pm * BM + ai * HALF + wr * 64 + m * 16 + fr) * 1024 + col;
#pragma unroll
                    for (int bj = 0; bj < 2; ++bj) rb[m][bj] = *(const u32x4*)(hb + off + bj * 32); }
                asm volatile("" : "+v"(sv[0]), "+v"(sv[1]), "+v"(sv[2]), "+v"(sv[3]), "+v"(rb[0][0]), "+v"(rb[0][1]), "+v"(rb[1][0]), "+v"(rb[1][1]), "+v"(rb[2][0]), "+v"(rb[2][1]), "+v"(rb[3][0]), "+v"(rb[3][1]));
#pragma unroll
                for (int m = 0; m < 4; ++m) { const float r_ = __builtin_amdgcn_rsqf(red_fq((sv[m][0] + sv[m][1]) + (sv[m][2] + sv[m][3])) * (1.f / 1024.f) + RMS_EPS); rs2[m] = r_ * r_ * 2.81474976710656e14f; } }
            else {
#pragma unroll
                for (int m = 0; m < 4; ++m) { const size_t off = (size_t)(u.pm * BM + ai * HALF + wr * 64 + m * 16 + fr) * 1024 + col;
#pragma unroll
                    for (int bj = 0; bj < 2; ++bj) rb[m][bj] = *(const u32x4*)(hb + off + bj * 32); }
                asm volatile("" : "+v"(rb[0][0]), "+v"(rb[0][1]), "+v"(rb[1][0]), "+v"(rb[1][1]), "+v"(rb[2][0]), "+v"(rb[2][1]), "+v"(rb[3][0]), "+v"(rb[3][1])); }
#pragma unroll
            for (int m = 0; m < 4; ++m) { const int row = u.pm * BM + ai * HALF + wr * 64 + m * 16 + fr; const size_t off = (size_t)row * 1024 + col; float s = 0.f;
#pragma unroll
                for (int bj = 0; bj < 2; ++bj) { const float sc_ = rs2[m]; const u32x4 w = rb[m][bj];
                    const f32x4 r0v = {__uint_as_float(w.x << 16), __uint_as_float(w.x & 0xffff0000u), __uint_as_float(w.y << 16), __uint_as_float(w.y & 0xffff0000u)};
                    const f32x4 r1v = {__uint_as_float(w.z << 16), __uint_as_float(w.z & 0xffff0000u), __uint_as_float(w.w << 16), __uint_as_float(w.w & 0xffff0000u)};
                    const f32x4 a = r0v + acc[ai][bj][m][0] * sc_, b = r1v + acc[ai][bj][m][1] * sc_;
                    if (mode == 2) { *(f32x4*)(out + off + bj * 32) = a; *(f32x4*)(out + off + bj * 32 + 4) = b; }
                    else { *(u32x4*)(hb + off + bj * 32) = pack8(a, b); s += sum4sq(a) + sum4sq(b); } }
                if (mode != 2) { s = red_fq(s); if (fq == 0) ssq[(size_t)row * 16 + u.pn * 4 + wc] = s; } }
        }
        }
    }
};
using EpiResid = EpiResidT<0, 0>;
struct EpiUp {
    static constexpr bool PERM = true, AFTER_DRAIN = false;
    int r0, hid_mib;
    __device__ __forceinline__ void operator()(const f32x4 (&acc)[2][2][4][2], const Unit& u, int wr, int wc, int fr, int fq) const {
        { int t_ = threadIdx.x; asm volatile("" : "+v"(t_)); fr = t_ & 15; fq = (t_ >> 4) & 3; }
        const int col = u.pn * BM + wc * 64 + fq * 8;
        bf16_t* hid = (bf16_t*)(wsp() + (size_t)hid_mib * 1048576);
#pragma unroll
        for (int ai = 0; ai < 2; ++ai)
#pragma unroll
            for (int m = 0; m < 4; ++m) { const int row = u.pm * BM + ai * HALF + wr * 64 + m * 16 + fr;
#pragma unroll
                for (int bj = 0; bj < 2; ++bj) { f32x4 a, b; const f32x2 k2 = {5.9604644775390625e-08f, 5.9604644775390625e-08f};
#pragma unroll
                    for (int hh = 0; hh < 2; ++hh) { const f32x4 s = acc[ai][bj][m][hh]; f32x2 lo = {s[0], s[1]}, hi = {s[2], s[3]};
                        asm("v_pk_mul_f32 %0, %1, %2 clamp" : "=v"(lo) : "v"(lo), "v"(k2)); asm("v_pk_mul_f32 %0, %1, %2 clamp" : "=v"(hi) : "v"(hi), "v"(k2));
                        lo = lo * lo; hi = hi * hi; const f32x4 q = {lo[0], lo[1], hi[0], hi[1]}; if (hh == 0) a = q; else b = q; }
                    *(u32x4*)(hid + (size_t)row * 4096 + col + bj * 32) = pack8(a, b); } }
    }
};
__device__ __forceinline__ void pg8_glds16(const char* sbase, unsigned voff, unsigned lds_dst) { unsigned keep;
    asm volatile("s_mov_b32 %0, m0\n\ts_mov_b32 m0, %3\n\ts_nop 0\n\tglobal_load_lds_dwordx4 %2, %1\n\ts_mov_b32 m0, %0" : "=&s"(keep) : "s"(sbase), "v"(voff), "s"(lds_dst) : "memory"); }

template <int pn_off> struct EpiKvq {
    static constexpr bool PERM = true, AFTER_DRAIN = false;
    __device__ __forceinline__ void operator()(const f32x4 (&acc)[2][2][4][2], const Unit& u, int wr, int wc, int fr, int fq) const {
        { int t_ = threadIdx.x; asm volatile("" : "+v"(t_)); fr = t_ & 15; fq = (t_ >> 4) & 3; }
        const int vpn = u.pn + pn_off; unsigned char* ws = wsp();
        const float* ssqh = (const float*)(ws + WS_SSQH); bf16_t* ckv = (bf16_t*)(ws + WS_CKV); bf16_t* ql = (bf16_t*)(ws + WS_QL); float* krope = (float*)(ws + WS_KROPE); float* ssq_ckv = (float*)(ws + WS_SSQCKV); float* ssq_ql = (float*)(ws + WS_SSQQL); float* ssq_kr = (float*)(ws + WS_SSQKR);
        float rsv[2][4];
        rstd16x8(ssqh, u.pm * BM + wr * 64 + fr, fq, 1.f / 1024.f, rsv);
#pragma unroll
        for (int ai = 0; ai < 2; ++ai)
#pragma unroll
            for (int m = 0; m < 4; ++m) { const int row = u.pm * BM + ai * HALF + wr * 64 + m * 16 + fr; const float rs = rsv[ai][m];
                const f32x4 a0 = acc[ai][0][m][0] * rs, b0 = acc[ai][0][m][1] * rs, a1 = acc[ai][1][m][0] * rs, b1 = acc[ai][1][m][1] * rs;
                if (vpn == 0) { bf16_t* p = ckv + (size_t)row * 256 + wc * 64 + fq * 8; *(u32x4*)p = pack8(a0, b0); *(u32x4*)(p + 32) = pack8(a1, b1);
                    const float s = red_fq((sum4sq(a0) + sum4sq(b0)) + (sum4sq(a1) + sum4sq(b1))); if (fq == 0) ssq_ckv[(size_t)row * 4 + wc] = s; }
                else if (vpn == 1 || wc < 2) { bf16_t* p = ql + (size_t)row * 384 + (vpn - 1) * 256 + wc * 64 + fq * 8; *(u32x4*)p = pack8(a0, b0); *(u32x4*)(p + 32) = pack8(a1, b1);
                    const float s = red_fq((sum4sq(a0) + sum4sq(b0)) + (sum4sq(a1) + sum4sq(b1))); if (fq == 0) ssq_ql[(size_t)row * 8 + (vpn - 1) * 4 + wc] = s; }
                else if (wc == 2 && pn_off == 0) { float* p = krope + (size_t)row * 32 + fq * 8; *(f32x4*)p = a0; *(f32x4*)(p + 4) = b0;
                    const float s = red_fq(sum4sq(a0) + sum4sq(b0)); if (fq == 0) ssq_kr[row] = s; } }
    }
};
struct EpiUkv {
    static constexpr bool PERM = true, AFTER_DRAIN = false;
    __device__ __forceinline__ void operator()(const f32x4 (&acc)[2][2][4][2], const Unit& u, int wr, int wc, int fr, int fq) const {
        { int t_ = threadIdx.x; asm volatile("" : "+v"(t_)); fr = t_ & 15; fq = (t_ >> 4) & 3; }
        const int G = u.pn * 4 + wc, head = G >> 1; const bool isv = (G & 1) != 0; unsigned char* ws = wsp();
        const float* ssq_ckv = (const float*)(ws + WS_SSQCKV); const float* ssq_kr = (const float*)(ws + WS_SSQKR); const float* krope = (const float*)(ws + WS_KROPE); const float* kgain = inp(11); const float* cosT = (const float*)(ws + WS_ROPE); const float* sinT = cosT + SEQ * 16; bf16_t* kb = (bf16_t*)(ws + WS_KB); bf16_t* vb = (bf16_t*)(ws + WS_VB);
        f32x4 g0a, g0b, g1a, g1b, gr1, gr2;
        if (!isv) { g0a = *(const f32x4*)(kgain + fq * 8); g0b = *(const f32x4*)(kgain + fq * 8 + 4); g1a = *(const f32x4*)(kgain + 32 + fq * 8); g1b = *(const f32x4*)(kgain + 36 + fq * 8);
            gr1 = *(const f32x4*)(kgain + 64 + 4 * fq); gr2 = *(const f32x4*)(kgain + 80 + 4 * fq); }
        const int rowb = u.pm * BM + wr * 64 + fr;
        float rsv[2][4], skr[2][4];
        { float v[2][4];
#pragma unroll
          for (int ai = 0; ai < 2; ++ai)
#pragma unroll
              for (int m = 0; m < 4; ++m) { v[ai][m] = ssq_ckv[(size_t)(rowb + ai * HALF + m * 16) * 4 + fq]; skr[ai][m] = isv ? 0.f : ssq_kr[rowb + ai * HALF + m * 16]; }
          asm volatile("" : "+v"(v[0][0]), "+v"(v[0][1]), "+v"(v[0][2]), "+v"(v[0][3]), "+v"(v[1][0]), "+v"(v[1][1]), "+v"(v[1][2]), "+v"(v[1][3]),
                            "+v"(skr[0][0]), "+v"(skr[0][1]), "+v"(skr[0][2]), "+v"(skr[0][3]), "+v"(skr[1][0]), "+v"(skr[1][1]), "+v"(skr[1][2]), "+v"(skr[1][3]));
#pragma unroll
          for (int ai = 0; ai < 2; ++ai)
#pragma unroll
              for (int m = 0; m < 4; ++m) rsv[ai][m] = __builtin_amdgcn_rsqf(red_fq(v[ai][m]) * (1.f / 256.f) + RMS_EPS); }
#pragma unroll
        for (int ai = 0; ai < 2; ++ai)
#pragma unroll
            for (int m = 0; m < 4; ++m) { const int row = rowb + ai * HALF + m * 16; const float rs = rsv[ai][m];
                f32x4 kx1, kx2, cc, ss;
                if (!isv) { const int pos = row & 4095;
                    kx1 = *(const f32x4*)(krope + (size_t)row * 32 + 4 * fq); kx2 = *(const f32x4*)(krope + (size_t)row * 32 + 16 + 4 * fq);
                    cc = *(const f32x4*)(cosT + pos * 16 + 4 * fq); ss = *(const f32x4*)(sinT + pos * 16 + 4 * fq);
                    asm volatile("" : "+v"(kx1), "+v"(kx2), "+v"(cc), "+v"(ss)); }
                const f32x4 a0 = acc[ai][0][m][0] * rs, b0 = acc[ai][0][m][1] * rs, a1 = acc[ai][1][m][0] * rs, b1 = acc[ai][1][m][1] * rs;
                if (isv) { bf16_t* p = vb + ((((size_t)(row >> 12) * 16 + head) << 12) + (row & 4095)) * 64 + fq * 8; *(u32x4*)p = pack8(a0, b0); *(u32x4*)(p + 32) = pack8(a1, b1); }
                else { const float s = red_fq((sum4sq(a0) + sum4sq(b0)) + (sum4sq(a1) + sum4sq(b1))) + skr[ai][m]; const float rk = __builtin_amdgcn_rsqf(s * (1.f / 96.f) + RMS_EPS);
                    bf16_t* p = kb + ((((size_t)(row >> 12) * 16 + head) << 12) + (row & 4095)) * 96; *(u32x4*)(p + fq * 8) = pack8(a0 * g0a * rk, b0 * g0b * rk); *(u32x4*)(p + 32 + fq * 8) = pack8(a1 * g1a * rk, b1 * g1b * rk);
                    const f32x4 x1 = kx1 * gr1 * rk, x2 = kx2 * gr2 * rk;
                    const f32x4 o1 = x1 * cc - x2 * ss, o2 = x2 * cc + x1 * ss;
                    typedef unsigned u32x2v __attribute__((ext_vector_type(2)));
                    u32x2v w1, w2; w1.x = cvt_pk_bf16(o1[0], o1[1]); w1.y = cvt_pk_bf16(o1[2], o1[3]); w2.x = cvt_pk_bf16(o2[0], o2[1]); w2.y = cvt_pk_bf16(o2[2], o2[3]);
                    *(u32x2v*)(p + 64 + 4 * fq) = w1; *(u32x2v*)(p + 80 + 4 * fq) = w2; } }
    }
};
struct EpiUq {
    static constexpr bool PERM = true, AFTER_DRAIN = false;
    __device__ __forceinline__ void operator()(const f32x4 (&acc)[2][2][4][2], const Unit& u, int wr, int wc, int fr, int fq) const {
        { int t_ = threadIdx.x; asm volatile("" : "+v"(t_)); fr = t_ & 15; fq = (t_ >> 4) & 3; }
        const int col = u.pn * BM + wc * 64 + fq * 8; const float* ssq_ql = (const float*)(wsp() + WS_SSQQL); bf16_t* qb = (bf16_t*)(wsp() + WS_QB);
        float rsv[2][4];
        rstd6x8(ssq_ql, u.pm * BM + wr * 64 + fr, fq, 1.f / 384.f, rsv);
#pragma unroll
        for (int ai = 0; ai < 2; ++ai)
#pragma unroll
            for (int m = 0; m < 4; ++m) { const int row = u.pm * BM + ai * HALF + wr * 64 + m * 16 + fr; const float rs = rsv[ai][m];
                bf16_t* p = qb + (size_t)row * 1536 + col; *(u32x4*)p = pack8(acc[ai][0][m][0] * rs, acc[ai][0][m][1] * rs); *(u32x4*)(p + 32) = pack8(acc[ai][1][m][0] * rs, acc[ai][1][m][1] * rs); }
    }
};

struct EpiInproj {
    static constexpr bool PERM = true, AFTER_DRAIN = false;
    int layer;
    __device__ __forceinline__ void operator()(const f32x4 (&acc)[2][2][4][2], const Unit& u, int wr, int wc, int fr, int fq) const {
        { int t_ = threadIdx.x; asm volatile("" : "+v"(t_)); fr = t_ & 15; fq = (t_ >> 4) & 3; }
        unsigned char* ws = wsp(); const float* ssqh = (const float*)(ws + WS_SSQH);
        const bool isq = u.pn < 4, isk = (u.pn == 4 && wc == 0), normed = isq || isk;
        f32x4 g0a = {1.f, 1.f, 1.f, 1.f}, g0b = g0a, g1a = g0a, g1b = g0a;
        if (normed) { const float* gp = (isq ? inp(4) : inp(5)) + layer * 64 + fq * 8; const float sc = isq ? 0.125f * 1.4426950408889634f : 1.f;
            g0a = *(const f32x4*)gp * sc; g0b = *(const f32x4*)(gp + 4) * sc; g1a = *(const f32x4*)(gp + 32) * sc; g1b = *(const f32x4*)(gp + 36) * sc; }
        bf16_t* dst; int ld;
        if (isq) { dst = (bf16_t*)(ws + WS_AQ) + (u.pn * 4 + wc) * 64; ld = 1024; }
        else if (u.pn == 4) { dst = (bf16_t*)(ws + (wc == 0 ? WS_AK : wc == 1 ? WS_AV : WS_AKI)); ld = 64; }
        else { dst = (bf16_t*)(ws + WS_AQI) + ((u.pn - 5) * 4 + wc) * 64; ld = 512; }
        const bool iswi = (u.pn == 4 && wc == 3);
        float rsv[2][4];
        rstd16x8(ssqh, u.pm * BM + wr * 64 + fr, fq, 1.f / 1024.f, rsv);
#pragma unroll
        for (int ai = 0; ai < 2; ++ai)
#pragma unroll
            for (int m = 0; m < 4; ++m) { const int row = u.pm * BM + ai * HALF + wr * 64 + m * 16 + fr; const float rs = rsv[ai][m];
                f32x4 a0 = acc[ai][0][m][0] * rs, b0 = acc[ai][0][m][1] * rs, a1 = acc[ai][1][m][0] * rs, b1 = acc[ai][1][m][1] * rs;
                if (iswi) { if (fq == 0) { float* p = (float*)(ws + WS_AWI) + (size_t)row * 8; *(f32x4*)p = a0; *(f32x4*)(p + 4) = b0; } }
                else { if (normed) { const float s = red_fq((sum4sq(a0) + sum4sq(b0)) + (sum4sq(a1) + sum4sq(b1))); const float rq = __builtin_amdgcn_rsqf(s * (1.f / 64.f) + RMS_EPS);
                        a0 = a0 * g0a * rq; b0 = b0 * g0b * rq; a1 = a1 * g1a * rq; b1 = b1 * g1b * rq; }
                    bf16_t* p = dst + (size_t)row * ld + fq * 8; *(u32x4*)p = pack8(a0, b0); *(u32x4*)(p + 32) = pack8(a1, b1); } }
    }
};
template <class Epi, class Sched, bool ALIGN_EPI = false, bool SP2 = false>
__device__ __forceinline__ void gemm_phase(PG8_LAS unsigned char* lds, const Gemm g, const Sched& S, const Epi& E) {
    int tid_ = threadIdx.x; asm volatile("" : "+v"(tid_));
    const int tid = tid_, wid = __builtin_amdgcn_readfirstlane(tid >> 6), lane = tid & 63, wr = wid >> 2, wc = wid & 3, fr = lane & 15, fq = lane >> 4;
    const int K = g.K, nt = K / BK;
    unsigned voffA[2], voffB[2];
#pragma unroll
    for (int i = 0; i < 2; ++i) { int R, C; stage_rc(tid * 16 + i * 8192, R, C); const int Rb = Epi::PERM ? ((R & ~31) + perm32(R & 31)) : R;
        voffA[i] = (unsigned)(R * K + C) * 2u; voffB[i] = (unsigned)(Rb * K + C) * 2u; }
    const size_t kstep = (size_t)(BK * 2);
    const size_t hstep = (size_t)HALF * K * 2;
    const size_t tstep = 2 * hstep;
    const unsigned ldsw = (unsigned)wid * 1024u;
    const unsigned ldsb = (unsigned)__builtin_amdgcn_readfirstlane((int)((unsigned)(unsigned long long)lds + ldsw));
    const int aoff = lds_byte(wr * 64 + fr, fq * 8), boff = lds_byte(wc * 32 + fr, fq * 8);
#define PG8_SA(b, h) (((b) * 2 + (h)) * HTB)
#define PG8_SB(b, h) ((4 + (b) * 2 + (h)) * HTB)
#define PG8_STAGE(bufoff, gbase, voff) do { _Pragma("unroll") for (int _i = 0; _i < 2; ++_i) \
        pg8_glds16((const char*)(gbase), (voff)[_i], ldsb + (unsigned)((bufoff) + _i * 8192)); } while (0)
#define PG8_LDA(dst, b, h) do { _Pragma("unroll") for (int m = 0; m < 4; ++m) _Pragma("unroll") for (int k = 0; k < 2; ++k) dst[m][k] = *(const PG8_LAS bf16x8*)(lds + PG8_SA(b, h) + aoff + m * 2048 + k * 1024); } while (0)
#define PG8_LDB(dst, b, h) do { _Pragma("unroll") for (int n = 0; n < 2; ++n) _Pragma("unroll") for (int k = 0; k < 2; ++k) dst[n][k] = *(const PG8_LAS bf16x8*)(lds + PG8_SB(b, h) + boff + n * 2048 + k * 1024); } while (0)
#define PG8_MMA(ai, bj, At, Bt) do { __builtin_amdgcn_s_setprio(1); _Pragma("unroll") for (int m = 0; m < 4; ++m) _Pragma("unroll") for (int n = 0; n < 2; ++n) _Pragma("unroll") for (int k = 0; k < 2; ++k) \
        acc[ai][bj][m][n] = __builtin_amdgcn_mfma_f32_16x16x32_bf16(Bt[n][k], At[m][k], acc[ai][bj][m][n], 0, 0, 0); __builtin_amdgcn_s_setprio(0); } while (0)
#define PG8_WAIT_V(n) asm volatile("s_waitcnt vmcnt(" #n ")" ::: "memory")
#define PG8_WAIT_L(n) asm volatile("s_waitcnt lgkmcnt(" #n ")" ::: "memory")
#define PG8_BAR __builtin_amdgcn_s_barrier()
#define PG8_SCHED __builtin_amdgcn_sched_barrier(0)
    Unit cur, nxt; int ui = 0;
    if (!S.next(0, cur)) return;
    f32x4 acc[2][2][4][2];
#pragma unroll
    for (int a = 0; a < 2; ++a)
#pragma unroll
        for (int b = 0; b < 2; ++b)
#pragma unroll
            for (int m = 0; m < 4; ++m)
#pragma unroll
                for (int n = 0; n < 2; ++n) acc[a][b][m][n] = (f32x4){0.f, 0.f, 0.f, 0.f};
    bf16x8 At[4][2], B0[2][2], B1[2][2];
    const char* cA = (const char*)g.A + (size_t)cur.pm * tstep; const char* cB = (const char*)g.Bt + (size_t)cur.pn * tstep;
    S.a_ready(cur);
    if constexpr (SP2) {
        PG8_STAGE(PG8_SB(0, 0), cB, voffB); PG8_STAGE(PG8_SB(0, 1), cB + hstep, voffB); PG8_STAGE(PG8_SA(0, 0), cA, voffA); PG8_STAGE(PG8_SA(0, 1), cA + hstep, voffA);
        if (wr == 1) PG8_BAR;
        PG8_WAIT_V(2); PG8_BAR;
        PG8_STAGE(PG8_SB(1, 0), cB + kstep, voffB); PG8_STAGE(PG8_SA(1, 0), cA + kstep, voffA); PG8_STAGE(PG8_SB(1, 1), cB + hstep + kstep, voffB);
        PG8_WAIT_V(6); PG8_BAR;
    } else {
        PG8_STAGE(PG8_SB(0, 0), cB, voffB); PG8_STAGE(PG8_SA(0, 0), cA, voffA); PG8_STAGE(PG8_SB(0, 1), cB + hstep, voffB); PG8_STAGE(PG8_SA(0, 1), cA + hstep, voffA);
        if (wr == 1) PG8_BAR;
        PG8_WAIT_V(4); PG8_BAR;
        PG8_STAGE(PG8_SB(1, 0), cB + kstep, voffB); PG8_STAGE(PG8_SA(1, 0), cA + kstep, voffA); PG8_STAGE(PG8_SB(1, 1), cB + hstep + kstep, voffB);
        PG8_WAIT_V(6); PG8_BAR;
    }
    for (;;) {
        const bool has_next = S.next(ui + 1, nxt);
        const char* nA = has_next ? (const char*)g.A + (size_t)nxt.pm * tstep : cA; const char* nB = has_next ? (const char*)g.Bt + (size_t)nxt.pn * tstep : cB;
        for (int t = 0; t < nt; t += 2) {
            const bool last = (t == nt - 2);
            const char* a1 = cA + (size_t)(t + 1) * kstep;
            const char* a2 = last ? nA : cA + (size_t)(t + 2) * kstep; const char* b2 = last ? nB : cB + (size_t)(t + 2) * kstep;
            const char* a3 = a2 + kstep; const char* b3 = b2 + kstep;
            if (last && has_next) S.a_ready(nxt);
            if constexpr (SP2) {
            PG8_LDB(B0, 0, 0); PG8_LDB(B1, 0, 1); PG8_SCHED; PG8_LDA(At, 0, 0); PG8_STAGE(PG8_SA(1, 1), a1 + hstep, voffA);
            PG8_WAIT_V(8); PG8_WAIT_L(0); PG8_BAR; PG8_MMA(0, 0, At, B0); PG8_MMA(0, 1, At, B1); PG8_BAR; PG8_SCHED;
            PG8_LDA(At, 0, 1); PG8_STAGE(PG8_SB(0, 0), b2, voffB); PG8_STAGE(PG8_SB(0, 1), b2 + hstep, voffB); PG8_STAGE(PG8_SA(0, 0), a2, voffA);
            PG8_WAIT_V(8); PG8_WAIT_L(0); PG8_BAR; PG8_MMA(1, 0, At, B0); PG8_MMA(1, 1, At, B1); PG8_BAR; PG8_SCHED;
            PG8_LDB(B0, 1, 0); PG8_LDB(B1, 1, 1); PG8_SCHED; PG8_LDA(At, 1, 0); PG8_STAGE(PG8_SA(0, 1), a2 + hstep, voffA);
            PG8_WAIT_V(8); PG8_WAIT_L(0); PG8_BAR; PG8_MMA(0, 0, At, B0); PG8_MMA(0, 1, At, B1); PG8_BAR; PG8_SCHED;
            PG8_LDA(At, 1, 1); PG8_STAGE(PG8_SB(1, 0), b3, voffB); PG8_STAGE(PG8_SB(1, 1), b3 + hstep, voffB); PG8_STAGE(PG8_SA(1, 0), a3, voffA);
            PG8_WAIT_V(8); PG8_WAIT_L(0); PG8_BAR; PG8_MMA(1, 0, At, B0); PG8_MMA(1, 1, At, B1); PG8_BAR; PG8_SCHED;
            } else {
            PG8_LDB(B0, 0, 0); PG8_SCHED; PG8_LDA(At, 0, 0); PG8_STAGE(PG8_SA(1, 1), a1 + hstep, voffA);
            PG8_WAIT_L(8); PG8_BAR; PG8_WAIT_L(0); PG8_MMA(0, 0, At, B0); PG8_BAR; PG8_SCHED;
            PG8_LDB(B1, 0, 1); PG8_STAGE(PG8_SB(0, 0), b2, voffB);
            PG8_BAR; PG8_WAIT_L(0); PG8_MMA(0, 1, At, B1); PG8_BAR;
            PG8_LDA(At, 0, 1); PG8_STAGE(PG8_SA(0, 0), a2, voffA);
            PG8_BAR; PG8_WAIT_L(0); PG8_MMA(1, 0, At, B0); PG8_BAR; PG8_SCHED;
            PG8_STAGE(PG8_SB(0, 1), b2 + hstep, voffB);
            PG8_WAIT_V(6); PG8_BAR; PG8_MMA(1, 1, At, B1); PG8_BAR;
            PG8_LDB(B0, 1, 0); PG8_SCHED; PG8_LDA(At, 1, 0); PG8_STAGE(PG8_SA(0, 1), a2 + hstep, voffA);
            PG8_WAIT_L(8); PG8_BAR; PG8_WAIT_L(0); PG8_MMA(0, 0, At, B0); PG8_BAR; PG8_SCHED;
            PG8_LDB(B1, 1, 1); PG8_STAGE(PG8_SB(1, 0), b3, voffB);
            PG8_BAR; PG8_WAIT_L(0); PG8_MMA(0, 1, At, B1); PG8_BAR;
            PG8_LDA(At, 1, 1); PG8_STAGE(PG8_SA(1, 0), a3, voffA);
            PG8_BAR; PG8_WAIT_L(0); PG8_MMA(1, 0, At, B0); PG8_BAR; PG8_SCHED;
            PG8_STAGE(PG8_SB(1, 1), b3 + hstep, voffB);
            PG8_WAIT_V(6); PG8_BAR; PG8_MMA(1, 1, At, B1); PG8_BAR;
            }
        }
        if constexpr (ALIGN_EPI) { if (wr == 0) PG8_BAR; }
        if constexpr (!Epi::AFTER_DRAIN) { E(acc, cur, wr, wc, fr, fq); S.done(cur); }
        if (!has_next) break;
#pragma unroll
        for (int a = 0; a < 2; ++a)
#pragma unroll
            for (int b = 0; b < 2; ++b)
#pragma unroll
                for (int m = 0; m < 4; ++m)
#pragma unroll
                    for (int n = 0; n < 2; ++n) acc[a][b][m][n] = (f32x4){0.f, 0.f, 0.f, 0.f};
        cur = nxt; cA = nA; cB = nB; ++ui;
        if constexpr (ALIGN_EPI) { if (wr == 1) PG8_BAR; }
    }
    PG8_WAIT_V(0);
    if constexpr (!ALIGN_EPI) { if (wr == 0) PG8_BAR; }
    PG8_BAR;
    if constexpr (Epi::AFTER_DRAIN) { E.fused(acc, cur, wr, wc, fr, fq, lds, wid, lane); S.done(cur); }
#undef PG8_SA
#undef PG8_SB
#undef PG8_STAGE
#undef PG8_LDA
#undef PG8_LDB
#undef PG8_MMA
#undef PG8_WAIT_V
#undef PG8_WAIT_L
#undef PG8_BAR
#undef PG8_SCHED
}
}
__device__ __forceinline__ unsigned long long rt() { return __builtin_amdgcn_s_memrealtime(); }
__device__ __forceinline__ unsigned f2bf(float f) { unsigned u = __builtin_bit_cast(unsigned, f); return (u + 0x7fffu + ((u >> 16) & 1u)) >> 16; }
__device__ __forceinline__ unsigned pk2(float lo, float hi) { return f2bf(lo) | (f2bf(hi) << 16); }

#define XB_TMO      128
#define XB_XCNT(j)  (256  + 64 * (j))
#define XB_XSUB(j)  (1280 + 64 * (j))
#define XB_XGEN(j)  (2304 + 64 * (j))
#define XB_TOP      3328
#define XB_TOPGEN   3392
#define XCD_BAR_WORDS 3456
#define XB_SPIN_CAP (1u << 18)

__device__ __forceinline__ unsigned xb_ld(unsigned* p)              { return __hip_atomic_load(p, __ATOMIC_RELAXED, __HIP_MEMORY_SCOPE_AGENT); }
__device__ __forceinline__ unsigned xb_add(unsigned* p, unsigned v) { return __hip_atomic_fetch_add(p, v, __ATOMIC_RELAXED, __HIP_MEMORY_SCOPE_AGENT); }
__device__ __forceinline__ unsigned xb_xcc_id() { return (unsigned)__builtin_amdgcn_s_getreg((3 << 11) | 20) & 0xFu; }
#define XB_SPIN(cond, bar) do { unsigned _sp = 0; while (cond) { __builtin_amdgcn_s_sleep(1); \
    if ((++_sp & 255u) == 0u) { if (xb_ld(&(bar)[XB_TMO])) break; if (_sp > XB_SPIN_CAP) { atomicAdd(&(bar)[XB_TMO], 1u); break; } } } } while (0)

struct XcdBarrier {
    unsigned* bar; unsigned x;
    volatile LAS unsigned* st;
};

__device__ __forceinline__ XcdBarrier xcd_barrier_post(unsigned* bar, volatile LAS unsigned* st) {
    XcdBarrier b; b.bar = bar; b.x = xb_xcc_id(); b.st = st;
    if (threadIdx.x == 0) (void)xb_add(&bar[XB_XCNT(b.x)], 1u);
    return b;
}
__device__ __forceinline__ void xcd_barrier_complete(unsigned* bar, unsigned x, unsigned& nloc, unsigned& nx) {
    const unsigned G = gridDim.x * gridDim.y * gridDim.z;
    unsigned sum, cnt, mine, sp = 0u;
    for (;;) {
        sum = 0u; cnt = 0u; mine = 0u;
#pragma unroll
        for (unsigned j = 0; j < 16; ++j) { const unsigned c = xb_ld(&bar[XB_XCNT(j)]); sum += c; cnt += (c > 0u) ? 1u : 0u; }
        if (sum == G) break;
        __builtin_amdgcn_s_sleep(1);
        if ((++sp & 255u) == 0u) { if (xb_ld(&bar[XB_TMO])) break; if (sp > XB_SPIN_CAP) { atomicAdd(&bar[XB_TMO], 1u); break; } }
    }
    mine = xb_ld(&bar[XB_XCNT(x)]);
    nloc = mine > 0u ? mine : 1u; nx = cnt > 0u ? cnt : 1u;
}

__device__ __forceinline__ void xcd_barrier(const XcdBarrier& b) {
    asm volatile("s_waitcnt vmcnt(0)" ::: "memory");
    __syncthreads();
    if (threadIdx.x == 0) {
        unsigned* bar = b.bar;
        __builtin_amdgcn_s_waitcnt(0);
        unsigned nloc = b.st[0], nx = b.st[1];
        if (nloc == 0u) { xcd_barrier_complete(bar, b.x, nloc, nx); b.st[0] = nloc; b.st[1] = nx; }
        const unsigned old = xb_add(&bar[XB_XSUB(b.x)], 1u);
        const unsigned gen = old / nloc;
        if (old + 1u == (gen + 1u) * nloc) {
            __builtin_amdgcn_fence(__ATOMIC_RELEASE, "agent");
            asm volatile("s_waitcnt vmcnt(0)" ::: "memory");
            const unsigned og = xb_add(&bar[XB_TOP], 1u);
            const unsigned tg = og / nx;
            if (og + 1u == (tg + 1u) * nx) xb_add(&bar[XB_TOPGEN], 1u);
            else XB_SPIN(xb_ld(&bar[XB_TOPGEN]) == tg, bar);
            __builtin_amdgcn_fence(__ATOMIC_ACQUIRE, "agent");
            xb_add(&bar[XB_XGEN(b.x)], 1u);
            asm volatile("s_waitcnt vmcnt(0)" ::: "memory");
        } else {
            XB_SPIN(xb_ld(&bar[XB_XGEN(b.x)]) == gen, bar);
            __builtin_amdgcn_fence(__ATOMIC_ACQUIRE, "agent");
            asm volatile("s_waitcnt vmcnt(0)" ::: "memory");
        }
    }
    __syncthreads();
}


struct Frame {
    LAS unsigned char* lds;
    volatile LAS unsigned* MISC;
    gu32* ctl;
    int tid, lane, wave;
    int vcu, G, gw;
};
__device__ __forceinline__ float wave_sum(float v) {
#pragma unroll
    for (int o = 1; o < 64; o <<= 1) v += __shfl_xor(v, o);
    return v;
}
__device__ __forceinline__ int phys_row(int lc) { return (lc & ~255) + 128 * ((lc >> 5) & 1) + 32 * ((lc >> 6) & 3) + (lc & 31); }
__device__ __forceinline__ void tr_item128(const float* W, int ldw, int c0, int nvalid, const float* gain, bf16* WT, int Kd, int lc0, int k0, int lane) {
    const int h = lane >> 5, c = lane & 31; const bool act = 4 * c < nvalid;
    if (act) { const int prow = phys_row(lc0 + 4 * c), kb = k0 + 32 * h;
#pragma unroll
        for (int half = 0; half < 2; ++half) { f32x4 v[16];
#pragma unroll
            for (int i = 0; i < 16; ++i) v[i] = W ? __builtin_nontemporal_load((const GAS f32x4*)(W + (size_t)(kb + 16 * half + i) * ldw + c0 + 4 * c)) : (f32x4){0.f, 0.f, 0.f, 0.f};
            if (gain) {
#pragma unroll
                for (int q = 0; q < 4; ++q) { const f32x4 gv = *(const GAS f32x4*)(gain + kb + 16 * half + 4 * q);
#pragma unroll
                    for (int e = 0; e < 4; ++e) v[4 * q + e] = v[4 * q + e] * gv[e]; } }
#pragma unroll
            for (int e = 0; e < 4; ++e) { v4u o0, o1;
                o0.x = pk2(v[0][e], v[1][e]); o0.y = pk2(v[2][e], v[3][e]); o0.z = pk2(v[4][e], v[5][e]); o0.w = pk2(v[6][e], v[7][e]);
                o1.x = pk2(v[8][e], v[9][e]); o1.y = pk2(v[10][e], v[11][e]); o1.z = pk2(v[12][e], v[13][e]); o1.w = pk2(v[14][e], v[15][e]);
                bf16* dst = WT + (size_t)(prow + e) * Kd + kb + 16 * half; *(GAS v4u*)dst = o0; *(GAS v4u*)(dst + 8) = o1; } } }
}
__device__ __forceinline__ void conv_seg(Frame& F, int& rot, const float* W, int ldw, int c0, int ncols, const float* gain, bf16* WT, int Kd, int lc0) {
    const int ng = (ncols + 127) / 128, nk = Kd / 64, nit = ng * nk, NGW = F.G * NWAVES;
    int it = F.gw - rot; if (it < 0) it += NGW;
    for (; it < nit; it += NGW) { const int g = it % ng, kb = it / ng; int nv = ncols - 128 * g; nv = nv > 128 ? 128 : nv;
        tr_item128(W, ldw, c0 + 128 * g, nv, gain, WT, Kd, lc0 + 128 * g, 64 * kb, F.lane); }
    rot = (rot + nit) % NGW;
}
__device__ __forceinline__ void p0_prologue(Frame& F) {
    int rot = 0;
#define ws wsp()
    const int NGW = F.G * NWAVES;
    { bf16* hb = (bf16*)(ws + WS_HB); float* ssq = (float*)(ws + WS_SSQH); const float* x = inp(0);
      for (int r = 2 * F.gw; r < M; r += 2 * NGW) { f32x4 v[2][4]; float s[2];
#pragma unroll
          for (int rr = 0; rr < 2; ++rr) { const GAS f32x4* xr = (const GAS f32x4*)(x + (size_t)(r + rr) * D) + F.lane;
#pragma unroll
              for (int j = 0; j < 4; ++j) v[rr][j] = __builtin_nontemporal_load(xr + 64 * j); }
#pragma unroll
          for (int rr = 0; rr < 2; ++rr) { float t = 0.f;
#pragma unroll
              for (int j = 0; j < 4; ++j) t += (v[rr][j].x * v[rr][j].x + v[rr][j].y * v[rr][j].y) + (v[rr][j].z * v[rr][j].z + v[rr][j].w * v[rr][j].w);
              s[rr] = wave_sum(t);
              GAS unsigned long long* o8 = (GAS unsigned long long*)(hb + (size_t)(r + rr) * D) + F.lane;
#pragma unroll
              for (int j = 0; j < 4; ++j) o8[64 * j] = (unsigned long long)pk2(v[rr][j].x, v[rr][j].y) | ((unsigned long long)pk2(v[rr][j].z, v[rr][j].w) << 32);
              if (F.lane < 16) ssq[(size_t)(r + rr) * 16 + F.lane] = F.lane == 0 ? s[rr] : 0.f; } } }
    { float* ct = (float*)(ws + WS_ROPE); float* st = ct + SEQ * 16;
      for (int e = F.vcu * 512 + F.tid; e < SEQ * 16; e += F.G * 512) { const int pos = e >> 4, i = e & 15;
          const double invd = i == 0 ? 1.0 : i == 1 ? 0.5623413251903491 : i == 2 ? 0.31622776601683794 : i == 3 ? 0.17782794100389226 : i == 4 ? 0.1 : i == 5 ? 0.056234132519034905 : i == 6 ? 0.03162277660168379 : i == 7 ? 0.01778279410038923 :
                              i == 8 ? 0.01 : i == 9 ? 0.005623413251903491 : i == 10 ? 0.003162277660168379 : i == 11 ? 0.001778279410038923 : i == 12 ? 0.001 : i == 13 ? 0.0005623413251903491 : i == 14 ? 0.00031622776601683794 : 0.00017782794100389227;
          const float angf = (float)pos * (float)invd; const double a = (double)angf;
          const double nq = __builtin_rint(a * 0.6366197723675814); const double r = (a - nq * 1.5707963267948966) - nq * 6.123233995736766e-17; const double r2 = r * r;
          const double sn = r * (1.0 + r2 * (-1.0 / 6 + r2 * (1.0 / 120 + r2 * (-1.0 / 5040 + r2 * (1.0 / 362880 + r2 * (-1.0 / 39916800 + r2 * (1.0 / 6227020800.0)))))));
          const double cs = 1.0 + r2 * (-0.5 + r2 * (1.0 / 24 + r2 * (-1.0 / 720 + r2 * (1.0 / 40320 + r2 * (-1.0 / 3628800 + r2 * (1.0 / 479001600.0 + r2 * (-1.0 / 87178291200.0)))))));
          const int q = (int)nq & 3; const double c = q == 0 ? cs : q == 1 ? -sn : q == 2 ? -cs : sn, s = q == 0 ? sn : q == 1 ? cs : q == 2 ? -sn : -cs;
          ct[e] = (float)c; st[e] = (float)s; } }
    for (int i = 0; i < 2; ++i) { const float* W = inp(3) + (size_t)i * D * A_IN; const float* g = inp(2) + i * D; bf16* WT = (bf16*)(ws + WS_WIN) + (size_t)i * WIN_ELEMS;
        conv_seg(F, rot, W, A_IN, 0, 1152, g, WT, D, 0);
        conv_seg(F, rot, W, A_IN, 1664, 64, g, WT, D, 1152);
        conv_seg(F, rot, W, A_IN, 1728, 8, g, WT, D, 1216);
        conv_seg(F, rot, nullptr, 0, 0, 56, nullptr, WT, D, 1224);
        conv_seg(F, rot, W, A_IN, 1152, 512, g, WT, D, 1280);
        conv_seg(F, rot, inp(6) + (size_t)i * D * D, D, 0, D, nullptr, (bf16*)(ws + WS_WOA) + (size_t)i * D * D, D, 0); }
    { bf16* WT = (bf16*)(ws + WS_WKVQ);
      conv_seg(F, rot, inp(8), 288, 0, 256, inp(7), WT, D, 0);
      conv_seg(F, rot, inp(13), QLORA, 0, QLORA, inp(12), WT, D, 256);
      conv_seg(F, rot, inp(8), 288, 256, 32, inp(7), WT, D, 640);
      conv_seg(F, rot, nullptr, 0, 0, 96, nullptr, WT, D, 672); }
    conv_seg(F, rot, inp(10), NUKV, 0, NUKV, inp(9), (bf16*)(ws + WS_WUKV), KVLORA, 0);
    { bf16* WT = (bf16*)(ws + WS_WDQ1);
      conv_seg(F, rot, inp(13) + (size_t)D * QLORA, QLORA, 0, QLORA, inp(12) + D, WT, D, 0);
      conv_seg(F, rot, nullptr, 0, 0, 128, nullptr, WT, D, 384); }
    for (int j = 0; j < 2; ++j) {
        conv_seg(F, rot, inp(15) + (size_t)j * QLORA * NUQ, NUQ, 0, NUQ, inp(14) + j * QLORA, (bf16*)(ws + WS_WUQ) + (size_t)j * WUQ_ELEMS, QLORA, 0);
        conv_seg(F, rot, inp(17) + (size_t)j * D * D, D, 0, D, nullptr, (bf16*)(ws + WS_WOB) + (size_t)j * D * D, D, 0); }
    for (int L = 0; L < 4; ++L) {
        conv_seg(F, rot, inp(19) + (size_t)L * D * FF, FF, 0, FF, inp(18) + L * D, (bf16*)(ws + WS_WUP) + (size_t)L * D * FF, D, 0);
        conv_seg(F, rot, inp(20) + (size_t)L * D * FF, D, 0, D, nullptr, (bf16*)(ws + WS_WDN) + (size_t)L * D * FF, FF, 0); }
#undef ws
}
namespace mla {
using bf16x8 = __attribute__((ext_vector_type(8))) short;
using s16x4  = __attribute__((ext_vector_type(4))) short;
using f32x16 = __attribute__((ext_vector_type(16))) float;
using u32x4  = __attribute__((ext_vector_type(4))) unsigned;
typedef __attribute__((address_space(3))) const char* lds_cptr;
typedef short v4i16_t __attribute__((ext_vector_type(4)));
constexpr int NW = 8, QBLK = 32, KVBLK = 64, LDQ = 1536, LDK = 96, LDV = 64, LDO = 1024, SEQL = 4096;
constexpr float SCALE = 0.10206207261596575f;
constexpr float THRL = 8.f;
constexpr int SHM_K = KVBLK * 96 * 2, SHM_V = KVBLK * 64 * 2;
constexpr int NSLOT = 5, SLOTB = SHM_K + SHM_V;
constexpr int LDS_OST = NSLOT * SLOTB, LDS_WS = LDS_OST + NW * 4096;
constexpr int SHM_ATTN = LDS_WS + NW * 256;
#define SBAR() __builtin_amdgcn_sched_barrier(0)
#define PIN(x) asm volatile("" : "+v"(x))
#define MFMA(a, b, c) __builtin_amdgcn_mfma_f32_32x32x16_bf16((a), (b), (c), 0, 0, 0)
__device__ __forceinline__ int crow(int r, int hi) { return (r & 3) + 8 * (r >> 2) + 4 * hi; }
__device__ __forceinline__ unsigned cvtpk(float lo, float hi) { return pg8::cvt_pk_bf16(lo, hi); }
__device__ __forceinline__ float bf2f(short s) { return __uint_as_float(((unsigned)(unsigned short)s) << 16); }
__device__ __forceinline__ void kload2(bf16x8* kf, lds_cptr kp, int d0) { kf[2 * d0] = *(const __attribute__((address_space(3))) bf16x8*)(kp + d0 * 2048); kf[2 * d0 + 1] = *(const __attribute__((address_space(3))) bf16x8*)(kp + d0 * 2048 + 512); }
__device__ __forceinline__ s16x4 vtr(lds_cptr p) { return __builtin_bit_cast(s16x4, __builtin_amdgcn_ds_read_tr16_b64_v4i16((__attribute__((address_space(3))) v4i16_t*)p)); }
#define MX3(a, b, c) __builtin_fmaxf(__builtin_fmaxf((a), (b)), (c))
__device__ __forceinline__ float rowmax(const f32x16& p0, const f32x16& p1) {
  float a = MX3(p0[0], p0[1], p1[0]), b = MX3(p0[2], p0[3], p1[1]); a = MX3(a, p1[2], p1[3]);
#pragma unroll
  for (int r = 4; r < 16; r += 4) { a = MX3(a, p0[r], p0[r + 1]); b = MX3(b, p0[r + 2], p0[r + 3]); a = MX3(a, p1[r], p1[r + 1]); b = MX3(b, p1[r + 2], p1[r + 3]); }
  float m = __builtin_fmaxf(a, b); auto rr = __builtin_amdgcn_permlane32_swap(__float_as_uint(m), __float_as_uint(m), false, false);
  return __builtin_fmaxf(__uint_as_float(rr[0]), __uint_as_float(rr[1])); }

__device__ __forceinline__ void attn_unit(const pg8::bf16_t* __restrict__ Qh, const pg8::bf16_t* __restrict__ Kh, const pg8::bf16_t* __restrict__ Vh, pg8::bf16_t* __restrict__ Oh,
                                          const float* __restrict__ qgain, const float* __restrict__ cosT, const float* __restrict__ sinT, int qb, char* lds,
                                          const pg8::bf16_t* __restrict__ Kn, const pg8::bf16_t* __restrict__ Vn, bool pre, int& ring) {
  int tid_ = threadIdx.x; asm volatile("" : "+v"(tid_));
  const int tid = tid_, wid = __builtin_amdgcn_readfirstlane(tid >> 6), lane = tid & 63, r32 = lane & 31, hi = lane >> 5;
  float* wsf = (float*)(lds + LDS_WS) + wid * 64;
  float m_reg = 0.f, l_reg = 0.f; f32x16 o[2]; o[0] = f32x16{}; o[1] = f32x16{}; bf16x8 qr[6];
  f32x16 negm = f32x16{}; PIN(negm);
  const int q0 = qb * 256, qrow = q0 + wid * QBLK + r32;
  const int NT = 4 * qb + 4, cqw = 4 * qb + (wid >> 1);
  const unsigned kvo0 = (unsigned)(lane * (LDK * 2) + wid * 16), kvo1 = (unsigned)(lane * (LDK * 2) + (8 + (wid & 3)) * 16);
  const unsigned vvo = (unsigned)((16 * (wid & 3) + (lane >> 2)) * (LDV * 2) + (wid >> 2) * 64 + (lane & 3) * 16);
  const unsigned lds0 = (unsigned)(uintptr_t)lds;
#define DMA(t, sl) do { const bool nx_ = (t) >= NT && Kn != nullptr; const int tt_ = (t) < NT ? (t) : (nx_ ? (t) - NT : NT - 1); const unsigned sl_ = lds0 + (sl);     \
    const char* kb_ = (const char*)(nx_ ? Kn : Kh) + (size_t)tt_ * (KVBLK * LDK * 2); const char* vb_ = (const char*)(nx_ ? Vn : Vh) + (size_t)tt_ * (KVBLK * LDV * 2);  \
    pg8::pg8_glds16(kb_, kvo0, sl_ + wid * 1024); pg8::pg8_glds16(kb_, kvo1, sl_ + (8 + (wid & 3)) * 1024); pg8::pg8_glds16(vb_, vvo, sl_ + SHM_K + wid * 1024); } while (0)
#define VMWAIT(n) asm volatile("s_waitcnt vmcnt(" #n ")" ::: "memory")
#define BAR() __builtin_amdgcn_s_barrier()
  const lds_cptr vp0 = (lds_cptr)lds + SHM_K + ((lane >> 4) & 1) * 32 + (lane & 3) * 8 + (4 * hi + ((lane & 15) >> 2)) * 64;
  const lds_cptr kp0 = (lds_cptr)lds + hi * 1024 + r32 * 16;
#define WRAP(x) ((x) >= NSLOT * SLOTB ? (x) - NSLOT * SLOTB : (x))
  const int s0_ = ring, s1_ = WRAP(s0_ + SLOTB), s2_ = WRAP(s1_ + SLOTB), s3_ = WRAP(s2_ + SLOTB), s4_ = WRAP(s3_ + SLOTB);
  if (!pre) { DMA(0, s0_); DMA(1, s1_); DMA(2, s2_); }
  {
    const pg8::bf16_t* Qw = Qh + (size_t)qrow * LDQ + hi * 8; float qf[6][8]; float ss = 0.f;
#pragma unroll
    for (int d0 = 0; d0 < 6; ++d0) { const bf16x8 raw = *reinterpret_cast<const bf16x8*>(Qw + d0 * 16);
#pragma unroll
      for (int j = 0; j < 8; ++j) { qf[d0][j] = bf2f(raw[j]); ss += qf[d0][j] * qf[d0][j]; } }
    { auto rr = __builtin_amdgcn_permlane32_swap(__float_as_uint(ss), __float_as_uint(ss), false, false); ss = __uint_as_float(rr[0]) + __uint_as_float(rr[1]); }
    const float rq = __builtin_amdgcn_rsqf(ss * (1.f / 96.f) + 1e-6f);
#pragma unroll
    for (int d0 = 0; d0 < 6; ++d0)
#pragma unroll
      for (int j = 0; j < 8; ++j) qf[d0][j] *= (rq * (SCALE * 1.4426950408889634f)) * qgain[d0 * 16 + hi * 8 + j];
#pragma unroll
    for (int j = 0; j < 8; ++j) { const float c = cosT[qrow * 16 + hi * 8 + j], s = sinT[qrow * 16 + hi * 8 + j]; const float x1 = qf[4][j], x2 = qf[5][j];
      qf[4][j] = x1 * c - x2 * s; qf[5][j] = x2 * c + x1 * s; }
#pragma unroll
    for (int d0 = 0; d0 < 6; ++d0) { u32x4 w = {cvtpk(qf[d0][0], qf[d0][1]), cvtpk(qf[d0][2], qf[d0][3]), cvtpk(qf[d0][4], qf[d0][5]), cvtpk(qf[d0][6], qf[d0][7])}; qr[d0] = __builtin_bit_cast(bf16x8, w); }
  }
  bool resc = false;
  f32x16 pA0, pA1, pB0, pB1; bf16x8 kf[12]; s16x4 vlo[4], vhi[4]; u32x4 pw0, pw1, pw2, pw3;
  int sl_prev = s0_, sl_cur = s1_, sl_next = s2_;
#define ROT() do { sl_prev = sl_cur; sl_cur = sl_next; sl_next = (sl_next == (NSLOT - 1) * SLOTB) ? 0 : sl_next + SLOTB; } while (0)
#define EX(v) __builtin_amdgcn_exp2f(v)
#define RESC() do { if (resc) { _Pragma("unroll") for (int d_ = 0; d_ < 2; ++d_) _Pragma("unroll") for (int r = 0; r < 16; ++r) o[d_][r] *= wsf[crow(r, hi)]; } } while (0)
#define DECIDE(C0, C1) do { const float pm_ = rowmax(C0, C1); resc = false;                                                              \
    if (__builtin_expect(__any(pm_ > THRL), 0)) { const float dl = __builtin_fmaxf(pm_, 0.f); m_reg += dl; const float nm_ = -m_reg;      \
      asm volatile("s_nop 15\n\ts_nop 7" ::: "memory");           \
      _Pragma("unroll") for (int r = 0; r < 16; ++r) { float a_ = C0[r], b_ = C1[r], c_ = negm[r];               \
        asm volatile("v_sub_f32 %0, %0, %3\n\tv_sub_f32 %1, %1, %3\n\tv_mov_b32 %2, %4" : "+v"(a_), "+v"(b_), "+v"(c_) : "v"(dl), "v"(nm_)); C0[r] = a_; C1[r] = b_; negm[r] = c_; } \
      const float f = __builtin_amdgcn_exp2f(-dl); l_reg *= f; if (hi == 0) wsf[r32] = f; resc = true; }                                  \
    PIN(negm); } while (0)
  VMWAIT(0); BAR();
  DMA(3, s3_);
  _Pragma("unroll") for (int d0 = 0; d0 < 6; ++d0) kload2(kf, kp0 + s0_, d0);
  pA0 = MFMA(kf[0], qr[0], negm); pA1 = MFMA(kf[1], qr[0], negm);
  _Pragma("unroll") for (int d0 = 1; d0 < 6; ++d0) { pA0 = MFMA(kf[2 * d0], qr[d0], pA0); pA1 = MFMA(kf[2 * d0 + 1], qr[d0], pA1); }
  DECIDE(pA0, pA1);
  _Pragma("unroll") for (int r = 0; r < 16; ++r) pA0[r] = EX(pA0[r]);
  _Pragma("unroll") for (int r = 0; r < 8; ++r) pA1[r] = EX(pA1[r]);
  _Pragma("unroll") for (int d0 = 0; d0 < 3; ++d0) kload2(kf, kp0 + s1_, d0);
  BAR(); RESC();
  DMA(4, s4_);
#define PKW(P, i) cvtpk(P[i], P[i + 1])
#define PAF(k) __builtin_bit_cast(bf16x8, pw##k)
#define VFR(s) (bf16x8){vlo[s][0], vlo[s][1], vlo[s][2], vlo[s][3], vhi[s][0], vhi[s][1], vhi[s][2], vhi[s][3]}
#define VRD(s, i) do { vlo[s] = vtr(vp_ + (((i) >> 2) * 4096 + ((i) & 3) * 1024)); vhi[s] = vtr(vp_ + (((i) >> 2) * 4096 + ((i) & 3) * 1024 + 512)); } while (0)
#define KRDN(d0) do { kload2(kf, kp0 + sl_next, d0); SBAR(); } while (0)
#define KRDC(d0) do { kload2(kf, kp0 + sl_cur, d0); SBAR(); } while (0)
#define STEP(C0, C1, P0, P1, t) do { SBAR(); const lds_cptr vp_ = vp0 + sl_prev; float sacc = 0.f; \
    KRDC(3); C0 = MFMA(kf[0], qr[0], negm); P1[8] = EX(P1[8]); PIN(P1); sacc += P0[0]; sacc += P0[1]; sacc += P0[2]; pw0[0] = PKW(P0, 0); PIN(pw0); PIN(sacc); SBAR(); \
    KRDC(4); C1 = MFMA(kf[1], qr[0], negm); P1[9] = EX(P1[9]); PIN(P1); sacc += P0[3]; sacc += P0[4]; sacc += P0[5]; pw0[1] = PKW(P0, 2); PIN(pw0); PIN(sacc); SBAR(); \
    KRDC(5); C0 = MFMA(kf[2], qr[1], C0); P1[10] = EX(P1[10]); PIN(P1); sacc += P0[6]; sacc += P0[7]; sacc += P0[8]; pw0[2] = PKW(P0, 4); pw2[0] = PKW(P1, 0); PIN(pw0); PIN(pw2); PIN(sacc); SBAR(); \
    C1 = MFMA(kf[3], qr[1], C1); P1[11] = EX(P1[11]); PIN(P1); sacc += P0[9]; sacc += P0[10]; sacc += P0[11]; pw0[3] = PKW(P0, 6); pw2[1] = PKW(P1, 2); PIN(pw0); PIN(pw2); PIN(sacc); SBAR(); \
    C0 = MFMA(kf[4], qr[2], C0); P1[12] = EX(P1[12]); PIN(P1); sacc += P0[12]; sacc += P0[13]; sacc += P0[14]; pw1[0] = PKW(P0, 8); pw2[2] = PKW(P1, 4); PIN(pw1); PIN(pw2); PIN(sacc); SBAR(); \
    C1 = MFMA(kf[5], qr[2], C1); P1[13] = EX(P1[13]); PIN(P1); sacc += P0[15]; sacc += P1[0]; sacc += P1[1]; pw1[1] = PKW(P0, 10); pw2[3] = PKW(P1, 6); PIN(pw1); PIN(pw2); PIN(sacc); SBAR(); \
    C0 = MFMA(kf[6], qr[3], C0); P1[14] = EX(P1[14]); PIN(P1); sacc += P1[2]; sacc += P1[3]; sacc += P1[4]; pw1[2] = PKW(P0, 12); PIN(pw1); PIN(sacc); SBAR(); \
    C1 = MFMA(kf[7], qr[3], C1); P1[15] = EX(P1[15]); PIN(P1); sacc += P1[5]; sacc += P1[6]; sacc += P1[7]; pw1[3] = PKW(P0, 14); PIN(pw1); PIN(sacc); SBAR(); \
    VRD(0, 0); SBAR(); C0 = MFMA(kf[8], qr[4], C0); sacc += P1[8]; sacc += P1[9]; sacc += P1[10]; pw3[0] = PKW(P1, 8); PIN(pw3); PIN(sacc); SBAR(); \
    VRD(1, 4); SBAR(); C1 = MFMA(kf[9], qr[4], C1); sacc += P1[11]; sacc += P1[12]; sacc += P1[13]; pw3[1] = PKW(P1, 10); PIN(pw3); PIN(sacc); SBAR(); \
    VRD(2, 1); SBAR(); C0 = MFMA(kf[10], qr[5], C0); sacc += P1[14]; sacc += P1[15]; pw3[2] = PKW(P1, 12); PIN(pw3); PIN(sacc); SBAR(); \
    VRD(3, 5); SBAR(); C1 = MFMA(kf[11], qr[5], C1); pw3[3] = PKW(P1, 14); PIN(pw3); PIN(sacc); SBAR(); \
    l_reg += sacc; \
    if ((t) > cqw) { asm volatile("" ::: "memory"); _Pragma("unroll") for (int r = 0; r < 16; ++r) { C0[r] = -1e30f; C1[r] = -1e30f; } PIN(C0); PIN(C1); }     \
    DECIDE(C0, C1); SBAR(); \
    o[0] = MFMA(PAF(0), VFR(0), o[0]); VRD(0, 2); C0[0] = EX(C0[0]); C0[1] = EX(C0[1]); C0[2] = EX(C0[2]); PIN(C0); SBAR(); \
    KRDN(0); o[1] = MFMA(PAF(0), VFR(1), o[1]); VRD(1, 6); C0[3] = EX(C0[3]); C0[4] = EX(C0[4]); C0[5] = EX(C0[5]); PIN(C0); SBAR(); \
    o[0] = MFMA(PAF(1), VFR(2), o[0]); VRD(2, 3); C0[6] = EX(C0[6]); C0[7] = EX(C0[7]); C0[8] = EX(C0[8]); PIN(C0); SBAR(); \
    KRDN(1); o[1] = MFMA(PAF(1), VFR(3), o[1]); VRD(3, 7); C0[9] = EX(C0[9]); C0[10] = EX(C0[10]); C0[11] = EX(C0[11]); PIN(C0); SBAR(); \
    o[0] = MFMA(PAF(2), VFR(0), o[0]); C0[12] = EX(C0[12]); C0[13] = EX(C0[13]); C0[14] = EX(C0[14]); PIN(C0); SBAR(); \
    KRDN(2); o[1] = MFMA(PAF(2), VFR(1), o[1]); C0[15] = EX(C0[15]); C1[0] = EX(C1[0]); C1[1] = EX(C1[1]); PIN(C0); PIN(C1); SBAR(); \
    o[0] = MFMA(PAF(3), VFR(2), o[0]); C1[2] = EX(C1[2]); C1[3] = EX(C1[3]); C1[4] = EX(C1[4]); PIN(C0); PIN(C1); SBAR(); \
    o[1] = MFMA(PAF(3), VFR(3), o[1]); C1[5] = EX(C1[5]); C1[6] = EX(C1[6]); C1[7] = EX(C1[7]); PIN(C0); PIN(C1); SBAR(); \
    } while (0)
  for (int t = 1; t + 1 < NT; t += 2) {
    STEP(pB0, pB1, pA0, pA1, t);     VMWAIT(3); BAR(); RESC(); DMA(t + 4, sl_prev); ROT();
    STEP(pA0, pA1, pB0, pB1, t + 1); VMWAIT(3); BAR(); RESC(); DMA(t + 5, sl_prev); ROT();
  }
  STEP(pB0, pB1, pA0, pA1, NT - 1); RESC();
  { _Pragma("unroll") for (int r = 8; r < 16; ++r) pB1[r] = EX(pB1[r]);
    float sacc = 0.f;
#pragma unroll
    for (int r = 0; r < 16; ++r) sacc += pB0[r];
#pragma unroll
    for (int r = 0; r < 16; ++r) sacc += pB1[r];
    l_reg += sacc;
    pw0 = (u32x4){PKW(pB0, 0), PKW(pB0, 2), PKW(pB0, 4), PKW(pB0, 6)}; pw1 = (u32x4){PKW(pB0, 8), PKW(pB0, 10), PKW(pB0, 12), PKW(pB0, 14)};
    pw2 = (u32x4){PKW(pB1, 0), PKW(pB1, 2), PKW(pB1, 4), PKW(pB1, 6)}; pw3 = (u32x4){PKW(pB1, 8), PKW(pB1, 10), PKW(pB1, 12), PKW(pB1, 14)};
    const lds_cptr vp_ = vp0 + sl_cur;
    VRD(0, 0); VRD(1, 4); VRD(2, 1); VRD(3, 5);
    o[0] = MFMA(PAF(0), VFR(0), o[0]); o[1] = MFMA(PAF(0), VFR(1), o[1]); o[0] = MFMA(PAF(1), VFR(2), o[0]); o[1] = MFMA(PAF(1), VFR(3), o[1]);
    VRD(0, 2); VRD(1, 6); VRD(2, 3); VRD(3, 7);
    o[0] = MFMA(PAF(2), VFR(0), o[0]); o[1] = MFMA(PAF(2), VFR(1), o[1]); o[0] = MFMA(PAF(3), VFR(2), o[0]); o[1] = MFMA(PAF(3), VFR(3), o[1]); }
  { auto rr = __builtin_amdgcn_permlane32_swap(__float_as_uint(l_reg), __float_as_uint(l_reg), false, false); l_reg = __uint_as_float(rr[0]) + __uint_as_float(rr[1]); }
  if (hi == 0) wsf[32 + r32] = l_reg; asm volatile("s_waitcnt lgkmcnt(0)" ::: "memory");
  float rli[16];
#pragma unroll
  for (int r = 0; r < 16; ++r) rli[r] = __builtin_amdgcn_rcpf(wsf[32 + crow(r, hi)]);
  pg8::bf16_t* Ow = Oh + (size_t)(q0 + wid * QBLK) * LDO; unsigned short* stg = (unsigned short*)(lds + LDS_OST) + wid * 2048;
#pragma unroll
  for (int r = 0; r < 16; ++r) { const int orow = crow(r, hi);
#pragma unroll
    for (int d0 = 0; d0 < 2; ++d0) stg[orow * 64 + d0 * 32 + r32] = (unsigned short)(cvtpk(o[d0][r] * rli[r], 0.f) & 0xffffu); }
  asm volatile("s_waitcnt lgkmcnt(0)" ::: "memory");
#pragma unroll
  for (int i = 0; i < 4; ++i) { const int row = i * 8 + (lane >> 3), ch = lane & 7; *(u32x4*)(Ow + (size_t)row * LDO + ch * 8) = *(const u32x4*)(stg + row * 64 + ch * 8); }
  ring = sl_next;
  asm volatile("s_waitcnt vmcnt(0) lgkmcnt(0)" ::: "memory"); BAR();
#undef DMA
#undef WRAP
#undef VMWAIT
#undef BAR
#undef ROT
#undef EX
#undef RESC
#undef DECIDE
#undef PKW
#undef PAF
#undef VFR
#undef VRD
#undef KRDN
#undef KRDC
#undef STEP
}
#undef SBAR
#undef PIN
#undef MFMA
#undef MX3
}

namespace dsa {
using bf16x8 = __attribute__((ext_vector_type(8))) short;
using s16x4  = __attribute__((ext_vector_type(4))) short;
using f32x4  = __attribute__((ext_vector_type(4))) float;
using u32x4  = __attribute__((ext_vector_type(4))) unsigned;
using u32x2  = __attribute__((ext_vector_type(2))) unsigned;
typedef unsigned short bf16_t;
constexpr int L_LIST = 0, L_BIAS = 16384, L_U = 18432, L_END = L_U + 131072;
constexpr float LOG2E = 1.4426950408889634f;
constexpr unsigned INVALID_ENTRY = 0x003f0000u;
__device__ __forceinline__ void glds16v(const void* gsrc, unsigned lds_dst) { unsigned keep;
    asm volatile("s_mov_b32 %0, m0\n\ts_mov_b32 m0, %2\n\ts_nop 0\n\tglobal_load_lds_dwordx4 %1, off\n\ts_mov_b32 m0, %0" : "=&s"(keep) : "v"(gsrc), "s"(lds_dst) : "memory"); }
__device__ __forceinline__ int t5_bucket(int rel) {
    const int n = rel < 0 ? -rel : rel; int b = n;
    if (n >= 8) { const int e = 31 - __builtin_clz(n); int v = 8 + 2 * (e - 3) + ((n * n) >= (2 << (2 * e)) ? 1 : 0); b = v > 15 ? 15 : v; }
    return b + (rel > 0 ? 16 : 0);
}
template <int OFF> __device__ __forceinline__ s16x4 trrdo(unsigned addr) { s16x4 r; asm volatile("ds_read_b64_tr_b16 %0, %1 offset:%2" : "=v"(r) : "v"(addr), "i"(OFF) : "memory"); return r; }
#define DSA_DPP(v, ctrl) __builtin_amdgcn_update_dpp(0, (v), (ctrl), 0xf, 0xf, true)
__device__ __forceinline__ int half_sum(int v) { v += DSA_DPP(v, 0xB1); v += DSA_DPP(v, 0x4E); v += DSA_DPP(v, 0x141); v += DSA_DPP(v, 0x140);
    auto r = __builtin_amdgcn_permlane16_swap((unsigned)v, (unsigned)v, false, false); return (int)(r[0] + r[1]); }
__device__ __forceinline__ float half_min(float x) { int v = __float_as_int(x);
#define DSA_STEP(ctrl) v = __float_as_int(fminf(__int_as_float(v), __int_as_float(DSA_DPP(v, ctrl))))
    DSA_STEP(0xB1); DSA_STEP(0x4E); DSA_STEP(0x141); DSA_STEP(0x140);
#undef DSA_STEP
    auto r = __builtin_amdgcn_permlane16_swap((unsigned)v, (unsigned)v, false, false); return fminf(__uint_as_float(r[0]), __uint_as_float(r[1])); }
__device__ __forceinline__ float half_max(float x) { int v = __float_as_int(x);
#define DSA_STEP(ctrl) v = __float_as_int(fmaxf(__int_as_float(v), __int_as_float(DSA_DPP(v, ctrl))))
    DSA_STEP(0xB1); DSA_STEP(0x4E); DSA_STEP(0x141); DSA_STEP(0x140);
#undef DSA_STEP
    auto r = __builtin_amdgcn_permlane16_swap((unsigned)v, (unsigned)v, false, false); return fmaxf(__uint_as_float(r[0]), __uint_as_float(r[1])); }
__device__ __forceinline__ void cnt4(int& cnt, float a, float b, float c, float d, float thr) {
    unsigned long long m0, m1, m2, m3;
    asm("v_cmp_gt_f32_e64 %1, %5, %9\n\tv_cmp_gt_f32_e64 %2, %6, %9\n\tv_cmp_gt_f32_e64 %3, %7, %9\n\tv_cmp_gt_f32_e64 %4, %8, %9\n\t"
        "v_addc_co_u32_e64 %0, %1, %0, 0, %1\n\tv_addc_co_u32_e64 %0, %2, %0, 0, %2\n\tv_addc_co_u32_e64 %0, %3, %0, 0, %3\n\tv_addc_co_u32_e64 %0, %4, %0, 0, %4"
        : "+v"(cnt), "=&s"(m0), "=&s"(m1), "=&s"(m2), "=&s"(m3) : "v"(a), "v"(b), "v"(c), "v"(d), "v"(thr));
}
using f32x2 = __attribute__((ext_vector_type(2))) float;
#define QNAN __builtin_nanf("")
__device__ __forceinline__ void cntp4(f32x2& ca, f32x2& cb, f32x2 s0, f32x2 s1, f32x2 s2, f32x2 s3, f32x2 big, f32x2 ntb) {
    f32x2 c0, c1, c2, c3;
    asm("v_pk_fma_f32 %2, %6, %10, %11 clamp\n\tv_pk_fma_f32 %3, %7, %10, %11 clamp\n\tv_pk_fma_f32 %4, %8, %10, %11 clamp\n\tv_pk_fma_f32 %5, %9, %10, %11 clamp\n\t"
        "v_pk_add_f32 %0, %0, %2\n\tv_pk_add_f32 %1, %1, %3\n\tv_pk_add_f32 %0, %0, %4\n\tv_pk_add_f32 %1, %1, %5"
        : "+v"(ca), "+v"(cb), "=&v"(c0), "=&v"(c1), "=&v"(c2), "=&v"(c3) : "v"(s0), "v"(s1), "v"(s2), "v"(s3), "v"(big), "v"(ntb)); }
__device__ __forceinline__ void selmap4(unsigned& map, float a, float b, float c, float d, float thr) {
    unsigned long long m0, m1, m2, m3;
    asm("v_cmp_gt_f32_e64 %1, %5, %9\n\tv_cmp_gt_f32_e64 %2, %6, %9\n\tv_cmp_gt_f32_e64 %3, %7, %9\n\tv_cmp_gt_f32_e64 %4, %8, %9\n\t"
        "v_addc_co_u32_e64 %0, %1, %0, %0, %1\n\tv_addc_co_u32_e64 %0, %2, %0, %0, %2\n\tv_addc_co_u32_e64 %0, %3, %0, %0, %3\n\tv_addc_co_u32_e64 %0, %4, %0, %0, %4"
        : "+v"(map), "=&s"(m0), "=&s"(m1), "=&s"(m2), "=&s"(m3) : "v"(a), "v"(b), "v"(c), "v"(d), "v"(thr));
}
#define DSA_LAS __attribute__((address_space(3)))
#define RELU(x) __builtin_amdgcn_fmed3f((x), 0.f, 3.0e38f)

__device__ __forceinline__ void dsa_pass(const bf16_t* __restrict__ Q, const bf16_t* __restrict__ QI, const bf16_t* __restrict__ K, const bf16_t* __restrict__ V, const bf16_t* __restrict__ KI,
                                         const float* __restrict__ WI, bf16_t* __restrict__ O, int b, int c, int pass, bool pre, bool pf, DSA_LAS unsigned char* lds) {
    int tid_ = threadIdx.x; asm volatile("" : "+v"(tid_));
    const int tid = tid_, wid = __builtin_amdgcn_readfirstlane(tid >> 6), lane = tid & 63, kl = lane & 15, g = lane >> 4, half = lane >> 5;
    const unsigned ldsb = (unsigned)(unsigned long long)lds;
    const size_t rb = (size_t)b * 4096;
    const int tw = 64 * c + 16 * pass + 2 * wid;
    DSA_LAS unsigned* list = (DSA_LAS unsigned*)(lds + L_LIST + wid * 2048);
    const DSA_LAS float* biasT = (const DSA_LAS float*)(lds + L_BIAS);
    const int nadm = 64 * (c + 1), ncnt = nadm < 256 ? nadm : 256;
    const int srow = 16 * wid + (lane >> 3), lch = (lane & 7) ^ ((srow >> 1) & 7);
    const bf16_t* kisrc = KI + (rb + srow) * 64 + lch * 8;
    const unsigned kidst = ldsb + L_U + wid * 2048;
    const bf16_t* kisrc2 = KI + (rb + srow + 8) * 64 + (lch ^ 4) * 8;
#define DSA_KIDMA(T_) do { glds16v(kisrc + (size_t)(T_) * 8192, kidst + ((T_) & 3) * 16384); glds16v(kisrc2 + (size_t)(T_) * 8192, kidst + ((T_) & 3) * 16384 + 1024); } while (0)
    if (c < 4) { if (pf) { DSA_KIDMA(0); DSA_KIDMA(1); } }
    if (c >= 4) {
        f32x2 sc2[64];
#define SC(j) sc2[(j) >> 1][(j) & 1]
#pragma unroll
        for (int j = 0; j < 64; ++j) sc2[j] = (f32x2){QNAN, QNAN};
        bf16x8 aq0, aq1; f32x4 w4;
        { const bf16_t* qp = QI + (rb + tw + (kl >> 3)) * 512 + (kl & 7) * 64 + 8 * g; aq0 = *(const bf16x8*)qp; aq1 = *(const bf16x8*)(qp + 32);
          w4 = *(const f32x4*)(WI + (rb + tw + (g >> 1)) * 8 + 4 * (g & 1)); }
        const int rd0 = kl * 128 + ((g ^ ((kl >> 1) & 7)) << 4), rd1 = rd0 ^ 64;
        const int nt = (c + 2) >> 1;
        if (!pre) { DSA_KIDMA(0); DSA_KIDMA(1); }
#pragma unroll
        for (int T = 0; T < 32; ++T) {
            if (T < nt) {
                if ((T & 1) == 0) {
                    asm volatile("s_waitcnt vmcnt(0)" ::: "memory");
                    __builtin_amdgcn_s_barrier(); asm volatile("" ::: "memory");
                    if (T + 2 < nt) DSA_KIDMA(T + 2);
                    if (T + 3 < nt) DSA_KIDMA(T + 3); }
                const DSA_LAS unsigned char* kb = lds + L_U + (T & 3) * 16384;
                bf16x8 fb[8]; f32x4 acc[4], acd[4];
#define DSA_RD(H) _Pragma("unroll") for (int st = 0; st < 4; ++st) { fb[2 * st] = *(const DSA_LAS bf16x8*)(kb + rd0 + (4 * (H) + st) * 2048); fb[2 * st + 1] = *(const DSA_LAS bf16x8*)(kb + rd1 + (4 * (H) + st) * 2048); }
#define DSA_MM(A) _Pragma("unroll") for (int st = 0; st < 4; ++st) A[st] = __builtin_amdgcn_mfma_f32_16x16x32_bf16(aq0, fb[2 * st], (f32x4){0.f, 0.f, 0.f, 0.f}, 0, 0, 0); \
                  _Pragma("unroll") for (int st = 0; st < 4; ++st) A[st] = __builtin_amdgcn_mfma_f32_16x16x32_bf16(aq1, fb[2 * st + 1], A[st], 0, 0, 0);
#define DSA_WS(A, H) _Pragma("unroll") for (int pr = 0; pr < 2; ++pr) { float ps[2]; \
                    _Pragma("unroll") for (int s2 = 0; s2 < 2; ++s2) { const f32x4 a = A[2 * pr + s2]; ps[s2] = (w4[0] * RELU(a[0]) + w4[1] * RELU(a[1])) + (w4[2] * RELU(a[2]) + w4[3] * RELU(a[3])); } \
                    auto r = __builtin_amdgcn_permlane16_swap(__float_as_uint(ps[0]), __float_as_uint(ps[1]), false, false); SC(4 * T + 2 * (H) + pr) = __uint_as_float(r[0]) + __uint_as_float(r[1]); }
                DSA_RD(0) __builtin_amdgcn_sched_barrier(0);
                DSA_MM(acc) __builtin_amdgcn_sched_barrier(0);
                DSA_RD(1) __builtin_amdgcn_sched_barrier(0);
                DSA_WS(acc, 0) __builtin_amdgcn_sched_barrier(0);
                DSA_MM(acd) __builtin_amdgcn_sched_barrier(0);
                DSA_WS(acd, 1) __builtin_amdgcn_sched_barrier(0);
#undef DSA_RD
#undef DSA_MM
#undef DSA_WS
                asm volatile("s_waitcnt lgkmcnt(0)" ::: "memory");
            }
        }
        __builtin_amdgcn_s_barrier();
        if (pf) { DSA_KIDMA(0); DSA_KIDMA(1); }
        if ((c & 1) == 0) {
#pragma unroll
            for (int T = 0; T < 32; ++T) if (T == nt - 1) sc2[2 * T + 1] = (f32x2){QNAN, QNAN};
        }
        const int nregs = 4 * nt;
        float mn = 3.0e38f, mx = -3.0e38f, mnb = 3.0e38f, mxb = -3.0e38f;
#pragma unroll
        for (int blk = 0; blk < 8; ++blk) if (16 * blk < nregs) {
#pragma unroll
            for (int jj = 0; jj < 8; jj += 2) { const f32x2 a = sc2[8 * blk + jj], b2 = sc2[8 * blk + jj + 1];
                asm("v_min3_f32 %0, %0, %1, %2" : "+v"(mn) : "v"(a[0]), "v"(a[1])); asm("v_max3_f32 %0, %0, %1, %2" : "+v"(mx) : "v"(a[0]), "v"(a[1]));
                asm("v_min3_f32 %0, %0, %1, %2" : "+v"(mnb) : "v"(b2[0]), "v"(b2[1])); asm("v_max3_f32 %0, %0, %1, %2" : "+v"(mxb) : "v"(b2[0]), "v"(b2[1])); } }
        mn = fminf(mn, mnb); mx = fmaxf(mx, mxb);
        mn = half_min(mn); mx = half_max(mx);
        constexpr float BIGF = 1.2676506002282294e30f;
        f32x2 big2 = {BIGF, BIGF}; asm volatile("" : "+v"(big2));
        float lo[2], hi[2], thr[2], tie[2]; int chi[2], need[2]; bool done[2];
#pragma unroll
        for (int q = 0; q < 2; ++q) { lo[q] = __int_as_float(__builtin_amdgcn_readlane(__float_as_int(mn), 32 * q)) - 1.0f; hi[q] = __int_as_float(__builtin_amdgcn_readlane(__float_as_int(mx), 32 * q));
            chi[q] = 0; need[q] = 0; done[q] = false; thr[q] = hi[q]; tie[q] = __builtin_nanf(""); }
        for (int it = 0; it < 64; ++it) {
            if (done[0] && done[1]) break;
            float mid[2];
#pragma unroll
            for (int q = 0; q < 2; ++q) { mid[q] = 0.5f * lo[q] + 0.5f * hi[q];
                if (!done[q] && (!(mid[q] > lo[q]) || !(mid[q] < hi[q]))) { done[q] = true; thr[q] = hi[q]; tie[q] = hi[q]; need[q] = 256 - chi[q]; } }
            if (done[0] && done[1]) break;
            const float tv = half ? mid[1] : mid[0]; const float ntb_ = tv * -BIGF; const f32x2 ntb2 = {ntb_, ntb_}; f32x2 ca = {0.f, 0.f}, cb = {0.f, 0.f};
#pragma unroll
            for (int blk = 0; blk < 8; ++blk) if (16 * blk < nregs) {
#pragma unroll
                for (int jj = 0; jj < 8; jj += 4) cntp4(ca, cb, sc2[8 * blk + jj], sc2[8 * blk + jj + 1], sc2[8 * blk + jj + 2], sc2[8 * blk + jj + 3], big2, ntb2); }
            ca += cb; int cv = (int)(ca[0] + ca[1]);
            cv = half_sum(cv);
            const int c0 = __builtin_amdgcn_readlane(cv, 0), c1 = __builtin_amdgcn_readlane(cv, 32);
#pragma unroll
            for (int q = 0; q < 2; ++q) { const int cq = q ? c1 : c0;
                if (!done[q]) { if (cq == 256) { done[q] = true; thr[q] = mid[q]; need[q] = 0; } else if (cq > 256) lo[q] = mid[q]; else { hi[q] = mid[q]; chi[q] = cq; } } }
        }
#pragma unroll
        for (int q = 0; q < 2; ++q) if (!done[q]) { thr[q] = hi[q]; tie[q] = hi[q]; need[q] = 256 - chi[q]; }
        DSA_LAS unsigned* lq = list + half * 256;
        if (need[0] == 0 && need[1] == 0) {
            const float tv = half ? thr[1] : thr[0]; unsigned mk[4] = {0u, 0u, 0u, 0u};
#pragma unroll
            for (int blk = 0; blk < 8; ++blk) {
                if (16 * blk < nregs) {
#pragma unroll
                    for (int jj = 0; jj < 16; jj += 4) selmap4(mk[blk >> 1], SC(16 * blk + jj), SC(16 * blk + jj + 1), SC(16 * blk + jj + 2), SC(16 * blk + jj + 3), tv);
                } else if (blk & 1) mk[blk >> 1] <<= 16;
            }
            const int cv = __builtin_popcount(mk[0]) + __builtin_popcount(mk[1]) + __builtin_popcount(mk[2]) + __builtin_popcount(mk[3]);
            int incl = cv;
#pragma unroll
            for (int o = 1; o < 32; o <<= 1) { const int t = __shfl_up(incl, o, 32); if ((lane & 31) >= o) incl += t; }
            unsigned wp = (unsigned)(unsigned long long)lq + 4u * (unsigned)(incl - cv);
#pragma unroll
            for (int w = 0; w < 4; ++w) if (32 * w < nregs) { unsigned m = mk[w]; const unsigned kb_ = (unsigned)(1024 * w + (lane & 31));
                while (m) { const unsigned lz = (unsigned)__builtin_clz(m); *(DSA_LAS unsigned*)wp = (lz << 5) + kb_; wp += 4u; m ^= 0x80000000u >> lz; } }
        } else {
            const float tv = half ? thr[1] : thr[0], ev = half ? tie[1] : tie[0]; const int nd = half ? need[1] : need[0]; int base = 0, tb = 0;
#pragma unroll
            for (int blk = 0; blk < 8; ++blk) if (16 * blk < nregs) {
#pragma unroll
                for (int jj = 0; jj < 16; ++jj) { const int j = 16 * blk + jj; const float s = SC(j);
                    const bool eq = (s == ev); const unsigned long long meq = __builtin_amdgcn_ballot_w64(eq);
                    const unsigned elo = (unsigned)meq, ehi = (unsigned)(meq >> 32);
                    int pe = __builtin_amdgcn_mbcnt_hi(ehi, __builtin_amdgcn_mbcnt_lo(elo, 0)); if (half) pe -= __builtin_popcount(elo);
                    const bool sel = (s > tv) || (eq && (tb + pe < nd));
                    const unsigned long long ms = __builtin_amdgcn_ballot_w64(sel); const unsigned slo = (unsigned)ms, shi = (unsigned)(ms >> 32);
                    int pp = __builtin_amdgcn_mbcnt_hi(shi, __builtin_amdgcn_mbcnt_lo(slo, 0)); if (half) pp -= __builtin_popcount(slo);
                    const int pos = base + pp;
                    if (sel && pos < 256) lq[pos] = (unsigned)(32 * j + (lane & 31));
                    base += half ? __builtin_popcount(shi) : __builtin_popcount(slo); tb += half ? __builtin_popcount(ehi) : __builtin_popcount(elo); } }
            for (int p = base + (lane & 31); p < 256; p += 32) lq[p] = INVALID_ENTRY;
        }
    } else {
        for (int p = lane; p < 2 * ncnt; p += 64) { const int q = p / ncnt; list[q * 256 + (p - q * ncnt)] = (unsigned)(p - q * ncnt); }
    }
    asm volatile("s_waitcnt lgkmcnt(0)" ::: "memory");
#pragma unroll
    for (int q = 0; q < 2; ++q)
#pragma unroll
        for (int i = 0; i < 4; ++i) { const int p = lane + 64 * i; if (p < ncnt) { const unsigned e = list[q * 256 + p]; if (e != INVALID_ENTRY) list[q * 256 + p] = e | ((unsigned)t5_bucket((int)e - (tw + q)) << 16); } }
    asm volatile("s_waitcnt lgkmcnt(0)" ::: "memory");
    const int nq = ncnt >> 6;
    const int vrow = lane >> 3, vslot = lane & 7;
    const int ls_ = (((vslot >> 1) ^ ((vrow >> 1) & 3)) << 1) | (vslot & 1);
    const int trow = 4 * g + ((lane >> 2) & 3), tp = lane & 3, tx = (trow >> 1) & 3;
    const unsigned vbuf = ldsb + L_U + 65536 + wid * 8192;
    struct StepRegs { bf16x8 k[4][2]; bf16x8 v[8]; bf16x8 q[2]; };
    const char* const Kb_ = (const char*)(K + rb * 64), * const Vb_ = (const char*)(V + rb * 64), * const Qb_ = (const char*)(Q + (rb + tw) * 1024);
    const unsigned koff_ = (unsigned)(16 * g), voff_ = (unsigned)(16 * ls_), qoff_ = (unsigned)(kl * 128 + 16 * g);
#define DSA_STEP_LOAD(R, S) do { const int q_ = (S) / nq, qr_ = (S) - q_ * nq; const DSA_LAS unsigned* lq_ = list + q_ * 256 + 64 * qr_; \
        { const unsigned qo_ = qoff_ + (unsigned)q_ * 2048u; R.q[0] = *(const bf16x8*)(Qb_ + qo_); R.q[1] = *(const bf16x8*)(Qb_ + qo_ + 64u); } \
        _Pragma("unroll") for (int tt = 0; tt < 4; ++tt) { const unsigned ko_ = (lq_[16 * tt + kl] & 0xffffu) * 128u + koff_; R.k[tt][0] = *(const bf16x8*)(Kb_ + ko_); R.k[tt][1] = *(const bf16x8*)(Kb_ + ko_ + 64u); } \
        _Pragma("unroll") for (int i = 0; i < 8; ++i) { const unsigned vo_ = (lq_[8 * i + vrow] & 0xffffu) * 128u + voff_; R.v[i] = *(const bf16x8*)(Vb_ + vo_); } } while (0)
#define DSA_STEP(R, S, VB) do { const int q_ = (S) / nq, qr_ = (S) - q_ * nq; const DSA_LAS unsigned* lq_ = list + q_ * 256 + 64 * qr_; \
        if (qr_ == 0) { m_run = -1.0e30f; l_run = 0.f; _Pragma("unroll") for (int db = 0; db < 4; ++db) o[db] = (f32x4){0.f, 0.f, 0.f, 0.f}; } \
          \
        u32x4 e4[4]; f32x4 bv[4]; \
        _Pragma("unroll") for (int tt = 0; tt < 4; ++tt) e4[tt] = *(const DSA_LAS u32x4*)(lq_ + 16 * tt + 4 * g); \
        _Pragma("unroll") for (int tt = 0; tt < 4; ++tt) _Pragma("unroll") for (int r = 0; r < 4; ++r) bv[tt][r] = biasT[((e4[tt][r] >> 16) & 31u) * 16 + kl]; \
        f32x4 st[4]; \
        _Pragma("unroll") for (int tt = 0; tt < 4; ++tt) { \
            f32x4 a = __builtin_amdgcn_mfma_f32_16x16x32_bf16(R.k[tt][0], R.q[0], (f32x4){0.f, 0.f, 0.f, 0.f}, 0, 0, 0); a = __builtin_amdgcn_mfma_f32_16x16x32_bf16(R.k[tt][1], R.q[1], a, 0, 0, 0); \
            _Pragma("unroll") for (int r = 0; r < 4; ++r) a[r] = (e4[tt][r] >> 16) == 63u ? -1.0e30f : a[r] + bv[tt][r]; \
            st[tt] = a; } \
        float mloc = fmaxf(fmaxf(fmaxf(st[0][0], st[0][1]), fmaxf(st[0][2], st[0][3])), fmaxf(fmaxf(st[1][0], st[1][1]), fmaxf(st[1][2], st[1][3]))); \
        mloc = fmaxf(mloc, fmaxf(fmaxf(fmaxf(st[2][0], st[2][1]), fmaxf(st[2][2], st[2][3])), fmaxf(fmaxf(st[3][0], st[3][1]), fmaxf(st[3][2], st[3][3])))); \
        { auto r16 = __builtin_amdgcn_permlane16_swap(__float_as_uint(mloc), __float_as_uint(mloc), false, false); mloc = fmaxf(__uint_as_float(r16[0]), __uint_as_float(r16[1])); \
          auto r32_ = __builtin_amdgcn_permlane32_swap(__float_as_uint(mloc), __float_as_uint(mloc), false, false); mloc = fmaxf(__uint_as_float(r32_[0]), __uint_as_float(r32_[1])); } \
        const float mnew = fmaxf(m_run, mloc), alpha = __builtin_amdgcn_exp2f(m_run - mnew); m_run = mnew; \
        float ps = 0.f; unsigned pk[4][2]; \
        _Pragma("unroll") for (int tt = 0; tt < 4; ++tt) { f32x4 p; _Pragma("unroll") for (int r = 0; r < 4; ++r) p[r] = __builtin_amdgcn_exp2f(st[tt][r] - mnew); \
            ps += (p[0] + p[1]) + (p[2] + p[3]); pk[tt][0] = pg8::cvt_pk_bf16(p[0], p[1]); pk[tt][1] = pg8::cvt_pk_bf16(p[2], p[3]); } \
        l_run = l_run * alpha + ps; \
        _Pragma("unroll") for (int db = 0; db < 4; ++db) o[db] = o[db] * alpha; \
        { DSA_LAS unsigned char* vw = lds + L_U + 65536 + wid * 8192 + (VB) + vrow * 128 + vslot * 16; \
          _Pragma("unroll") for (int i = 0; i < 8; ++i) *(DSA_LAS bf16x8*)(vw + i * 1024) = R.v[i]; \
          asm volatile("s_waitcnt lgkmcnt(0)" ::: "memory"); } \
        _Pragma("unroll") for (int s2 = 0; s2 < 2; ++s2) { \
            const u32x4 pw = {pk[2 * s2][0], pk[2 * s2][1], pk[2 * s2 + 1][0], pk[2 * s2 + 1][1]}; const bf16x8 pb = __builtin_bit_cast(bf16x8, pw); \
            s16x4 v1[4], v2[4]; \
            _Pragma("unroll") for (int db = 0; db < 4; ++db) { const unsigned ta = vbuf + (VB) + trow * 128 + ((db ^ tx) << 5) + tp * 8; \
                v1[db] = s2 == 0 ? trrdo<0>(ta) : trrdo<4096>(ta); v2[db] = s2 == 0 ? trrdo<2048>(ta) : trrdo<6144>(ta); } \
            asm volatile("s_waitcnt lgkmcnt(0)" : "+v"(v1[0]), "+v"(v1[1]), "+v"(v1[2]), "+v"(v1[3]), "+v"(v2[0]), "+v"(v2[1]), "+v"(v2[2]), "+v"(v2[3]) :: "memory"); \
            _Pragma("unroll") for (int db = 0; db < 4; ++db) { const bf16x8 va = {v1[db][0], v1[db][1], v1[db][2], v1[db][3], v2[db][0], v2[db][1], v2[db][2], v2[db][3]}; \
                o[db] = __builtin_amdgcn_mfma_f32_16x16x32_bf16(va, pb, o[db], 0, 0, 0); } } \
        if (qr_ == nq - 1) { float lt = l_run; \
            { auto r16 = __builtin_amdgcn_permlane16_swap(__float_as_uint(lt), __float_as_uint(lt), false, false); lt = __uint_as_float(r16[0]) + __uint_as_float(r16[1]); \
              auto r32_ = __builtin_amdgcn_permlane32_swap(__float_as_uint(lt), __float_as_uint(lt), false, false); lt = __uint_as_float(r32_[0]) + __uint_as_float(r32_[1]); } \
            const float rl = __builtin_amdgcn_rcpf(lt); bf16_t* op = O + (rb + tw + q_) * 1024 + kl * 64 + 4 * g; \
            _Pragma("unroll") for (int db = 0; db < 4; ++db) { u32x2 w; w.x = pg8::cvt_pk_bf16(o[db][0] * rl, o[db][1] * rl); w.y = pg8::cvt_pk_bf16(o[db][2] * rl, o[db][3] * rl); *(u32x2*)(op + 16 * db) = w; } } \
    } while (0)
    {
        float m_run = -1.0e30f, l_run = 0.f; f32x4 o[4];
#pragma unroll
        for (int db = 0; db < 4; ++db) o[db] = (f32x4){0.f, 0.f, 0.f, 0.f};
        StepRegs RA, RB; const int nsteps = 2 * nq;
        DSA_STEP_LOAD(RA, 0);
#pragma unroll 1
        for (int s = 0; s < nsteps; s += 2) {
            DSA_STEP_LOAD(RB, s + 1);
            asm volatile("" ::: "memory");
            DSA_STEP(RA, s, 0);
            { const int sn_ = s + 2 < nsteps ? s + 2 : nsteps - 1; DSA_STEP_LOAD(RA, sn_); }
            asm volatile("" ::: "memory");
            DSA_STEP(RB, s + 1, 0);
        }
    }
#undef DSA_STEP
#undef DSA_STEP_LOAD
#undef DSA_KIDMA
}

#undef RELU
#undef SC
#undef QNAN
#undef DSA_LAS
#undef DSA_DPP
}
__device__ __forceinline__ void dsa_phase(Frame& F) {
    unsigned char* ws = wsp();
    const dsa::bf16_t* Q = (const dsa::bf16_t*)(ws + WS_AQ); const dsa::bf16_t* QI = (const dsa::bf16_t*)(ws + WS_AQI); const dsa::bf16_t* K = (const dsa::bf16_t*)(ws + WS_AK);
    const dsa::bf16_t* V = (const dsa::bf16_t*)(ws + WS_AV); const dsa::bf16_t* KI = (const dsa::bf16_t*)(ws + WS_AKI); const float* WI = (const float*)(ws + WS_AWI); dsa::bf16_t* O = (dsa::bf16_t*)(ws + WS_OB);
    { int t_ = threadIdx.x; asm volatile("" : "+v"(t_)); const float* rbias = inp(1); LAS float* bt = (LAS float*)(F.lds + dsa::L_BIAS); if (t_ < 512) bt[t_] = rbias[t_] * dsa::LOG2E; }
    __syncthreads();
    for (int pr = F.vcu; pr < NB * 32; pr += F.G) { const int b = pr >> 5, c0 = pr & 31;
        bool pre = false;
        for (int k = 0; k < 2; ++k) { const int c = k == 0 ? c0 : 63 - c0;
            for (int pass = 0; pass < 4; ++pass) { const bool last = (k == 1 && pass == 3); const int cn = (pass == 3) ? 63 - c0 : c; const bool pf = !last && cn >= 4;
                dsa::dsa_pass(Q, QI, K, V, KI, WI, O, b, c, pass, pre, pf, F.lds); pre = pf; } }
        __syncthreads(); }
    __syncthreads();
}

__device__ __forceinline__ void mla_phase(Frame& F, int j) {
    unsigned char* ws = wsp();
    const pg8::bf16_t* QB = (const pg8::bf16_t*)(ws + WS_QB); const pg8::bf16_t* KB = (const pg8::bf16_t*)(ws + WS_KB); const pg8::bf16_t* VB = (const pg8::bf16_t*)(ws + WS_VB); pg8::bf16_t* OB = (pg8::bf16_t*)(ws + WS_OB);
    const float* qgain = inp(16) + j * 96; const float* cosT = (const float*)(ws + WS_ROPE); const float* sinT = cosT + SEQ * 16;
    int ring = 0; bool pre = false;
    for (int item = F.vcu; item < NB * 16 * 8; item += F.G) { const int bh = item >> 3, s = item & 7, b = bh >> 4, h = bh & 15; const size_t rb = (size_t)b * SEQ;
        const pg8::bf16_t* Kc = KB + (size_t)bh * SEQ * 96; const pg8::bf16_t* Vc = VB + (size_t)bh * SEQ * 64;
        for (int k = 0; k < 2; ++k) { const int qb = k == 0 ? s : 15 - s;
            const pg8::bf16_t* Kn = Kc; const pg8::bf16_t* Vn = Vc;
            if (k == 1) { const int ni = item + F.G; if (ni < NB * 16 * 8) { const int bh2 = ni >> 3; Kn = KB + (size_t)bh2 * SEQ * 96; Vn = VB + (size_t)bh2 * SEQ * 64; } else { Kn = nullptr; Vn = nullptr; } }
            mla::attn_unit(QB + rb * 1536 + h * 96, Kc, Vc, OB + rb * 1024 + h * 64, qgain, cosT, sinT, qb, (char*)F.lds, Kn, Vn, pre, ring); pre = Kn != nullptr; } }
}

#ifndef PROBE_BAR2
#define PROBE_BAR2 0
#endif
#ifndef REP_DSA
#define REP_DSA 1
#endif
#ifndef REP_MLA
#define REP_MLA 1
#endif
#ifndef REP_UP
#define REP_UP 1
#endif
#ifndef DSA_ENABLED
#define DSA_ENABLED 0
#endif
struct Args { const float* in[21]; float* out; unsigned char* ws; };
__global__ void __launch_bounds__(NWAVES * 64, 2) yoco_fwd(Args args) {
    extern __shared__ __attribute__((aligned(16))) unsigned char lds[];
    Frame F;
    F.lds = (LAS unsigned char*)lds;
    F.MISC = (volatile LAS unsigned*)(F.lds + MISC_OFF);
    F.tid = threadIdx.x; F.lane = F.tid & 63; F.wave = __builtin_amdgcn_readfirstlane(F.tid >> 6);
    F.G = gridDim.x; { const int bx = blockIdx.x; F.vcu = (F.G % 8 == 0) ? (bx % 8) * (F.G / 8) + bx / 8 : bx; }
    F.gw = F.vcu * NWAVES + F.wave;
    F.ctl = (gu32*)(wsp() + WS_CTL);
#define ws wsp()
    for (int u = F.tid; u < (LDS_BYTES - LDSCTL_OFF) / 4; u += NWAVES * 64) ((LAS unsigned*)(F.lds + LDSCTL_OFF))[u] = 0u;
    __syncthreads();
    (void)xcd_barrier_post((unsigned*)(wsp() + WS_CTL) + CW_BAR, F.MISC + 8);
#define GRID_BAR() do { XcdBarrier bar_; bar_.bar = (unsigned*)(wsp() + WS_CTL) + CW_BAR; bar_.x = xb_xcc_id(); bar_.st = F.MISC + 8; xcd_barrier(bar_); if (PROBE_BAR2) xcd_barrier(bar_); } while (0)
    typedef pg8::bf16_t hb_t;

    p0_prologue(F);
    GRID_BAR();

    for (int L = 0; L < 2; ++L) {
        bool mixed = false;
        if (L < 2) {
            { pg8::Gemm g{(const hb_t*)(ws + WS_HB), (const hb_t*)(ws + WS_WIN) + (size_t)L * WIN_ELEMS, M, NIN, D}; pg8::StaticOrder S; S.init(M, NIN, F.G, (int)blockIdx.x);
              pg8::EpiInproj E{L};
              pg8::gemm_phase<pg8::EpiInproj, pg8::StaticOrder, PG8_ALIGN, PG8_SP2>(F.lds + RING_OFF, g, S, E); }
            GRID_BAR();
            for (int rep_ = 0; rep_ < REP_DSA; ++rep_) dsa_phase(F);
            GRID_BAR();
            mixed = true;
        }
        if (mixed) {
            const hb_t* Wo = L < 2 ? (const hb_t*)(ws + WS_WOA) + (size_t)L * D * D : (const hb_t*)(ws + WS_WOB) + (size_t)(L - 2) * D * D;
            pg8::Gemm g{(const hb_t*)(ws + WS_OB), Wo, M, D, D}; pg8::StaticOrder S; S.init(M, D, F.G, (int)blockIdx.x);
            pg8::EpiResidT<1, 0> E{1, 0};
            pg8::gemm_phase<pg8::EpiResidT<1, 0>, pg8::StaticOrder, PG8_ALIGN, PG8_SP2>(F.lds + RING_OFF, g, S, E);
            GRID_BAR();
        }
        { pg8::Gemm g{(const hb_t*)(ws + WS_HB), (const hb_t*)(ws + WS_WUP) + (size_t)L * D * FF, M, FF, D}; pg8::StaticOrder S; S.init(M, FF, F.G, (int)blockIdx.x);
          pg8::EpiUp E{0, (int)(WS_KB / MiB)};
          pg8::gemm_phase<pg8::EpiUp, pg8::StaticOrder, PG8_ALIGN, PG8_SP2>(F.lds + RING_OFF, g, S, E); }
        GRID_BAR();
        { pg8::Gemm g{(const hb_t*)(ws + WS_KB), (const hb_t*)(ws + WS_WDN) + (size_t)L * D * FF, M, D, FF}; pg8::StaticOrder S; S.init(M, D, F.G, (int)blockIdx.x);
          pg8::EpiResidT<0, 1> E{1, 0};
          pg8::gemm_phase<pg8::EpiResidT<0, 1>, pg8::StaticOrder, PG8_ALIGN, PG8_SP2>(F.lds + RING_OFF, g, S, E); }
        GRID_BAR();
    }
    for (int L = 2; L < 4; ++L) {
        bool mixed = false;
        if (L >= 2) {
            const int j = L - 2;
            if (j == 0) { pg8::Gemm g{(const hb_t*)(ws + WS_HB), (const hb_t*)(ws + WS_WKVQ), M, NKVQ, D}; pg8::StaticOrder S; S.init(M, NKVQ, F.G, (int)blockIdx.x);
              pg8::EpiKvq<0> E{};
              pg8::gemm_phase<pg8::EpiKvq<0>, pg8::StaticOrder, PG8_ALIGN, PG8_SP2>(F.lds + RING_OFF, g, S, E); }
            else { pg8::Gemm g{(const hb_t*)(ws + WS_HB), (const hb_t*)(ws + WS_WDQ1), M, NDQ1, D}; pg8::StaticOrder S; S.init(M, NDQ1, F.G, (int)blockIdx.x);
              pg8::EpiKvq<1> E{};
              pg8::gemm_phase<pg8::EpiKvq<1>, pg8::StaticOrder, PG8_ALIGN, PG8_SP2>(F.lds + RING_OFF, g, S, E); }
            GRID_BAR();
            if (j == 0) {
                int Kk = KVLORA; asm volatile("" : "+s"(Kk));
                pg8::Gemm g{(const hb_t*)(ws + WS_CKV), (const hb_t*)(ws + WS_WUKV), M, NUKV, Kk}; pg8::StaticOrder S; S.init(M, NUKV, F.G, (int)blockIdx.x);
                pg8::EpiUkv E{};
                pg8::gemm_phase<pg8::EpiUkv, pg8::StaticOrder, PG8_ALIGN, PG8_SP2>(F.lds + RING_OFF, g, S, E); }
            { int Kk = QLORA; asm volatile("" : "+s"(Kk)); pg8::Gemm g{(const hb_t*)(ws + WS_QL), (const hb_t*)(ws + WS_WUQ) + (size_t)j * WUQ_ELEMS, M, NUQ, Kk}; pg8::StaticOrder S; S.init(M, NUQ, F.G, (int)blockIdx.x);
              pg8::EpiUq E{};
              pg8::gemm_phase<pg8::EpiUq, pg8::StaticOrder, PG8_ALIGN, PG8_SP2>(F.lds + RING_OFF, g, S, E); }
            GRID_BAR();
            for (int rep_ = 0; rep_ < REP_MLA; ++rep_) mla_phase(F, j);
            GRID_BAR();
            mixed = true;
        }
        if (mixed) {
            const hb_t* Wo = L < 2 ? (const hb_t*)(ws + WS_WOA) + (size_t)L * D * D : (const hb_t*)(ws + WS_WOB) + (size_t)(L - 2) * D * D;
            pg8::Gemm g{(const hb_t*)(ws + WS_OB), Wo, M, D, D}; pg8::StaticOrder S; S.init(M, D, F.G, (int)blockIdx.x);
            pg8::EpiResidT<1, 0> E{1, 0};
            pg8::gemm_phase<pg8::EpiResidT<1, 0>, pg8::StaticOrder, PG8_ALIGN, PG8_SP2>(F.lds + RING_OFF, g, S, E);
            GRID_BAR();
        }
        const int nhalf = L == 3 ? 1 : 2, Mrows = L == 3 ? M : MH, hid_mib = L == 3 ? (int)(WS_KB / MiB) : (int)(WS_HID / MiB);
        for (int hf = 0; hf < nhalf; ++hf) {
            const size_t r0 = (size_t)hf * MH;
            for (int rep_ = 0; rep_ < REP_UP; ++rep_)
            { pg8::Gemm g{(const hb_t*)(ws + WS_HB) + r0 * D, (const hb_t*)(ws + WS_WUP) + (size_t)L * D * FF, Mrows, FF, D}; pg8::StaticOrder S; S.init(Mrows, FF, F.G, (int)blockIdx.x);
              pg8::EpiUp E{(int)r0, hid_mib};
              pg8::gemm_phase<pg8::EpiUp, pg8::StaticOrder, PG8_ALIGN, PG8_SP2>(F.lds + RING_OFF, g, S, E); }
            GRID_BAR();
            { pg8::Gemm g{(const hb_t*)(ws + (size_t)hid_mib * MiB), (const hb_t*)(ws + WS_WDN) + (size_t)L * D * FF, Mrows, D, FF}; pg8::StaticOrder S; S.init(Mrows, D, F.G, (int)blockIdx.x);
              pg8::EpiResidT<0, 1> E{L == 3 ? 2 : 1, (int)r0};
              pg8::gemm_phase<pg8::EpiResidT<0, 1>, pg8::StaticOrder, PG8_ALIGN, PG8_SP2>(F.lds + RING_OFF, g, S, E); }
            if (L != 3) GRID_BAR();
        }
        }
#undef ws
}
extern "C" void kernel_launch(void* const* d_in, const int* in_sizes, int n_in, void* d_out, int out_size, void* d_ws, size_t ws_size, hipStream_t stream) {
    static int grid = 0;
    if (grid == 0) {
        if (n_in != 21 || in_sizes[0] != M * D || out_size != M * D || ws_size < WS_END) { fprintf(stderr, "kernel_launch: unexpected shapes: n_in %d in0 %d out %d ws %zu\n", n_in, n_in > 0 ? in_sizes[0] : -1, out_size, ws_size); grid = -1; return; }
        int dev = 0, cus = 0, per_cu = 0;
        if (hipGetDevice(&dev) != hipSuccess || hipDeviceGetAttribute(&cus, hipDeviceAttributeMultiprocessorCount, dev) != hipSuccess) { grid = -1; return; }
        if (hipFuncSetAttribute((const void*)yoco_fwd, hipFuncAttributeMaxDynamicSharedMemorySize, LDS_BYTES) != hipSuccess) { fprintf(stderr, "kernel_launch: hipFuncSetAttribute failed\n"); grid = -1; return; }
        if (hipOccupancyMaxActiveBlocksPerMultiprocessor(&per_cu, (const void*)yoco_fwd, NWAVES * 64, LDS_BYTES) != hipSuccess || per_cu < 1) { fprintf(stderr, "kernel_launch: occupancy query reports %d\n", per_cu); }
        (void)hipGetLastError();
        grid = cus;
    }
    if (grid < 0) return;
    if (hipMemsetAsync((char*)d_ws + WS_CTL, 0, CTL_ZERO_BYTES, stream) != hipSuccess) return;
    Args a{};
    for (int i = 0; i < 21; ++i) a.in[i] = (const float*)d_in[i];
    a.out = (float*)d_out; a.ws = (unsigned char*)d_ws;
    hipLaunchKernelGGL(yoco_fwd, dim3(grid), dim3(NWAVES * 64), LDS_BYTES, stream, a);
}
```

```cpp
#include <hip/hip_runtime.h>
#include <cstdio>
#include <cstdint>

#ifndef PG8_SP2
#define PG8_SP2 true
#endif
#ifndef PG8_ALIGN
#define PG8_ALIGN true
#endif
constexpr int NWAVES = 8;
constexpr int NB = 8, SEQ = 4096, M = NB * SEQ, D = 1024, FF = 4096, MH = M / 2;
constexpr int A_IN = 1736, NIN = 1792;
constexpr int NKVQ = 768, NUKV = 2048, NDQ1 = 512, NUQ = 1536, QLORA = 384, KVLORA = 256;
constexpr size_t MiB = 1u << 20;
constexpr size_t WS_CTL = 0, CTL_ZERO_BYTES = 1 * MiB;
constexpr size_t WS_WIN = 1 * MiB, WS_WOA = 8 * MiB, WS_WKVQ = 12 * MiB, WS_WUKV = 14 * MiB, WS_WDQ1 = 15 * MiB, WS_WUQ = 16 * MiB, WS_WOB = 19 * MiB, WS_WUP = 23 * MiB, WS_WDN = 55 * MiB;
constexpr size_t WS_SSQH = 87 * MiB, WS_SSQCKV = 89 * MiB, WS_SSQQL = 89 * MiB + 512 * 1024, WS_SSQKR = 90 * MiB + 512 * 1024, WS_KROPE = 91 * MiB, WS_ROPE = 95 * MiB;
constexpr size_t WS_HB = 96 * MiB, WS_KB = 160 * MiB, WS_VB = 256 * MiB, WS_X = 320 * MiB;
constexpr size_t WS_HID = WS_X, WS_QB = WS_X, WS_OB = 416 * MiB, WS_QL = 416 * MiB, WS_CKV = 448 * MiB, WS_SSQB = 480 * MiB, WS_END = 482 * MiB;
constexpr size_t WS_AQ = WS_X, WS_AQI = 384 * MiB, WS_AK = 160 * MiB, WS_AV = 164 * MiB, WS_AKI = 168 * MiB, WS_AWI = 172 * MiB;
constexpr size_t WIN_ELEMS = (size_t)NIN * D, WUQ_ELEMS = (size_t)NUQ * QLORA;
constexpr int CW_TMO = 0, CW_CODE = 1, CW_BAR = 4096;
constexpr int RING_OFF = 0, RING_BYTES = 131072;
constexpr int LDSCTL_OFF = 151552, MISC_OFF = LDSCTL_OFF + 320;
constexpr int LDS_BYTES = 155648;
#define GAS __attribute__((address_space(1)))
#define LAS __attribute__((address_space(3)))
typedef unsigned short bf16;
typedef unsigned v4u __attribute__((ext_vector_type(4)));
typedef float f32x4 __attribute__((ext_vector_type(4)));
typedef short bf16x8 __attribute__((ext_vector_type(8)));
typedef GAS unsigned gu32;
typedef GAS unsigned long long gu64;
#define RLX_AGENT __ATOMIC_RELAXED, __HIP_MEMORY_SCOPE_AGENT
#define LDS_WAIT() asm volatile("s_waitcnt lgkmcnt(0)" ::: "memory")
#define VM_WAIT() asm volatile("s_waitcnt vmcnt(0)" ::: "memory")

typedef const float* cfp_t;
__device__ __forceinline__ cfp_t inp(int i) { return ((volatile cfp_t __attribute__((address_space(4)))*)__builtin_amdgcn_kernarg_segment_ptr())[i]; }
__device__ __forceinline__ float* outp() { return (float*)((volatile cfp_t __attribute__((address_space(4)))*)__builtin_amdgcn_kernarg_segment_ptr())[21]; }
__device__ __forceinline__ unsigned char* wsp() { return (unsigned char*)((volatile cfp_t __attribute__((address_space(4)))*)__builtin_amdgcn_kernarg_segment_ptr())[22]; }
namespace pg8 {
#define PG8_LAS __attribute__((address_space(3)))
typedef unsigned short bf16_t;
typedef short bf16x8 __attribute__((ext_vector_type(8)));
typedef float f32x4 __attribute__((ext_vector_type(4)));
typedef unsigned u32x4 __attribute__((ext_vector_type(4)));
constexpr int BM = 256, BK = 64, HALF = 128, HTB = HALF * BK * 2  , STAGE_BYTES = 8 * HTB, NXCD = 8, WGM = 8;

__host__ __device__ __forceinline__ int lds_byte(int r, int c) { const int st = (r >> 4) * 2 + (c >> 5), rr = r & 15, cc = c & 31, ob = rr * 64 + cc * 2; return st * 1024 + (ob ^ (((ob >> 9) & 1) << 5)); }
__host__ __device__ __forceinline__ void stage_rc(int b, int& R, int& C) { const int st = b / 1024, sb = b % 1024, swz = sb ^ (((sb >> 9) & 1) << 5); R = (st >> 1) * 16 + swz / 64; C = (st & 1) * 32 + (swz % 64) / 2; }
__host__ __device__ __forceinline__ int perm32(int rho) { const int n = rho >> 4, i = rho & 15; return 8 * (i >> 2) + 4 * n + (i & 3); }

struct Unit { int pm, pn; };
struct Gemm { const bf16_t* A; const bf16_t* Bt; int M, N, K; };

struct StaticOrder {
    int nM, nN, nwg, G, c;
    __host__ __device__ void init(int M, int N, int G_, int c_) { nM = M / BM; nN = N / BM; nwg = nM * nN; G = G_; c = c_; }
    __host__ __device__ bool next(int i, Unit& u) const {
        const long L = (long)i * G + c; if (L >= nwg) return false;
        int wgid = (int)L; { const int q = nwg / NXCD, r = nwg % NXCD, xcd = wgid % NXCD, off = wgid / NXCD; wgid = (xcd < r ? xcd * (q + 1) : r * (q + 1) + (xcd - r) * q) + off; }
        const int nig = WGM * nN, gid = wgid / nig, fm = gid * WGM, gsz = (nM - fm) < WGM ? (nM - fm) : WGM;
        u.pm = fm + ((wgid % nig) % gsz); u.pn = (wgid % nig) / gsz; return true;
    }
    __device__ __forceinline__ void a_ready(const Unit&) const {}
    __device__ __forceinline__ void done(const Unit&) const {}
};


typedef float f32x2 __attribute__((ext_vector_type(2)));
typedef __bf16 bf16x2_t __attribute__((ext_vector_type(2)));
__device__ __forceinline__ unsigned cvt_pk_bf16(float lo, float hi) { f32x2 v = {lo, hi}; bf16x2_t b = __builtin_convertvector(v, bf16x2_t); return __builtin_bit_cast(unsigned, b); }
__device__ __forceinline__ u32x4 pack8(f32x4 a, f32x4 b) { u32x4 w; w.x = cvt_pk_bf16(a[0], a[1]); w.y = cvt_pk_bf16(a[2], a[3]); w.z = cvt_pk_bf16(b[0], b[1]); w.w = cvt_pk_bf16(b[2], b[3]); return w; }
__device__ __forceinline__ float sum4sq(f32x4 a) { return (a[0] * a[0] + a[1] * a[1]) + (a[2] * a[2] + a[3] * a[3]); }
__device__ __forceinline__ float red_fq(float s) { const unsigned u = __float_as_uint(s); auto a = __builtin_amdgcn_permlane16_swap(u, u, false, false); const float t = __uint_as_float(a[0]) + __uint_as_float(a[1]);
    const unsigned w = __float_as_uint(t); auto b = __builtin_amdgcn_permlane32_swap(w, w, false, false); return __uint_as_float(b[0]) + __uint_as_float(b[1]); }
constexpr float RMS_EPS = 1e-6f;
__device__ __forceinline__ float rstd16(const float* ssq, int row, int fq, float inv_n) { const f32x4 v = *(const f32x4*)(ssq + (size_t)row * 16 + 4 * fq); return __builtin_amdgcn_rsqf(red_fq((v[0] + v[1]) + (v[2] + v[3])) * inv_n + RMS_EPS); }
__device__ __forceinline__ float rstd4(const float* ssq, int row, int fq, float inv_n) { return __builtin_amdgcn_rsqf(red_fq(ssq[(size_t)row * 4 + fq]) * inv_n + RMS_EPS); }
__device__ __forceinline__ float rstd6(const float* ssq, int row, int fq, float inv_n) { const f32x2 v = *(const f32x2*)(ssq + (size_t)row * 8 + 2 * fq); return __builtin_amdgcn_rsqf(red_fq(fq < 3 ? v[0] + v[1] : 0.f) * inv_n + RMS_EPS); }

__device__ __forceinline__ void rstd16x8(const float* ssq, int rowb, int fq, float inv_n, float (&rs)[2][4]) { f32x4 v[2][4];
#pragma unroll
    for (int ai = 0; ai < 2; ++ai)
#pragma unroll
        for (int m = 0; m < 4; ++m) v[ai][m] = *(const f32x4*)(ssq + (size_t)(rowb + ai * HALF + m * 16) * 16 + 4 * fq);
    asm volatile("" : "+v"(v[0][0]), "+v"(v[0][1]), "+v"(v[0][2]), "+v"(v[0][3]), "+v"(v[1][0]), "+v"(v[1][1]), "+v"(v[1][2]), "+v"(v[1][3]));
#pragma unroll
    for (int ai = 0; ai < 2; ++ai)
#pragma unroll
        for (int m = 0; m < 4; ++m) rs[ai][m] = __builtin_amdgcn_rsqf(red_fq((v[ai][m][0] + v[ai][m][1]) + (v[ai][m][2] + v[ai][m][3])) * inv_n + RMS_EPS); }
__device__ __forceinline__ void rstd6x8(const float* ssq, int rowb, int fq, float inv_n, float (&rs)[2][4]) { f32x2 v[2][4];
#pragma unroll
    for (int ai = 0; ai < 2; ++ai)
#pragma unroll
        for (int m = 0; m < 4; ++m) v[ai][m] = *(const f32x2*)(ssq + (size_t)(rowb + ai * HALF + m * 16) * 8 + 2 * fq);
    asm volatile("" : "+v"(v[0][0]), "+v"(v[0][1]), "+v"(v[0][2]), "+v"(v[0][3]), "+v"(v[1][0]), "+v"(v[1][1]), "+v"(v[1][2]), "+v"(v[1][3]));
#pragma unroll
    for (int ai = 0; ai < 2; ++ai)
#pragma unroll
        for (int m = 0; m < 4; ++m) rs[ai][m] = __builtin_amdgcn_rsqf(red_fq(fq < 3 ? v[ai][m][0] + v[ai][m][1] : 0.f) * inv_n + RMS_EPS); }
template <int SB_, int SCALE_> struct EpiResidT {
    static constexpr bool PERM = true, AFTER_DRAIN = false; static constexpr int sb = SB_, scale = SCALE_;
    int mode, r0;
    __device__ __forceinline__ void operator()(const f32x4 (&acc)[2][2][4][2], const Unit& u, int wr, int wc, int fr, int fq) const {
        { int t_ = threadIdx.x; asm volatile("" : "+v"(t_)); fr = t_ & 15; fq = (t_ >> 4) & 3; }
        const int col = u.pn * BM + wc * 64 + fq * 8;
        const float* xin = inp(0) + (size_t)r0 * 1024; float* out = outp() + (size_t)r0 * 1024; bf16_t* hb = (bf16_t*)(wsp() + WS_HB) + (size_t)r0 * 1024; float* ssq = (float*)(wsp() + (sb ? WS_SSQB : WS_SSQH)) + (size_t)r0 * 16;
        if (scale == 0) {
        u32x4 rb[2][4][2];
#pragma unroll
        for (int ai = 0; ai < 2; ++ai)
#pragma unroll
            for (int m = 0; m < 4; ++m) { const size_t off = (size_t)(u.pm * BM + ai * HALF + wr * 64 + m * 16 + fr) * 1024 + col;
#pragma unroll
                for (int bj = 0; bj < 2; ++bj) rb[ai][m][bj] = *(const u32x4*)(hb + off + bj * 32); }
        asm volatile("" ::: "memory");
#pragma unroll
        for (int ai = 0; ai < 2; ++ai) {
            asm volatile("" : "+v"(rb[ai][0][0]), "+v"(rb[ai][0][1]), "+v"(rb[ai][1][0]), "+v"(rb[ai][1][1]), "+v"(rb[ai][2][0]), "+v"(rb[ai][2][1]), "+v"(rb[ai][3][0]), "+v"(rb[ai][3][1]));
#pragma unroll
            for (int m = 0; m < 4; ++m) { const int row = u.pm * BM + ai * HALF + wr * 64 + m * 16 + fr; const size_t off = (size_t)row * 1024 + col; float s = 0.f;
#pragma unroll
                for (int bj = 0; bj < 2; ++bj) { const u32x4 w = rb[ai][m][bj];
                    const f32x4 r0v = {__uint_as_float(w.x << 16), __uint_as_float(w.x & 0xffff0000u), __uint_as_float(w.y << 16), __uint_as_float(w.y & 0xffff0000u)};
                    const f32x4 r1v = {__uint_as_float(w.z << 16), __uint_as_float(w.z & 0xffff0000u), __uint_as_float(w.w << 16), __uint_as_float(w.w & 0xffff0000u)};
                    const f32x4 a = r0v + acc[ai][bj][m][0], b = r1v + acc[ai][bj][m][1];
                    if (mode == 2) { *(f32x4*)(out + off + bj * 32) = a; *(f32x4*)(out + off + bj * 32 + 4) = b; }
                    else { *(u32x4*)(hb + off + bj * 32) = pack8(a, b); s += sum4sq(a) + sum4sq(b); } }
                if (mode != 2) { s = red_fq(s); if (fq == 0) ssq[(size_t)row * 16 + u.pn * 4 + wc] = s; } }
        }
        } else {
        u32x4 rb[4][2]; f32x4 sv[4]; const float* sq = (const float*)(wsp() + WS_SSQB) + (size_t)r0 * 16;
#pragma unroll
        for (int m = 0; m < 4; ++m) sv[m] = *(const f32x4*)(sq + (size_t)(u.pm * BM + wr * 64 + m * 16 + fr) * 16 + 4 * fq);
#pragma unroll
        for (int m = 0; m < 4; ++m) { const size_t off = (size_t)(u.pm * BM + wr * 64 + m * 16 + fr) * 1024 + col;
#pragma unroll
            for (int bj = 0; bj < 2; ++bj) rb[m][bj] = *(const u32x4*)(hb + off + bj * 32); }
#pragma unroll
        for (int ai = 0; ai < 2; ++ai) {
            float rs2[4];
            asm volatile("" : "+v"(sv[0]), "+v"(sv[1]), "+v"(sv[2]), "+v"(sv[3]), "+v"(rb[0][0]), "+v"(rb[0][1]), "+v"(rb[1][0]), "+v"(rb[1][1]), "+v"(rb[2][0]), "+v"(rb[2][1]), "+v"(rb[3][0]), "+v"(rb[3][1]));
#pragma unroll
            for (int m = 0; m < 4; ++m) { const float r_ = __builtin_amdgcn_rsqf(red_fq((sv[m][0] + sv[m][1]) + (sv[m][2] + sv[m][3])) * (1.f / 1024.f) + RMS_EPS); rs2[m] = r_ * r_ * 2.81474976710656e14f; }
            if (ai == 0) {
#pragma unroll
                for (int m = 0; m < 4; ++m) sv[m] = *(const f32x4*)(sq + (size_t)(u.pm * BM + HALF + wr * 64 + m * 16 + fr) * 16 + 4 * fq);
                asm volatile("" ::: "memory"); }
#pragma unroll
            for (int m = 0; m < 4; ++m) { const int row = u.pm * BM + ai * HALF + wr * 64 + m * 16 + fr; const size_t off = (size_t)row * 1024 + col; float s = 0.f;
#pragma unroll
                for (int bj = 0; bj < 2; ++bj) { const float sc_ = rs2[m]; const u32x4 w = rb[m][bj];
                    const f32x4 r0v = {__uint_as_float(w.x << 16), __uint_as_float(w.x & 0xffff0000u), __uint_as_float(w.y << 16), __uint_as_float(w.y & 0xffff0000u)};
                    const f32x4 r1v = {__uint_as_float(w.z << 16), __uint_as_float(w.z & 0xffff0000u), __uint_as_float(w.w << 16), __uint_as_float(w.w & 0xffff0000u)};
                    const f32x4 a = r0v + acc[ai][bj][m][0] * sc_, b = r1v + acc[ai][bj][m][1] * sc_;
                    if (mode == 2) { *(f32x4*)(out + off + bj * 32) = a; *(f32x4*)(out + off + bj * 32 + 4) = b; }
                    else { *(u32x4*)(hb + off + bj * 32) = pack8(a, b); s += sum4sq(a) + sum4sq(b); } }
                if (mode != 2) { s = red_fq(s); if (fq == 0) ssq[(size_t)row * 16 + u.pn * 4 + wc] = s; }
                if (ai == 0) { const size_t offn = off + (size_t)HALF * 1024;
#pragma unroll
                    for (int bj = 0; bj < 2; ++bj) rb[m][bj] = *(const u32x4*)(hb + offn + bj * 32);
                    asm volatile("" ::: "memory"); } }
        }
        }
    }
};
using EpiResid = EpiResidT<0, 0>;
struct EpiUp {
    static constexpr bool PERM = true, AFTER_DRAIN = false;
    int r0, hid_mib;
    __device__ __forceinline__ void operator()(const f32x4 (&acc)[2][2][4][2], const Unit& u, int wr, int wc, int fr, int fq) const {
        { int t_ = threadIdx.x; asm volatile("" : "+v"(t_)); fr = t_ & 15; fq = (t_ >> 4) & 3; }
        const int col = u.pn * BM + wc * 64 + fq * 8;
        bf16_t* hid = (bf16_t*)(wsp() + (size_t)hid_mib * 1048576);
#pragma unroll
        for (int ai = 0; ai < 2; ++ai)
#pragma unroll
            for (int m = 0; m < 4; ++m) { const int row = u.pm * BM + ai * HALF + wr * 64 + m * 16 + fr;
#pragma unroll
                for (int bj = 0; bj < 2; ++bj) { f32x4 a, b; const f32x2 k2 = {5.9604644775390625e-08f, 5.9604644775390625e-08f};
#pragma unroll
                    for (int hh = 0; hh < 2; ++hh) { const f32x4 s = acc[ai][bj][m][hh]; f32x2 lo = {s[0], s[1]}, hi = {s[2], s[3]};
                        asm("v_pk_mul_f32 %0, %1, %2 clamp" : "=v"(lo) : "v"(lo), "v"(k2)); asm("v_pk_mul_f32 %0, %1, %2 clamp" : "=v"(hi) : "v"(hi), "v"(k2));
                        lo = lo * lo; hi = hi * hi; const f32x4 q = {lo[0], lo[1], hi[0], hi[1]}; if (hh == 0) a = q; else b = q; }
                    *(u32x4*)(hid + (size_t)row * 4096 + col + bj * 32) = pack8(a, b); } }
    }
};
__device__ __forceinline__ void pg8_glds16(const char* sbase, unsigned voff, unsigned lds_dst) { unsigned keep;
    asm volatile("s_mov_b32 %0, m0\n\ts_mov_b32 m0, %3\n\ts_nop 0\n\tglobal_load_lds_dwordx4 %2, %1\n\ts_mov_b32 m0, %0" : "=&s"(keep) : "s"(sbase), "v"(voff), "s"(lds_dst) : "memory"); }

template <int pn_off> struct EpiKvq {
    static constexpr bool PERM = true, AFTER_DRAIN = false;
    __device__ __forceinline__ void operator()(const f32x4 (&acc)[2][2][4][2], const Unit& u, int wr, int wc, int fr, int fq) const {
        { int t_ = threadIdx.x; asm volatile("" : "+v"(t_)); fr = t_ & 15; fq = (t_ >> 4) & 3; }
        const int vpn = u.pn + pn_off; unsigned char* ws = wsp();
        const float* ssqh = (const float*)(ws + WS_SSQH); bf16_t* ckv = (bf16_t*)(ws + WS_CKV); bf16_t* ql = (bf16_t*)(ws + WS_QL); float* krope = (float*)(ws + WS_KROPE); float* ssq_ckv = (float*)(ws + WS_SSQCKV); float* ssq_ql = (float*)(ws + WS_SSQQL); float* ssq_kr = (float*)(ws + WS_SSQKR);
        float rsv[2][4];
        rstd16x8(ssqh, u.pm * BM + wr * 64 + fr, fq, 1.f / 1024.f, rsv);
#pragma unroll
        for (int ai = 0; ai < 2; ++ai)
#pragma unroll
            for (int m = 0; m < 4; ++m) { const int row = u.pm * BM + ai * HALF + wr * 64 + m * 16 + fr; const float rs = rsv[ai][m];
                const f32x4 a0 = acc[ai][0][m][0] * rs, b0 = acc[ai][0][m][1] * rs, a1 = acc[ai][1][m][0] * rs, b1 = acc[ai][1][m][1] * rs;
                if (vpn == 0) { bf16_t* p = ckv + (size_t)row * 256 + wc * 64 + fq * 8; *(u32x4*)p = pack8(a0, b0); *(u32x4*)(p + 32) = pack8(a1, b1);
                    const float s = red_fq((sum4sq(a0) + sum4sq(b0)) + (sum4sq(a1) + sum4sq(b1))); if (fq == 0) ssq_ckv[(size_t)row * 4 + wc] = s; }
                else if (vpn == 1 || wc < 2) { bf16_t* p = ql + (size_t)row * 384 + (vpn - 1) * 256 + wc * 64 + fq * 8; *(u32x4*)p = pack8(a0, b0); *(u32x4*)(p + 32) = pack8(a1, b1);
                    const float s = red_fq((sum4sq(a0) + sum4sq(b0)) + (sum4sq(a1) + sum4sq(b1))); if (fq == 0) ssq_ql[(size_t)row * 8 + (vpn - 1) * 4 + wc] = s; }
                else if (wc == 2 && pn_off == 0) { float* p = krope + (size_t)row * 32 + fq * 8; *(f32x4*)p = a0; *(f32x4*)(p + 4) = b0;
                    const float s = red_fq(sum4sq(a0) + sum4sq(b0)); if (fq == 0) ssq_kr[row] = s; } }
    }
};
struct EpiUkv {
    static constexpr bool PERM = true, AFTER_DRAIN = false;
    __device__ __forceinline__ void operator()(const f32x4 (&acc)[2][2][4][2], const Unit& u, int wr, int wc, int fr, int fq) const {
        { int t_ = threadIdx.x; asm volatile("" : "+v"(t_)); fr = t_ & 15; fq = (t_ >> 4) & 3; }
        const int G = u.pn * 4 + wc, head = G >> 1; const bool isv = (G & 1) != 0; unsigned char* ws = wsp();
        const float* ssq_ckv = (const float*)(ws + WS_SSQCKV); const float* ssq_kr = (const float*)(ws + WS_SSQKR); const float* krope = (const float*)(ws + WS_KROPE); const float* kgain = inp(11); const float* cosT = (const float*)(ws + WS_ROPE); const float* sinT = cosT + SEQ * 16; bf16_t* kb = (bf16_t*)(ws + WS_KB); bf16_t* vb = (bf16_t*)(ws + WS_VB);
        f32x4 g0a, g0b, g1a, g1b, gr1, gr2;
        if (!isv) { g0a = *(const f32x4*)(kgain + fq * 8); g0b = *(const f32x4*)(kgain + fq * 8 + 4); g1a = *(const f32x4*)(kgain + 32 + fq * 8); g1b = *(const f32x4*)(kgain + 36 + fq * 8);
            gr1 = *(const f32x4*)(kgain + 64 + 4 * fq); gr2 = *(const f32x4*)(kgain + 80 + 4 * fq); }
        const int rowb = u.pm * BM + wr * 64 + fr;
        float rsv[2][4], skr[2][4];
        { float v[2][4];
#pragma unroll
          for (int ai = 0; ai < 2; ++ai)
#pragma unroll
              for (int m = 0; m < 4; ++m) { v[ai][m] = ssq_ckv[(size_t)(rowb + ai * HALF + m * 16) * 4 + fq]; skr[ai][m] = isv ? 0.f : ssq_kr[rowb + ai * HALF + m * 16]; }
          asm volatile("" : "+v"(v[0][0]), "+v"(v[0][1]), "+v"(v[0][2]), "+v"(v[0][3]), "+v"(v[1][0]), "+v"(v[1][1]), "+v"(v[1][2]), "+v"(v[1][3]),
                            "+v"(skr[0][0]), "+v"(skr[0][1]), "+v"(skr[0][2]), "+v"(skr[0][3]), "+v"(skr[1][0]), "+v"(skr[1][1]), "+v"(skr[1][2]), "+v"(skr[1][3]));
#pragma unroll
          for (int ai = 0; ai < 2; ++ai)
#pragma unroll
              for (int m = 0; m < 4; ++m) rsv[ai][m] = __builtin_amdgcn_rsqf(red_fq(v[ai][m]) * (1.f / 256.f) + RMS_EPS); }
#pragma unroll
        for (int ai = 0; ai < 2; ++ai)
#pragma unroll
            for (int m = 0; m < 4; ++m) { const int row = rowb + ai * HALF + m * 16; const float rs = rsv[ai][m];
                f32x4 kx1, kx2, cc, ss;
                if (!isv) { const int pos = row & 4095;
                    kx1 = *(const f32x4*)(krope + (size_t)row * 32 + 4 * fq); kx2 = *(const f32x4*)(krope + (size_t)row * 32 + 16 + 4 * fq);
                    cc = *(const f32x4*)(cosT + pos * 16 + 4 * fq); ss = *(const f32x4*)(sinT + pos * 16 + 4 * fq);
                    asm volatile("" : "+v"(kx1), "+v"(kx2), "+v"(cc), "+v"(ss)); }
                const f32x4 a0 = acc[ai][0][m][0] * rs, b0 = acc[ai][0][m][1] * rs, a1 = acc[ai][1][m][0] * rs, b1 = acc[ai][1][m][1] * rs;
                if (isv) { bf16_t* p = vb + ((((size_t)(row >> 12) * 16 + head) << 12) + (row & 4095)) * 64 + fq * 8; *(u32x4*)p = pack8(a0, b0); *(u32x4*)(p + 32) = pack8(a1, b1); }
                else { const float s = red_fq((sum4sq(a0) + sum4sq(b0)) + (sum4sq(a1) + sum4sq(b1))) + skr[ai][m]; const float rk = __builtin_amdgcn_rsqf(s * (1.f / 96.f) + RMS_EPS);
                    bf16_t* p = kb + ((((size_t)(row >> 12) * 16 + head) << 12) + (row & 4095)) * 96; *(u32x4*)(p + fq * 8) = pack8(a0 * g0a * rk, b0 * g0b * rk); *(u32x4*)(p + 32 + fq * 8) = pack8(a1 * g1a * rk, b1 * g1b * rk);
                    const f32x4 x1 = kx1 * gr1 * rk, x2 = kx2 * gr2 * rk;
                    const f32x4 o1 = x1 * cc - x2 * ss, o2 = x2 * cc + x1 * ss;
                    typedef unsigned u32x2v __attribute__((ext_vector_type(2)));
                    u32x2v w1, w2; w1.x = cvt_pk_bf16(o1[0], o1[1]); w1.y = cvt_pk_bf16(o1[2], o1[3]); w2.x = cvt_pk_bf16(o2[0], o2[1]); w2.y = cvt_pk_bf16(o2[2], o2[3]);
                    *(u32x2v*)(p + 64 + 4 * fq) = w1; *(u32x2v*)(p + 80 + 4 * fq) = w2; } }
    }
};
struct EpiUq {
    static constexpr bool PERM = true, AFTER_DRAIN = false;
    __device__ __forceinline__ void operator()(const f32x4 (&acc)[2][2][4][2], const Unit& u, int wr, int wc, int fr, int fq) const {
        { int t_ = threadIdx.x; asm volatile("" : "+v"(t_)); fr = t_ & 15; fq = (t_ >> 4) & 3; }
        const int col = u.pn * BM + wc * 64 + fq * 8; const float* ssq_ql = (const float*)(wsp() + WS_SSQQL); bf16_t* qb = (bf16_t*)(wsp() + WS_QB);
        float rsv[2][4];
        rstd6x8(ssq_ql, u.pm * BM + wr * 64 + fr, fq, 1.f / 384.f, rsv);
#pragma unroll
        for (int ai = 0; ai < 2; ++ai)
#pragma unroll
            for (int m = 0; m < 4; ++m) { const int row = u.pm * BM + ai * HALF + wr * 64 + m * 16 + fr; const float rs = rsv[ai][m];
                bf16_t* p = qb + (size_t)row * 1536 + col; *(u32x4*)p = pack8(acc[ai][0][m][0] * rs, acc[ai][0][m][1] * rs); *(u32x4*)(p + 32) = pack8(acc[ai][1][m][0] * rs, acc[ai][1][m][1] * rs); }
    }
};

struct EpiInproj {
    static constexpr bool PERM = true, AFTER_DRAIN = false;
    int layer;
    __device__ __forceinline__ void operator()(const f32x4 (&acc)[2][2][4][2], const Unit& u, int wr, int wc, int fr, int fq) const {
        { int t_ = threadIdx.x; asm volatile("" : "+v"(t_)); fr = t_ & 15; fq = (t_ >> 4) & 3; }
        unsigned char* ws = wsp(); const float* ssqh = (const float*)(ws + WS_SSQH);
        const bool isq = u.pn < 4, isk = (u.pn == 4 && wc == 0), normed = isq || isk;
        f32x4 g0a = {1.f, 1.f, 1.f, 1.f}, g0b = g0a, g1a = g0a, g1b = g0a;
        if (normed) { const float* gp = (isq ? inp(4) : inp(5)) + layer * 64 + fq * 8; const float sc = isq ? 0.125f * 1.4426950408889634f : 1.f;
            g0a = *(const f32x4*)gp * sc; g0b = *(const f32x4*)(gp + 4) * sc; g1a = *(const f32x4*)(gp + 32) * sc; g1b = *(const f32x4*)(gp + 36) * sc; }
        bf16_t* dst; int ld;
        if (isq) { dst = (bf16_t*)(ws + WS_AQ) + (u.pn * 4 + wc) * 64; ld = 1024; }
        else if (u.pn == 4) { dst = (bf16_t*)(ws + (wc == 0 ? WS_AK : wc == 1 ? WS_AV : WS_AKI)); ld = 64; }
        else { dst = (bf16_t*)(ws + WS_AQI) + ((u.pn - 5) * 4 + wc) * 64; ld = 512; }
        const bool iswi = (u.pn == 4 && wc == 3);
        float rsv[2][4];
        rstd16x8(ssqh, u.pm * BM + wr * 64 + fr, fq, 1.f / 1024.f, rsv);
#pragma unroll
        for (int ai = 0; ai < 2; ++ai)
#pragma unroll
            for (int m = 0; m < 4; ++m) { const int row = u.pm * BM + ai * HALF + wr * 64 + m * 16 + fr; const float rs = rsv[ai][m];
                f32x4 a0 = acc[ai][0][m][0] * rs, b0 = acc[ai][0][m][1] * rs, a1 = acc[ai][1][m][0] * rs, b1 = acc[ai][1][m][1] * rs;
                if (iswi) { if (fq == 0) { float* p = (float*)(ws + WS_AWI) + (size_t)row * 8; *(f32x4*)p = a0; *(f32x4*)(p + 4) = b0; } }
                else { if (normed) { const float s = red_fq((sum4sq(a0) + sum4sq(b0)) + (sum4sq(a1) + sum4sq(b1))); const float rq = __builtin_amdgcn_rsqf(s * (1.f / 64.f) + RMS_EPS);
                        a0 = a0 * g0a * rq; b0 = b0 * g0b * rq; a1 = a1 * g1a * rq; b1 = b1 * g1b * rq; }
                    bf16_t* p = dst + (size_t)row * ld + fq * 8; *(u32x4*)p = pack8(a0, b0); *(u32x4*)(p + 32) = pack8(a1, b1); } }
    }
};
template <class Epi, class Sched, bool ALIGN_EPI = false, bool SP2 = false>
__device__ __forceinline__ void gemm_phase(PG8_LAS unsigned char* lds, const Gemm g, const Sched& S, const Epi& E) {
    int tid_ = threadIdx.x; asm volatile("" : "+v"(tid_));
    const int tid = tid_, wid = __builtin_amdgcn_readfirstlane(tid >> 6), lane = tid & 63, wr = wid >> 2, wc = wid & 3, fr = lane & 15, fq = lane >> 4;
    const int K = g.K, nt = K / BK;
    unsigned voffA[2], voffB[2];
#pragma unroll
    for (int i = 0; i < 2; ++i) { int R, C; stage_rc(tid * 16 + i * 8192, R, C); const int Rb = Epi::PERM ? ((R & ~31) + perm32(R & 31)) : R;
        voffA[i] = (unsigned)(R * K + C) * 2u; voffB[i] = (unsigned)(Rb * K + C) * 2u; }
    const size_t kstep = (size_t)(BK * 2);
    const size_t hstep = (size_t)HALF * K * 2;
    const size_t tstep = 2 * hstep;
    const unsigned ldsw = (unsigned)wid * 1024u;
    const unsigned ldsb = (unsigned)__builtin_amdgcn_readfirstlane((int)((unsigned)(unsigned long long)lds + ldsw));
    const int aoff = lds_byte(wr * 64 + fr, fq * 8), boff = lds_byte(wc * 32 + fr, fq * 8);
#define PG8_SA(b, h) (((b) * 2 + (h)) * HTB)
#define PG8_SB(b, h) ((4 + (b) * 2 + (h)) * HTB)
#define PG8_STAGE(bufoff, gbase, voff) do { _Pragma("unroll") for (int _i = 0; _i < 2; ++_i) \
        pg8_glds16((const char*)(gbase), (voff)[_i], ldsb + (unsigned)((bufoff) + _i * 8192)); } while (0)
#define PG8_LDA(dst, b, h) do { _Pragma("unroll") for (int m = 0; m < 4; ++m) _Pragma("unroll") for (int k = 0; k < 2; ++k) dst[m][k] = *(const PG8_LAS bf16x8*)(lds + PG8_SA(b, h) + aoff + m * 2048 + k * 1024); } while (0)
#define PG8_LDB(dst, b, h) do { _Pragma("unroll") for (int n = 0; n < 2; ++n) _Pragma("unroll") for (int k = 0; k < 2; ++k) dst[n][k] = *(const PG8_LAS bf16x8*)(lds + PG8_SB(b, h) + boff + n * 2048 + k * 1024); } while (0)
#define PG8_MMA(ai, bj, At, Bt) do { __builtin_amdgcn_s_setprio(1); _Pragma("unroll") for (int m = 0; m < 4; ++m) _Pragma("unroll") for (int n = 0; n < 2; ++n) _Pragma("unroll") for (int k = 0; k < 2; ++k) \
        acc[ai][bj][m][n] = __builtin_amdgcn_mfma_f32_16x16x32_bf16(Bt[n][k], At[m][k], acc[ai][bj][m][n], 0, 0, 0); __builtin_amdgcn_s_setprio(0); } while (0)
#define PG8_WAIT_V(n) asm volatile("s_waitcnt vmcnt(" #n ")" ::: "memory")
#define PG8_WAIT_L(n) asm volatile("s_waitcnt lgkmcnt(" #n ")" ::: "memory")
#define PG8_BAR __builtin_amdgcn_s_barrier()
#define PG8_SCHED __builtin_amdgcn_sched_barrier(0)
    Unit cur, nxt; int ui = 0;
    if (!S.next(0, cur)) return;
    f32x4 acc[2][2][4][2];
#pragma unroll
    for (int a = 0; a < 2; ++a)
#pragma unroll
        for (int b = 0; b < 2; ++b)
#pragma unroll
            for (int m = 0; m < 4; ++m)
#pragma unroll
                for (int n = 0; n < 2; ++n) acc[a][b][m][n] = (f32x4){0.f, 0.f, 0.f, 0.f};
    bf16x8 At[4][2], B0[2][2], B1[2][2];
    const char* cA = (const char*)g.A + (size_t)cur.pm * tstep; const char* cB = (const char*)g.Bt + (size_t)cur.pn * tstep;
    S.a_ready(cur);
    if constexpr (SP2) {
        PG8_STAGE(PG8_SB(0, 0), cB, voffB); PG8_STAGE(PG8_SB(0, 1), cB + hstep, voffB); PG8_STAGE(PG8_SA(0, 0), cA, voffA); PG8_STAGE(PG8_SA(0, 1), cA + hstep, voffA);
        if (wr == 1) PG8_BAR;
        PG8_WAIT_V(2); PG8_BAR;
        PG8_STAGE(PG8_SB(1, 0), cB + kstep, voffB); PG8_STAGE(PG8_SA(1, 0), cA + kstep, voffA); PG8_STAGE(PG8_SB(1, 1), cB + hstep + kstep, voffB);
        PG8_WAIT_V(6); PG8_BAR;
    } else {
        PG8_STAGE(PG8_SB(0, 0), cB, voffB); PG8_STAGE(PG8_SA(0, 0), cA, voffA); PG8_STAGE(PG8_SB(0, 1), cB + hstep, voffB); PG8_STAGE(PG8_SA(0, 1), cA + hstep, voffA);
        if (wr == 1) PG8_BAR;
        PG8_WAIT_V(4); PG8_BAR;
        PG8_STAGE(PG8_SB(1, 0), cB + kstep, voffB); PG8_STAGE(PG8_SA(1, 0), cA + kstep, voffA); PG8_STAGE(PG8_SB(1, 1), cB + hstep + kstep, voffB);
        PG8_WAIT_V(6); PG8_BAR;
    }
    for (;;) {
        const bool has_next = S.next(ui + 1, nxt);
        const char* nA = has_next ? (const char*)g.A + (size_t)nxt.pm * tstep : cA; const char* nB = has_next ? (const char*)g.Bt + (size_t)nxt.pn * tstep : cB;
        for (int t = 0; t < nt; t += 2) {
            const bool last = (t == nt - 2);
            const char* a1 = cA + (size_t)(t + 1) * kstep;
            const char* a2 = last ? nA : cA + (size_t)(t + 2) * kstep; const char* b2 = last ? nB : cB + (size_t)(t + 2) * kstep;
            const char* a3 = a2 + kstep; const char* b3 = b2 + kstep;
            if (last && has_next) S.a_ready(nxt);
            if constexpr (SP2) {
            PG8_LDB(B0, 0, 0); PG8_LDB(B1, 0, 1); PG8_SCHED; PG8_LDA(At, 0, 0); PG8_STAGE(PG8_SA(1, 1), a1 + hstep, voffA);
            PG8_WAIT_V(8); PG8_WAIT_L(0); PG8_BAR; PG8_MMA(0, 0, At, B0); PG8_MMA(0, 1, At, B1); PG8_BAR; PG8_SCHED;
            PG8_LDA(At, 0, 1); PG8_STAGE(PG8_SB(0, 0), b2, voffB); PG8_STAGE(PG8_SB(0, 1), b2 + hstep, voffB); PG8_STAGE(PG8_SA(0, 0), a2, voffA);
            PG8_WAIT_V(8); PG8_WAIT_L(0); PG8_BAR; PG8_MMA(1, 0, At, B0); PG8_MMA(1, 1, At, B1); PG8_BAR; PG8_SCHED;
            PG8_LDB(B0, 1, 0); PG8_LDB(B1, 1, 1); PG8_SCHED; PG8_LDA(At, 1, 0); PG8_STAGE(PG8_SA(0, 1), a2 + hstep, voffA);
            PG8_WAIT_V(8); PG8_WAIT_L(0); PG8_BAR; PG8_MMA(0, 0, At, B0); PG8_MMA(0, 1, At, B1); PG8_BAR; PG8_SCHED;
            PG8_LDA(At, 1, 1); PG8_STAGE(PG8_SB(1, 0), b3, voffB); PG8_STAGE(PG8_SB(1, 1), b3 + hstep, voffB); PG8_STAGE(PG8_SA(1, 0), a3, voffA);
            PG8_WAIT_V(8); PG8_WAIT_L(0); PG8_BAR; PG8_MMA(1, 0, At, B0); PG8_MMA(1, 1, At, B1); PG8_BAR; PG8_SCHED;
            } else {
            PG8_LDB(B0, 0, 0); PG8_SCHED; PG8_LDA(At, 0, 0); PG8_STAGE(PG8_SA(1, 1), a1 + hstep, voffA);
            PG8_WAIT_L(8); PG8_BAR; PG8_WAIT_L(0); PG8_MMA(0, 0, At, B0); PG8_BAR; PG8_SCHED;
            PG8_LDB(B1, 0, 1); PG8_STAGE(PG8_SB(0, 0), b2, voffB);
            PG8_BAR; PG8_WAIT_L(0); PG8_MMA(0, 1, At, B1); PG8_BAR;
            PG8_LDA(At, 0, 1); PG8_STAGE(PG8_SA(0, 0), a2, voffA);
            PG8_BAR; PG8_WAIT_L(0); PG8_MMA(1, 0, At, B0); PG8_BAR; PG8_SCHED;
            PG8_STAGE(PG8_SB(0, 1), b2 + hstep, voffB);
            PG8_WAIT_V(6); PG8_BAR; PG8_MMA(1, 1, At, B1); PG8_BAR;
            PG8_LDB(B0, 1, 0); PG8_SCHED; PG8_LDA(At, 1, 0); PG8_STAGE(PG8_SA(0, 1), a2 + hstep, voffA);
            PG8_WAIT_L(8); PG8_BAR; PG8_WAIT_L(0); PG8_MMA(0, 0, At, B0); PG8_BAR; PG8_SCHED;
            PG8_LDB(B1, 1, 1); PG8_STAGE(PG8_SB(1, 0), b3, voffB);
            PG8_BAR; PG8_WAIT_L(0); PG8_MMA(0, 1, At, B1); PG8_BAR;
            PG8_LDA(At, 1, 1); PG8_STAGE(PG8_SA(1, 0), a3, voffA);
            PG8_BAR; PG8_WAIT_L(0); PG8_MMA(1, 0, At, B0); PG8_BAR; PG8_SCHED;
            PG8_STAGE(PG8_SB(1, 1), b3 + hstep, voffB);
            PG8_WAIT_V(6); PG8_BAR; PG8_MMA(1, 1, At, B1); PG8_BAR;
            }
        }
        if constexpr (ALIGN_EPI) { if (wr == 0) PG8_BAR; }
        if constexpr (!Epi::AFTER_DRAIN) { E(acc, cur, wr, wc, fr, fq); S.done(cur); }
        if (!has_next) break;
#pragma unroll
        for (int a = 0; a < 2; ++a)
#pragma unroll
            for (int b = 0; b < 2; ++b)
#pragma unroll
                for (int m = 0; m < 4; ++m)
#pragma unroll
                    for (int n = 0; n < 2; ++n) acc[a][b][m][n] = (f32x4){0.f, 0.f, 0.f, 0.f};
        cur = nxt; cA = nA; cB = nB; ++ui;
        if constexpr (ALIGN_EPI) { if (wr == 1) PG8_BAR; }
    }
    PG8_WAIT_V(0);
    if constexpr (!ALIGN_EPI) { if (wr == 0) PG8_BAR; }
    PG8_BAR;
    if constexpr (Epi::AFTER_DRAIN) { E.fused(acc, cur, wr, wc, fr, fq, lds, wid, lane); S.done(cur); }
#undef PG8_SA
#undef PG8_SB
#undef PG8_STAGE
#undef PG8_LDA
#undef PG8_LDB
#undef PG8_MMA
#undef PG8_WAIT_V
#undef PG8_WAIT_L
#undef PG8_BAR
#undef PG8_SCHED
}
}
__device__ __forceinline__ unsigned long long rt() { return __builtin_amdgcn_s_memrealtime(); }
__device__ __forceinline__ unsigned f2bf(float f) { unsigned u = __builtin_bit_cast(unsigned, f); return (u + 0x7fffu + ((u >> 16) & 1u)) >> 16; }
__device__ __forceinline__ unsigned pk2(float lo, float hi) { return f2bf(lo) | (f2bf(hi) << 16); }

#define XB_TMO      128
#define XB_XCNT(j)  (256  + 64 * (j))
#define XB_XSUB(j)  (1280 + 64 * (j))
#define XB_XGEN(j)  (2304 + 64 * (j))
#define XB_TOP      3328
#define XB_TOPGEN   3392
#define XCD_BAR_WORDS 3456
#define XB_SPIN_CAP (1u << 18)

__device__ __forceinline__ unsigned xb_ld(unsigned* p)              { return __hip_atomic_load(p, __ATOMIC_RELAXED, __HIP_MEMORY_SCOPE_AGENT); }
__device__ __forceinline__ unsigned xb_add(unsigned* p, unsigned v) { return __hip_atomic_fetch_add(p, v, __ATOMIC_RELAXED, __HIP_MEMORY_SCOPE_AGENT); }
__device__ __forceinline__ unsigned xb_xcc_id() { return (unsigned)__builtin_amdgcn_s_getreg((3 << 11) | 20) & 0xFu; }
#define XB_SPIN(cond, bar) do { unsigned _sp = 0; while (cond) { __builtin_amdgcn_s_sleep(1); \
    if ((++_sp & 255u) == 0u) { if (xb_ld(&(bar)[XB_TMO])) break; if (_sp > XB_SPIN_CAP) { atomicAdd(&(bar)[XB_TMO], 1u); break; } } } } while (0)

struct XcdBarrier {
    unsigned* bar; unsigned x;
    volatile LAS unsigned* st;
};

__device__ __forceinline__ XcdBarrier xcd_barrier_post(unsigned* bar, volatile LAS unsigned* st) {
    XcdBarrier b; b.bar = bar; b.x = xb_xcc_id(); b.st = st;
    if (threadIdx.x == 0) (void)xb_add(&bar[XB_XCNT(b.x)], 1u);
    return b;
}
__device__ __forceinline__ void xcd_barrier_complete(unsigned* bar, unsigned x, unsigned& nloc, unsigned& nx) {
    const unsigned G = gridDim.x * gridDim.y * gridDim.z;
    unsigned sum, cnt, mine, sp = 0u;
    for (;;) {
        sum = 0u; cnt = 0u; mine = 0u;
#pragma unroll
        for (unsigned j = 0; j < 16; ++j) { const unsigned c = xb_ld(&bar[XB_XCNT(j)]); sum += c; cnt += (c > 0u) ? 1u : 0u; }
        if (sum == G) break;
        __builtin_amdgcn_s_sleep(1);
        if ((++sp & 255u) == 0u) { if (xb_ld(&bar[XB_TMO])) break; if (sp > XB_SPIN_CAP) { atomicAdd(&bar[XB_TMO], 1u); break; } }
    }
    mine = xb_ld(&bar[XB_XCNT(x)]);
    nloc = mine > 0u ? mine : 1u; nx = cnt > 0u ? cnt : 1u;
}

__device__ __forceinline__ void xcd_barrier(const XcdBarrier& b) {
    asm volatile("s_waitcnt vmcnt(0)" ::: "memory");
    __syncthreads();
    if (threadIdx.x == 0) {
        unsigned* bar = b.bar;
        __builtin_amdgcn_s_waitcnt(0);
        unsigned nloc = b.st[0], nx = b.st[1];
        if (nloc == 0u) { xcd_barrier_complete(bar, b.x, nloc, nx); b.st[0] = nloc; b.st[1] = nx; }
        const unsigned old = xb_add(&bar[XB_XSUB(b.x)], 1u);
        const unsigned gen = old / nloc;
        if (old + 1u == (gen + 1u) * nloc) {
            __builtin_amdgcn_fence(__ATOMIC_RELEASE, "agent");
            asm volatile("s_waitcnt vmcnt(0)" ::: "memory");
            const unsigned og = xb_add(&bar[XB_TOP], 1u);
            const unsigned tg = og / nx;
            if (og + 1u == (tg + 1u) * nx) xb_add(&bar[XB_TOPGEN], 1u);
            else XB_SPIN(xb_ld(&bar[XB_TOPGEN]) == tg, bar);
            __builtin_amdgcn_fence(__ATOMIC_ACQUIRE, "agent");
            xb_add(&bar[XB_XGEN(b.x)], 1u);
            asm volatile("s_waitcnt vmcnt(0)" ::: "memory");
        } else {
            XB_SPIN(xb_ld(&bar[XB_XGEN(b.x)]) == gen, bar);
            __builtin_amdgcn_fence(__ATOMIC_ACQUIRE, "agent");
            asm volatile("s_waitcnt vmcnt(0)" ::: "memory");
        }
    }
    __syncthreads();
}


struct Frame {
    LAS unsigned char* lds;
    volatile LAS unsigned* MISC;
    gu32* ctl;
    int tid, lane, wave;
    int vcu, G, gw;
};
__device__ __forceinline__ float wave_sum(float v) {
#pragma unroll
    for (int o = 1; o < 64; o <<= 1) v += __shfl_xor(v, o);
    return v;
}
__device__ __forceinline__ int phys_row(int lc) { return (lc & ~255) + 128 * ((lc >> 5) & 1) + 32 * ((lc >> 6) & 3) + (lc & 31); }
__device__ __forceinline__ void tr_item128(const float* W, int ldw, int c0, int nvalid, const float* gain, bf16* WT, int Kd, int lc0, int k0, int lane) {
    const int h = lane >> 5, c = lane & 31; const bool act = 4 * c < nvalid;
    if (act) { const int prow = phys_row(lc0 + 4 * c), kb = k0 + 32 * h;
#pragma unroll
        for (int half = 0; half < 2; ++half) { f32x4 v[16];
#pragma unroll
            for (int i = 0; i < 16; ++i) v[i] = W ? __builtin_nontemporal_load((const GAS f32x4*)(W + (size_t)(kb + 16 * half + i) * ldw + c0 + 4 * c)) : (f32x4){0.f, 0.f, 0.f, 0.f};
            if (gain) {
#pragma unroll
                for (int q = 0; q < 4; ++q) { const f32x4 gv = *(const GAS f32x4*)(gain + kb + 16 * half + 4 * q);
#pragma unroll
                    for (int e = 0; e < 4; ++e) v[4 * q + e] = v[4 * q + e] * gv[e]; } }
#pragma unroll
            for (int e = 0; e < 4; ++e) { v4u o0, o1;
                o0.x = pk2(v[0][e], v[1][e]); o0.y = pk2(v[2][e], v[3][e]); o0.z = pk2(v[4][e], v[5][e]); o0.w = pk2(v[6][e], v[7][e]);
                o1.x = pk2(v[8][e], v[9][e]); o1.y = pk2(v[10][e], v[11][e]); o1.z = pk2(v[12][e], v[13][e]); o1.w = pk2(v[14][e], v[15][e]);
                bf16* dst = WT + (size_t)(prow + e) * Kd + kb + 16 * half; *(GAS v4u*)dst = o0; *(GAS v4u*)(dst + 8) = o1; } } }
}
__device__ __forceinline__ void conv_seg(Frame& F, int& rot, const float* W, int ldw, int c0, int ncols, const float* gain, bf16* WT, int Kd, int lc0) {
    const int ng = (ncols + 127) / 128, nk = Kd / 64, nit = ng * nk, NGW = F.G * NWAVES;
    int it = F.gw - rot; if (it < 0) it += NGW;
    for (; it < nit; it += NGW) { const int g = it % ng, kb = it / ng; int nv = ncols - 128 * g; nv = nv > 128 ? 128 : nv;
        tr_item128(W, ldw, c0 + 128 * g, nv, gain, WT, Kd, lc0 + 128 * g, 64 * kb, F.lane); }
    rot = (rot + nit) % NGW;
}
__device__ __forceinline__ void p0_prologue(Frame& F) {
    int rot = 0;
#define ws wsp()
    const int NGW = F.G * NWAVES;
    { bf16* hb = (bf16*)(ws + WS_HB); float* ssq = (float*)(ws + WS_SSQH); const float* x = inp(0);
      for (int r = 2 * F.gw; r < M; r += 2 * NGW) { f32x4 v[2][4]; float s[2];
#pragma unroll
          for (int rr = 0; rr < 2; ++rr) { const GAS f32x4* xr = (const GAS f32x4*)(x + (size_t)(r + rr) * D) + F.lane;
#pragma unroll
              for (int j = 0; j < 4; ++j) v[rr][j] = __builtin_nontemporal_load(xr + 64 * j); }
#pragma unroll
          for (int rr = 0; rr < 2; ++rr) { float t = 0.f;
#pragma unroll
              for (int j = 0; j < 4; ++j) t += (v[rr][j].x * v[rr][j].x + v[rr][j].y * v[rr][j].y) + (v[rr][j].z * v[rr][j].z + v[rr][j].w * v[rr][j].w);
              s[rr] = wave_sum(t);
              GAS unsigned long long* o8 = (GAS unsigned long long*)(hb + (size_t)(r + rr) * D) + F.lane;
#pragma unroll
              for (int j = 0; j < 4; ++j) o8[64 * j] = (unsigned long long)pk2(v[rr][j].x, v[rr][j].y) | ((unsigned long long)pk2(v[rr][j].z, v[rr][j].w) << 32);
              if (F.lane < 16) ssq[(size_t)(r + rr) * 16 + F.lane] = F.lane == 0 ? s[rr] : 0.f; } } }
    { float* ct = (float*)(ws + WS_ROPE); float* st = ct + SEQ * 16;
      for (int e = F.vcu * 512 + F.tid; e < SEQ * 16; e += F.G * 512) { const int pos = e >> 4, i = e & 15;
          const double invd = i == 0 ? 1.0 : i == 1 ? 0.5623413251903491 : i == 2 ? 0.31622776601683794 : i == 3 ? 0.17782794100389226 : i == 4 ? 0.1 : i == 5 ? 0.056234132519034905 : i == 6 ? 0.03162277660168379 : i == 7 ? 0.01778279410038923 :
                              i == 8 ? 0.01 : i == 9 ? 0.005623413251903491 : i == 10 ? 0.003162277660168379 : i == 11 ? 0.001778279410038923 : i == 12 ? 0.001 : i == 13 ? 0.0005623413251903491 : i == 14 ? 0.00031622776601683794 : 0.00017782794100389227;
          const float angf = (float)pos * (float)invd; const double a = (double)angf;
          const double nq = __builtin_rint(a * 0.6366197723675814); const double r = (a - nq * 1.5707963267948966) - nq * 6.123233995736766e-17; const double r2 = r * r;
          const double sn = r * (1.0 + r2 * (-1.0 / 6 + r2 * (1.0 / 120 + r2 * (-1.0 / 5040 + r2 * (1.0 / 362880 + r2 * (-1.0 / 39916800 + r2 * (1.0 / 6227020800.0)))))));
          const double cs = 1.0 + r2 * (-0.5 + r2 * (1.0 / 24 + r2 * (-1.0 / 720 + r2 * (1.0 / 40320 + r2 * (-1.0 / 3628800 + r2 * (1.0 / 479001600.0 + r2 * (-1.0 / 87178291200.0)))))));
          const int q = (int)nq & 3; const double c = q == 0 ? cs : q == 1 ? -sn : q == 2 ? -cs : sn, s = q == 0 ? sn : q == 1 ? cs : q == 2 ? -sn : -cs;
          ct[e] = (float)c; st[e] = (float)s; } }
    for (int i = 0; i < 2; ++i) { const float* W = inp(3) + (size_t)i * D * A_IN; const float* g = inp(2) + i * D; bf16* WT = (bf16*)(ws + WS_WIN) + (size_t)i * WIN_ELEMS;
        conv_seg(F, rot, W, A_IN, 0, 1152, g, WT, D, 0);
        conv_seg(F, rot, W, A_IN, 1664, 64, g, WT, D, 1152);
        conv_seg(F, rot, W, A_IN, 1728, 8, g, WT, D, 1216);
        conv_seg(F, rot, nullptr, 0, 0, 56, nullptr, WT, D, 1224);
        conv_seg(F, rot, W, A_IN, 1152, 512, g, WT, D, 1280);
        conv_seg(F, rot, inp(6) + (size_t)i * D * D, D, 0, D, nullptr, (bf16*)(ws + WS_WOA) + (size_t)i * D * D, D, 0); }
    { bf16* WT = (bf16*)(ws + WS_WKVQ);
      conv_seg(F, rot, inp(8), 288, 0, 256, inp(7), WT, D, 0);
      conv_seg(F, rot, inp(13), QLORA, 0, QLORA, inp(12), WT, D, 256);
      conv_seg(F, rot, inp(8), 288, 256, 32, inp(7), WT, D, 640);
      conv_seg(F, rot, nullptr, 0, 0, 96, nullptr, WT, D, 672); }
    conv_seg(F, rot, inp(10), NUKV, 0, NUKV, inp(9), (bf16*)(ws + WS_WUKV), KVLORA, 0);
    { bf16* WT = (bf16*)(ws + WS_WDQ1);
      conv_seg(F, rot, inp(13) + (size_t)D * QLORA, QLORA, 0, QLORA, inp(12) + D, WT, D, 0);
      conv_seg(F, rot, nullptr, 0, 0, 128, nullptr, WT, D, 384); }
    for (int j = 0; j < 2; ++j) {
        conv_seg(F, rot, inp(15) + (size_t)j * QLORA * NUQ, NUQ, 0, NUQ, inp(14) + j * QLORA, (bf16*)(ws + WS_WUQ) + (size_t)j * WUQ_ELEMS, QLORA, 0);
        conv_seg(F, rot, inp(17) + (size_t)j * D * D, D, 0, D, nullptr, (bf16*)(ws + WS_WOB) + (size_t)j * D * D, D, 0); }
    for (int L = 0; L < 4; ++L) {
        conv_seg(F, rot, inp(19) + (size_t)L * D * FF, FF, 0, FF, inp(18) + L * D, (bf16*)(ws + WS_WUP) + (size_t)L * D * FF, D, 0);
        conv_seg(F, rot, inp(20) + (size_t)L * D * FF, D, 0, D, nullptr, (bf16*)(ws + WS_WDN) + (size_t)L * D * FF, FF, 0); }
#undef ws
}
namespace mla {
using bf16x8 = __attribute__((ext_vector_type(8))) short;
using s16x4  = __attribute__((ext_vector_type(4))) short;
using f32x16 = __attribute__((ext_vector_type(16))) float;
using u32x4  = __attribute__((ext_vector_type(4))) unsigned;
typedef __attribute__((address_space(3))) const char* lds_cptr;
typedef short v4i16_t __attribute__((ext_vector_type(4)));
constexpr int NW = 8, QBLK = 32, KVBLK = 64, LDQ = 1536, LDK = 96, LDV = 64, LDO = 1024, SEQL = 4096;
constexpr float SCALE = 0.10206207261596575f;
constexpr float THRL = 8.f;
constexpr int SHM_K = KVBLK * 96 * 2, SHM_V = KVBLK * 64 * 2;
constexpr int NSLOT = 5, SLOTB = SHM_K + SHM_V;
constexpr int LDS_OST = NSLOT * SLOTB, LDS_WS = LDS_OST + NW * 4096;
constexpr int SHM_ATTN = LDS_WS + NW * 256;
#define SBAR() __builtin_amdgcn_sched_barrier(0)
#define PIN(x) asm volatile("" : "+v"(x))
#define MFMA(a, b, c) __builtin_amdgcn_mfma_f32_32x32x16_bf16((a), (b), (c), 0, 0, 0)
__device__ __forceinline__ int crow(int r, int hi) { return (r & 3) + 8 * (r >> 2) + 4 * hi; }
__device__ __forceinline__ unsigned cvtpk(float lo, float hi) { return pg8::cvt_pk_bf16(lo, hi); }
__device__ __forceinline__ float bf2f(short s) { return __uint_as_float(((unsigned)(unsigned short)s) << 16); }
__device__ __forceinline__ void kload2(bf16x8* kf, lds_cptr kp, int d0) { kf[2 * d0] = *(const __attribute__((address_space(3))) bf16x8*)(kp + d0 * 2048); kf[2 * d0 + 1] = *(const __attribute__((address_space(3))) bf16x8*)(kp + d0 * 2048 + 512); }
__device__ __forceinline__ s16x4 vtr(lds_cptr p) { return __builtin_bit_cast(s16x4, __builtin_amdgcn_ds_read_tr16_b64_v4i16((__attribute__((address_space(3))) v4i16_t*)p)); }
#define MX3(a, b, c) __builtin_fmaxf(__builtin_fmaxf((a), (b)), (c))
__device__ __forceinline__ float rowmax(const f32x16& p0, const f32x16& p1) {
  float a = MX3(p0[0], p0[1], p1[0]), b = MX3(p0[2], p0[3], p1[1]); a = MX3(a, p1[2], p1[3]);
#pragma unroll
  for (int r = 4; r < 16; r += 4) { a = MX3(a, p0[r], p0[r + 1]); b = MX3(b, p0[r + 2], p0[r + 3]); a = MX3(a, p1[r], p1[r + 1]); b = MX3(b, p1[r + 2], p1[r + 3]); }
  float m = __builtin_fmaxf(a, b); auto rr = __builtin_amdgcn_permlane32_swap(__float_as_uint(m), __float_as_uint(m), false, false);
  return __builtin_fmaxf(__uint_as_float(rr[0]), __uint_as_float(rr[1])); }

__device__ __forceinline__ void attn_unit(const pg8::bf16_t* __restrict__ Qh, const pg8::bf16_t* __restrict__ Kh, const pg8::bf16_t* __restrict__ Vh, pg8::bf16_t* __restrict__ Oh,
                                          const float* __restrict__ qgain, const float* __restrict__ cosT, const float* __restrict__ sinT, int qb, char* lds,
                                          const pg8::bf16_t* __restrict__ Kn, const pg8::bf16_t* __restrict__ Vn, bool pre, int& ring) {
  int tid_ = threadIdx.x; asm volatile("" : "+v"(tid_));
  const int tid = tid_, wid = __builtin_amdgcn_readfirstlane(tid >> 6), lane = tid & 63, r32 = lane & 31, hi = lane >> 5;
  float* wsf = (float*)(lds + LDS_WS) + wid * 64;
  float m_reg = 0.f, l_reg = 0.f; f32x16 o[2]; o[0] = f32x16{}; o[1] = f32x16{}; bf16x8 qr[6];
  f32x16 negm = f32x16{}; PIN(negm);
  const int q0 = qb * 256, qrow = q0 + wid * QBLK + r32;
  const int NT = 4 * qb + 4, cqw = 4 * qb + (wid >> 1);
  const unsigned kvo0 = (unsigned)(lane * (LDK * 2) + wid * 16), kvo1 = (unsigned)(lane * (LDK * 2) + (8 + (wid & 3)) * 16);
  const unsigned vvo = (unsigned)((16 * (wid & 3) + (lane >> 2)) * (LDV * 2) + (wid >> 2) * 64 + (lane & 3) * 16);
  const unsigned lds0 = (unsigned)(uintptr_t)lds;
#define DMA(t, sl) do { const bool nx_ = (t) >= NT && Kn != nullptr; const int tt_ = (t) < NT ? (t) : (nx_ ? (t) - NT : NT - 1); const unsigned sl_ = lds0 + (sl);     \
    const char* kb_ = (const char*)(nx_ ? Kn : Kh) + (size_t)tt_ * (KVBLK * LDK * 2); const char* vb_ = (const char*)(nx_ ? Vn : Vh) + (size_t)tt_ * (KVBLK * LDV * 2);  \
    pg8::pg8_glds16(kb_, kvo0, sl_ + wid * 1024); pg8::pg8_glds16(kb_, kvo1, sl_ + (8 + (wid & 3)) * 1024); pg8::pg8_glds16(vb_, vvo, sl_ + SHM_K + wid * 1024); } while (0)
#define VMWAIT(n) asm volatile("s_waitcnt vmcnt(" #n ")" ::: "memory")
#define BAR() __builtin_amdgcn_s_barrier()
  const lds_cptr vp0 = (lds_cptr)lds + SHM_K + ((lane >> 4) & 1) * 32 + (lane & 3) * 8 + (4 * hi + ((lane & 15) >> 2)) * 64;
  const lds_cptr kp0 = (lds_cptr)lds + hi * 1024 + r32 * 16;
#define WRAP(x) ((x) >= NSLOT * SLOTB ? (x) - NSLOT * SLOTB : (x))
  const int s0_ = ring, s1_ = WRAP(s0_ + SLOTB), s2_ = WRAP(s1_ + SLOTB), s3_ = WRAP(s2_ + SLOTB), s4_ = WRAP(s3_ + SLOTB);
  if (!pre) { DMA(0, s0_); DMA(1, s1_); DMA(2, s2_); }
  {
    const pg8::bf16_t* Qw = Qh + (size_t)qrow * LDQ + hi * 8; float qf[6][8]; float ss = 0.f;
#pragma unroll
    for (int d0 = 0; d0 < 6; ++d0) { const bf16x8 raw = *reinterpret_cast<const bf16x8*>(Qw + d0 * 16);
#pragma unroll
      for (int j = 0; j < 8; ++j) { qf[d0][j] = bf2f(raw[j]); ss += qf[d0][j] * qf[d0][j]; } }
    { auto rr = __builtin_amdgcn_permlane32_swap(__float_as_uint(ss), __float_as_uint(ss), false, false); ss = __uint_as_float(rr[0]) + __uint_as_float(rr[1]); }
    const float rq = __builtin_amdgcn_rsqf(ss * (1.f / 96.f) + 1e-6f);
#pragma unroll
    for (int d0 = 0; d0 < 6; ++d0)
#pragma unroll
      for (int j = 0; j < 8; ++j) qf[d0][j] *= (rq * (SCALE * 1.4426950408889634f)) * qgain[d0 * 16 + hi * 8 + j];
#pragma unroll
    for (int j = 0; j < 8; ++j) { const float c = cosT[qrow * 16 + hi * 8 + j], s = sinT[qrow * 16 + hi * 8 + j]; const float x1 = qf[4][j], x2 = qf[5][j];
      qf[4][j] = x1 * c - x2 * s; qf[5][j] = x2 * c + x1 * s; }
#pragma unroll
    for (int d0 = 0; d0 < 6; ++d0) { u32x4 w = {cvtpk(qf[d0][0], qf[d0][1]), cvtpk(qf[d0][2], qf[d0][3]), cvtpk(qf[d0][4], qf[d0][5]), cvtpk(qf[d0][6], qf[d0][7])}; qr[d0] = __builtin_bit_cast(bf16x8, w); }
  }
  bool resc = false;
  f32x16 pA0, pA1, pB0, pB1; bf16x8 kf[12]; s16x4 vlo[4], vhi[4]; u32x4 pw0, pw1, pw2, pw3;
  int sl_prev = s0_, sl_cur = s1_, sl_next = s2_;
#define ROT() do { sl_prev = sl_cur; sl_cur = sl_next; sl_next = (sl_next == (NSLOT - 1) * SLOTB) ? 0 : sl_next + SLOTB; } while (0)
#define EX(v) __builtin_amdgcn_exp2f(v)
#define RESC() do { if (resc) { _Pragma("unroll") for (int d_ = 0; d_ < 2; ++d_) _Pragma("unroll") for (int r = 0; r < 16; ++r) o[d_][r] *= wsf[crow(r, hi)]; } } while (0)
#define DECIDE(C0, C1) do { const float pm_ = rowmax(C0, C1); resc = false;                                                              \
    if (__builtin_expect(__any(pm_ > THRL), 0)) { const float dl = __builtin_fmaxf(pm_, 0.f); m_reg += dl; const float nm_ = -m_reg;      \
      asm volatile("s_nop 15\n\ts_nop 7" ::: "memory");           \
      _Pragma("unroll") for (int r = 0; r < 16; ++r) { float a_ = C0[r], b_ = C1[r], c_ = negm[r];               \
        asm volatile("v_sub_f32 %0, %0, %3\n\tv_sub_f32 %1, %1, %3\n\tv_mov_b32 %2, %4" : "+v"(a_), "+v"(b_), "+v"(c_) : "v"(dl), "v"(nm_)); C0[r] = a_; C1[r] = b_; negm[r] = c_; } \
      const float f = __builtin_amdgcn_exp2f(-dl); l_reg *= f; if (hi == 0) wsf[r32] = f; resc = true; }                                  \
    PIN(negm); } while (0)
  VMWAIT(0); BAR();
  DMA(3, s3_);
  _Pragma("unroll") for (int d0 = 0; d0 < 6; ++d0) kload2(kf, kp0 + s0_, d0);
  pA0 = MFMA(kf[0], qr[0], negm); pA1 = MFMA(kf[1], qr[0], negm);
  _Pragma("unroll") for (int d0 = 1; d0 < 6; ++d0) { pA0 = MFMA(kf[2 * d0], qr[d0], pA0); pA1 = MFMA(kf[2 * d0 + 1], qr[d0], pA1); }
  DECIDE(pA0, pA1);
  _Pragma("unroll") for (int r = 0; r < 16; ++r) pA0[r] = EX(pA0[r]);
  _Pragma("unroll") for (int r = 0; r < 8; ++r) pA1[r] = EX(pA1[r]);
  _Pragma("unroll") for (int d0 = 0; d0 < 3; ++d0) kload2(kf, kp0 + s1_, d0);
  BAR(); RESC();
  DMA(4, s4_);
#define PKW(P, i) cvtpk(P[i], P[i + 1])
#define PAF(k) __builtin_bit_cast(bf16x8, pw##k)
#define VFR(s) (bf16x8){vlo[s][0], vlo[s][1], vlo[s][2], vlo[s][3], vhi[s][0], vhi[s][1], vhi[s][2], vhi[s][3]}
#define VRD(s, i) do { vlo[s] = vtr(vp_ + (((i) >> 2) * 4096 + ((i) & 3) * 1024)); vhi[s] = vtr(vp_ + (((i) >> 2) * 4096 + ((i) & 3) * 1024 + 512)); } while (0)
#define KRDN(d0) do { kload2(kf, kp0 + sl_next, d0); SBAR(); } while (0)
#define KRDC(d0) do { kload2(kf, kp0 + sl_cur, d0); SBAR(); } while (0)
#define STEP(C0, C1, P0, P1, t) do { SBAR(); const lds_cptr vp_ = vp0 + sl_prev; float sacc = 0.f; \
    KRDC(3); C0 = MFMA(kf[0], qr[0], negm); P1[8] = EX(P1[8]); PIN(P1); sacc += P0[0]; sacc += P0[1]; sacc += P0[2]; pw0[0] = PKW(P0, 0); PIN(pw0); PIN(sacc); SBAR(); \
    KRDC(4); C1 = MFMA(kf[1], qr[0], negm); P1[9] = EX(P1[9]); PIN(P1); sacc += P0[3]; sacc += P0[4]; sacc += P0[5]; pw0[1] = PKW(P0, 2); PIN(pw0); PIN(sacc); SBAR(); \
    KRDC(5); C0 = MFMA(kf[2], qr[1], C0); P1[10] = EX(P1[10]); PIN(P1); sacc += P0[6]; sacc += P0[7]; sacc += P0[8]; pw0[2] = PKW(P0, 4); pw2[0] = PKW(P1, 0); PIN(pw0); PIN(pw2); PIN(sacc); SBAR(); \
    C1 = MFMA(kf[3], qr[1], C1); P1[11] = EX(P1[11]); PIN(P1); sacc += P0[9]; sacc += P0[10]; sacc += P0[11]; pw0[3] = PKW(P0, 6); pw2[1] = PKW(P1, 2); PIN(pw0); PIN(pw2); PIN(sacc); SBAR(); \
    C0 = MFMA(kf[4], qr[2], C0); P1[12] = EX(P1[12]); PIN(P1); sacc += P0[12]; sacc += P0[13]; sacc += P0[14]; pw1[0] = PKW(P0, 8); pw2[2] = PKW(P1, 4); PIN(pw1); PIN(pw2); PIN(sacc); SBAR(); \
    C1 = MFMA(kf[5], qr[2], C1); P1[13] = EX(P1[13]); PIN(P1); sacc += P0[15]; sacc += P1[0]; sacc += P1[1]; pw1[1] = PKW(P0, 10); pw2[3] = PKW(P1, 6); PIN(pw1); PIN(pw2); PIN(sacc); SBAR(); \
    C0 = MFMA(kf[6], qr[3], C0); P1[14] = EX(P1[14]); PIN(P1); sacc += P1[2]; sacc += P1[3]; sacc += P1[4]; pw1[2] = PKW(P0, 12); PIN(pw1); PIN(sacc); SBAR(); \
    C1 = MFMA(kf[7], qr[3], C1); P1[15] = EX(P1[15]); PIN(P1); sacc += P1[5]; sacc += P1[6]; sacc += P1[7]; pw1[3] = PKW(P0, 14); PIN(pw1); PIN(sacc); SBAR(); \
    VRD(0, 0); SBAR(); C0 = MFMA(kf[8], qr[4], C0); sacc += P1[8]; sacc += P1[9]; sacc += P1[10]; pw3[0] = PKW(P1, 8); PIN(pw3); PIN(sacc); SBAR(); \
    VRD(1, 4); SBAR(); C1 = MFMA(kf[9], qr[4], C1); sacc += P1[11]; sacc += P1[12]; sacc += P1[13]; pw3[1] = PKW(P1, 10); PIN(pw3); PIN(sacc); SBAR(); \
    VRD(2, 1); SBAR(); C0 = MFMA(kf[10], qr[5], C0); sacc += P1[14]; sacc += P1[15]; pw3[2] = PKW(P1, 12); PIN(pw3); PIN(sacc); SBAR(); \
    VRD(3, 5); SBAR(); C1 = MFMA(kf[11], qr[5], C1); pw3[3] = PKW(P1, 14); PIN(pw3); PIN(sacc); SBAR(); \
    l_reg += sacc; \
    if ((t) > cqw) { asm volatile("" ::: "memory"); _Pragma("unroll") for (int r = 0; r < 16; ++r) { C0[r] = -1e30f; C1[r] = -1e30f; } PIN(C0); PIN(C1); }     \
    DECIDE(C0, C1); SBAR(); \
    o[0] = MFMA(PAF(0), VFR(0), o[0]); VRD(0, 2); C0[0] = EX(C0[0]); C0[1] = EX(C0[1]); C0[2] = EX(C0[2]); PIN(C0); SBAR(); \
    KRDN(0); o[1] = MFMA(PAF(0), VFR(1), o[1]); VRD(1, 6); C0[3] = EX(C0[3]); C0[4] = EX(C0[4]); C0[5] = EX(C0[5]); PIN(C0); SBAR(); \
    o[0] = MFMA(PAF(1), VFR(2), o[0]); VRD(2, 3); C0[6] = EX(C0[6]); C0[7] = EX(C0[7]); C0[8] = EX(C0[8]); PIN(C0); SBAR(); \
    KRDN(1); o[1] = MFMA(PAF(1), VFR(3), o[1]); VRD(3, 7); C0[9] = EX(C0[9]); C0[10] = EX(C0[10]); C0[11] = EX(C0[11]); PIN(C0); SBAR(); \
    o[0] = MFMA(PAF(2), VFR(0), o[0]); C0[12] = EX(C0[12]); C0[13] = EX(C0[13]); C0[14] = EX(C0[14]); PIN(C0); SBAR(); \
    KRDN(2); o[1] = MFMA(PAF(2), VFR(1), o[1]); C0[15] = EX(C0[15]); C1[0] = EX(C1[0]); C1[1] = EX(C1[1]); PIN(C0); PIN(C1); SBAR(); \
    o[0] = MFMA(PAF(3), VFR(2), o[0]); C1[2] = EX(C1[2]); C1[3] = EX(C1[3]); C1[4] = EX(C1[4]); PIN(C0); PIN(C1); SBAR(); \
    o[1] = MFMA(PAF(3), VFR(3), o[1]); C1[5] = EX(C1[5]); C1[6] = EX(C1[6]); C1[7] = EX(C1[7]); PIN(C0); PIN(C1); SBAR(); \
    } while (0)
  for (int t = 1; t + 1 < NT; t += 2) {
    STEP(pB0, pB1, pA0, pA1, t);     VMWAIT(3); BAR(); RESC(); DMA(t + 4, sl_prev); ROT();
    STEP(pA0, pA1, pB0, pB1, t + 1); VMWAIT(3); BAR(); RESC(); DMA(t + 5, sl_prev); ROT();
  }
  STEP(pB0, pB1, pA0, pA1, NT - 1); RESC();
  { _Pragma("unroll") for (int r = 8; r < 16; ++r) pB1[r] = EX(pB1[r]);
    float sacc = 0.f;
#pragma unroll
    for (int r = 0; r < 16; ++r) sacc += pB0[r];
#pragma unroll
    for (int r = 0; r < 16; ++r) sacc += pB1[r];
    l_reg += sacc;
    pw0 = (u32x4){PKW(pB0, 0), PKW(pB0, 2), PKW(pB0, 4), PKW(pB0, 6)}; pw1 = (u32x4){PKW(pB0, 8), PKW(pB0, 10), PKW(pB0, 12), PKW(pB0, 14)};
    pw2 = (u32x4){PKW(pB1, 0), PKW(pB1, 2), PKW(pB1, 4), PKW(pB1, 6)}; pw3 = (u32x4){PKW(pB1, 8), PKW(pB1, 10), PKW(pB1, 12), PKW(pB1, 14)};
    const lds_cptr vp_ = vp0 + sl_cur;
    VRD(0, 0); VRD(1, 4); VRD(2, 1); VRD(3, 5);
    o[0] = MFMA(PAF(0), VFR(0), o[0]); o[1] = MFMA(PAF(0), VFR(1), o[1]); o[0] = MFMA(PAF(1), VFR(2), o[0]); o[1] = MFMA(PAF(1), VFR(3), o[1]);
    VRD(0, 2); VRD(1, 6); VRD(2, 3); VRD(3, 7);
    o[0] = MFMA(PAF(2), VFR(0), o[0]); o[1] = MFMA(PAF(2), VFR(1), o[1]); o[0] = MFMA(PAF(3), VFR(2), o[0]); o[1] = MFMA(PAF(3), VFR(3), o[1]); }
  { auto rr = __builtin_amdgcn_permlane32_swap(__float_as_uint(l_reg), __float_as_uint(l_reg), false, false); l_reg = __uint_as_float(rr[0]) + __uint_as_float(rr[1]); }
  if (hi == 0) wsf[32 + r32] = l_reg; asm volatile("s_waitcnt lgkmcnt(0)" ::: "memory");
  float rli[16];
#pragma unroll
  for (int r = 0; r < 16; ++r) rli[r] = __builtin_amdgcn_rcpf(wsf[32 + crow(r, hi)]);
  pg8::bf16_t* Ow = Oh + (size_t)(q0 + wid * QBLK) * LDO; unsigned short* stg = (unsigned short*)(lds + LDS_OST) + wid * 2048;
#pragma unroll
  for (int r = 0; r < 16; ++r) { const int orow = crow(r, hi);
#pragma unroll
    for (int d0 = 0; d0 < 2; ++d0) stg[orow * 64 + d0 * 32 + r32] = (unsigned short)(cvtpk(o[d0][r] * rli[r], 0.f) & 0xffffu); }
  asm volatile("s_waitcnt lgkmcnt(0)" ::: "memory");
#pragma unroll
  for (int i = 0; i < 4; ++i) { const int row = i * 8 + (lane >> 3), ch = lane & 7; *(u32x4*)(Ow + (size_t)row * LDO + ch * 8) = *(const u32x4*)(stg + row * 64 + ch * 8); }
  ring = sl_next;
  asm volatile("s_waitcnt vmcnt(0) lgkmcnt(0)" ::: "memory"); BAR();
#undef DMA
#undef WRAP
#undef VMWAIT
#undef BAR
#undef ROT
#undef EX
#undef RESC
#undef DECIDE
#undef PKW
#undef PAF
#undef VFR
#undef VRD
#undef KRDN
#undef KRDC
#undef STEP
}
#undef SBAR
#undef PIN
#undef MFMA
#undef MX3
}

namespace dsa {
using bf16x8 = __attribute__((ext_vector_type(8))) short;
using s16x4  = __attribute__((ext_vector_type(4))) short;
using f32x4  = __attribute__((ext_vector_type(4))) float;
using u32x4  = __attribute__((ext_vector_type(4))) unsigned;
using u32x2  = __attribute__((ext_vector_type(2))) unsigned;
typedef unsigned short bf16_t;
constexpr int L_LIST = 0, L_BIAS = 16384, L_U = 18432, L_END = L_U + 131072;
constexpr float LOG2E = 1.4426950408889634f;
constexpr unsigned INVALID_ENTRY = 0x003f0000u;
__device__ __forceinline__ void glds16v(const void* gsrc, unsigned lds_dst) { unsigned keep;
    asm volatile("s_mov_b32 %0, m0\n\ts_mov_b32 m0, %2\n\ts_nop 0\n\tglobal_load_lds_dwordx4 %1, off\n\ts_mov_b32 m0, %0" : "=&s"(keep) : "v"(gsrc), "s"(lds_dst) : "memory"); }
__device__ __forceinline__ int t5_bucket(int rel) {
    const int n = rel < 0 ? -rel : rel; int b = n;
    if (n >= 8) { const int e = 31 - __builtin_clz(n); int v = 8 + 2 * (e - 3) + ((n * n) >= (2 << (2 * e)) ? 1 : 0); b = v > 15 ? 15 : v; }
    return b + (rel > 0 ? 16 : 0);
}
template <int OFF> __device__ __forceinline__ s16x4 trrdo(unsigned addr) { s16x4 r; asm volatile("ds_read_b64_tr_b16 %0, %1 offset:%2" : "=v"(r) : "v"(addr), "i"(OFF) : "memory"); return r; }
#define DSA_DPP(v, ctrl) __builtin_amdgcn_update_dpp(0, (v), (ctrl), 0xf, 0xf, true)
__device__ __forceinline__ int half_sum(int v) { v += DSA_DPP(v, 0xB1); v += DSA_DPP(v, 0x4E); v += DSA_DPP(v, 0x141); v += DSA_DPP(v, 0x140);
    auto r = __builtin_amdgcn_permlane16_swap((unsigned)v, (unsigned)v, false, false); return (int)(r[0] + r[1]); }
__device__ __forceinline__ float half_min(float x) { int v = __float_as_int(x);
#define DSA_STEP(ctrl) v = __float_as_int(fminf(__int_as_float(v), __int_as_float(DSA_DPP(v, ctrl))))
    DSA_STEP(0xB1); DSA_STEP(0x4E); DSA_STEP(0x141); DSA_STEP(0x140);
#undef DSA_STEP
    auto r = __builtin_amdgcn_permlane16_swap((unsigned)v, (unsigned)v, false, false); return fminf(__uint_as_float(r[0]), __uint_as_float(r[1])); }
__device__ __forceinline__ float half_max(float x) { int v = __float_as_int(x);
#define DSA_STEP(ctrl) v = __float_as_int(fmaxf(__int_as_float(v), __int_as_float(DSA_DPP(v, ctrl))))
    DSA_STEP(0xB1); DSA_STEP(0x4E); DSA_STEP(0x141); DSA_STEP(0x140);
#undef DSA_STEP
    auto r = __builtin_amdgcn_permlane16_swap((unsigned)v, (unsigned)v, false, false); return fmaxf(__uint_as_float(r[0]), __uint_as_float(r[1])); }
__device__ __forceinline__ void cnt4(int& cnt, float a, float b, float c, float d, float thr) {
    unsigned long long m0, m1, m2, m3;
    asm("v_cmp_gt_f32_e64 %1, %5, %9\n\tv_cmp_gt_f32_e64 %2, %6, %9\n\tv_cmp_gt_f32_e64 %3, %7, %9\n\tv_cmp_gt_f32_e64 %4, %8, %9\n\t"
        "v_addc_co_u32_e64 %0, %1, %0, 0, %1\n\tv_addc_co_u32_e64 %0, %2, %0, 0, %2\n\tv_addc_co_u32_e64 %0, %3, %0, 0, %3\n\tv_addc_co_u32_e64 %0, %4, %0, 0, %4"
        : "+v"(cnt), "=&s"(m0), "=&s"(m1), "=&s"(m2), "=&s"(m3) : "v"(a), "v"(b), "v"(c), "v"(d), "v"(thr));
}
using f32x2 = __attribute__((ext_vector_type(2))) float;
#define QNAN __builtin_nanf("")
__device__ __forceinline__ void cntp4(f32x2& ca, f32x2& cb, f32x2 s0, f32x2 s1, f32x2 s2, f32x2 s3, f32x2 big, f32x2 ntb) {
    f32x2 c0, c1, c2, c3;
    asm("v_pk_fma_f32 %2, %6, %10, %11 clamp\n\tv_pk_fma_f32 %3, %7, %10, %11 clamp\n\tv_pk_fma_f32 %4, %8, %10, %11 clamp\n\tv_pk_fma_f32 %5, %9, %10, %11 clamp\n\t"
        "v_pk_add_f32 %0, %0, %2\n\tv_pk_add_f32 %1, %1, %3\n\tv_pk_add_f32 %0, %0, %4\n\tv_pk_add_f32 %1, %1, %5"
        : "+v"(ca), "+v"(cb), "=&v"(c0), "=&v"(c1), "=&v"(c2), "=&v"(c3) : "v"(s0), "v"(s1), "v"(s2), "v"(s3), "v"(big), "v"(ntb)); }
__device__ __forceinline__ void selmap4(unsigned& map, float a, float b, float c, float d, float thr) {
    unsigned long long m0, m1, m2, m3;
    asm("v_cmp_gt_f32_e64 %1, %5, %9\n\tv_cmp_gt_f32_e64 %2, %6, %9\n\tv_cmp_gt_f32_e64 %3, %7, %9\n\tv_cmp_gt_f32_e64 %4, %8, %9\n\t"
        "v_addc_co_u32_e64 %0, %1, %0, %0, %1\n\tv_addc_co_u32_e64 %0, %2, %0, %0, %2\n\tv_addc_co_u32_e64 %0, %3, %0, %0, %3\n\tv_addc_co_u32_e64 %0, %4, %0, %0, %4"
        : "+v"(map), "=&s"(m0), "=&s"(m1), "=&s"(m2), "=&s"(m3) : "v"(a), "v"(b), "v"(c), "v"(d), "v"(thr));
}
#define DSA_LAS __attribute__((address_space(3)))
#define RELU(x) __builtin_amdgcn_fmed3f((x), 0.f, 3.0e38f)

__device__ __forceinline__ void dsa_pass(const bf16_t* __restrict__ Q, const bf16_t* __restrict__ QI, const bf16_t* __restrict__ K, const bf16_t* __restrict__ V, const bf16_t* __restrict__ KI,
                                         const float* __restrict__ WI, bf16_t* __restrict__ O, int b, int c, int pass, bool pre, bool pf, DSA_LAS unsigned char* lds) {
    int tid_ = threadIdx.x; asm volatile("" : "+v"(tid_));
    const int tid = tid_, wid = __builtin_amdgcn_readfirstlane(tid >> 6), lane = tid & 63, kl = lane & 15, g = lane >> 4, half = lane >> 5;
    const unsigned ldsb = (unsigned)(unsigned long long)lds;
    const size_t rb = (size_t)b * 4096;
    const int tw = 64 * c + 16 * pass + 2 * wid;
    DSA_LAS unsigned* list = (DSA_LAS unsigned*)(lds + L_LIST + wid * 2048);
    const DSA_LAS float* biasT = (const DSA_LAS float*)(lds + L_BIAS);
    const int nadm = 64 * (c + 1), ncnt = nadm < 256 ? nadm : 256;
    const int srow = 16 * wid + (lane >> 3), lch = (lane & 7) ^ ((srow >> 1) & 7);
    const bf16_t* kisrc = KI + (rb + srow) * 64 + lch * 8;
    const unsigned kidst = ldsb + L_U + wid * 2048;
    const bf16_t* kisrc2 = KI + (rb + srow + 8) * 64 + (lch ^ 4) * 8;
#define DSA_KIDMA(T_) do { glds16v(kisrc + (size_t)(T_) * 8192, kidst + ((T_) & 3) * 16384); glds16v(kisrc2 + (size_t)(T_) * 8192, kidst + ((T_) & 3) * 16384 + 1024); } while (0)
    if (c < 4) { if (pf) { DSA_KIDMA(0); DSA_KIDMA(1); } }
    if (c >= 4) {
        f32x2 sc2[64];
#define SC(j) sc2[(j) >> 1][(j) & 1]
#pragma unroll
        for (int j = 0; j < 64; ++j) sc2[j] = (f32x2){QNAN, QNAN};
        bf16x8 aq0, aq1; f32x4 w4;
        { const bf16_t* qp = QI + (rb + tw + (kl >> 3)) * 512 + (kl & 7) * 64 + 8 * g; aq0 = *(const bf16x8*)qp; aq1 = *(const bf16x8*)(qp + 32);
          w4 = *(const f32x4*)(WI + (rb + tw + (g >> 1)) * 8 + 4 * (g & 1)); }
        const int rd0 = kl * 128 + ((g ^ ((kl >> 1) & 7)) << 4), rd1 = rd0 ^ 64;
        const int nt = (c + 2) >> 1;
        if (!pre) { DSA_KIDMA(0); DSA_KIDMA(1); }
#pragma unroll
        for (int T = 0; T < 32; ++T) {
            if (T < nt) {
                if ((T & 1) == 0) {
                    asm volatile("s_waitcnt vmcnt(0)" ::: "memory");
                    __builtin_amdgcn_s_barrier(); asm volatile("" ::: "memory");
                    if (T + 2 < nt) DSA_KIDMA(T + 2);
                    if (T + 3 < nt) DSA_KIDMA(T + 3); }
                const DSA_LAS unsigned char* kb = lds + L_U + (T & 3) * 16384;
                bf16x8 fb[8]; f32x4 acc[4], acd[4];
#define DSA_RD(H) _Pragma("unroll") for (int st = 0; st < 4; ++st) { fb[2 * st] = *(const DSA_LAS bf16x8*)(kb + rd0 + (4 * (H) + st) * 2048); fb[2 * st + 1] = *(const DSA_LAS bf16x8*)(kb + rd1 + (4 * (H) + st) * 2048); }
#define DSA_MM(A) _Pragma("unroll") for (int st = 0; st < 4; ++st) A[st] = __builtin_amdgcn_mfma_f32_16x16x32_bf16(aq0, fb[2 * st], (f32x4){0.f, 0.f, 0.f, 0.f}, 0, 0, 0); \
                  _Pragma("unroll") for (int st = 0; st < 4; ++st) A[st] = __builtin_amdgcn_mfma_f32_16x16x32_bf16(aq1, fb[2 * st + 1], A[st], 0, 0, 0);
#define DSA_WS(A, H) _Pragma("unroll") for (int pr = 0; pr < 2; ++pr) { float ps[2]; \
                    _Pragma("unroll") for (int s2 = 0; s2 < 2; ++s2) { const f32x4 a = A[2 * pr + s2]; ps[s2] = (w4[0] * RELU(a[0]) + w4[1] * RELU(a[1])) + (w4[2] * RELU(a[2]) + w4[3] * RELU(a[3])); } \
                    auto r = __builtin_amdgcn_permlane16_swap(__float_as_uint(ps[0]), __float_as_uint(ps[1]), false, false); SC(4 * T + 2 * (H) + pr) = __uint_as_float(r[0]) + __uint_as_float(r[1]); }
                DSA_RD(0) __builtin_amdgcn_sched_barrier(0);
                DSA_MM(acc) __builtin_amdgcn_sched_barrier(0);
                DSA_RD(1) __builtin_amdgcn_sched_barrier(0);
                DSA_WS(acc, 0) __builtin_amdgcn_sched_barrier(0);
                DSA_MM(acd) __builtin_amdgcn_sched_barrier(0);
                DSA_WS(acd, 1) __builtin_amdgcn_sched_barrier(0);
#undef DSA_RD
#undef DSA_MM
#undef DSA_WS
                asm volatile("s_waitcnt lgkmcnt(0)" ::: "memory");
            }
        }
        __builtin_amdgcn_s_barrier();
        if (pf) { DSA_KIDMA(0); DSA_KIDMA(1); }
        if ((c & 1) == 0) {
#pragma unroll
            for (int T = 0; T < 32; ++T) if (T == nt - 1) sc2[2 * T + 1] = (f32x2){QNAN, QNAN};
        }
        const int nregs = 4 * nt;
        float mn = 3.0e38f, mx = -3.0e38f, mnb = 3.0e38f, mxb = -3.0e38f;
#pragma unroll
        for (int blk = 0; blk < 8; ++blk) if (16 * blk < nregs) {
#pragma unroll
            for (int jj = 0; jj < 8; jj += 2) { const f32x2 a = sc2[8 * blk + jj], b2 = sc2[8 * blk + jj + 1];
                asm("v_min3_f32 %0, %0, %1, %2" : "+v"(mn) : "v"(a[0]), "v"(a[1])); asm("v_max3_f32 %0, %0, %1, %2" : "+v"(mx) : "v"(a[0]), "v"(a[1]));
                asm("v_min3_f32 %0, %0, %1, %2" : "+v"(mnb) : "v"(b2[0]), "v"(b2[1])); asm("v_max3_f32 %0, %0, %1, %2" : "+v"(mxb) : "v"(b2[0]), "v"(b2[1])); } }
        mn = fminf(mn, mnb); mx = fmaxf(mx, mxb);
        mn = half_min(mn); mx = half_max(mx);
        constexpr float BIGF = 1.2676506002282294e30f;
        f32x2 big2 = {BIGF, BIGF}; asm volatile("" : "+v"(big2));
        float lo[2], hi[2], thr[2], tie[2]; int chi[2], need[2]; bool done[2];
#pragma unroll
        for (int q = 0; q < 2; ++q) { lo[q] = __int_as_float(__builtin_amdgcn_readlane(__float_as_int(mn), 32 * q)) - 1.0f; hi[q] = __int_as_float(__builtin_amdgcn_readlane(__float_as_int(mx), 32 * q));
            chi[q] = 0; need[q] = 0; done[q] = false; thr[q] = hi[q]; tie[q] = __builtin_nanf(""); }
        for (int it = 0; it < 64; ++it) {
            if (done[0] && done[1]) break;
            float mid[2];
#pragma unroll
            for (int q = 0; q < 2; ++q) { mid[q] = 0.5f * lo[q] + 0.5f * hi[q];
                if (!done[q] && (!(mid[q] > lo[q]) || !(mid[q] < hi[q]))) { done[q] = true; thr[q] = hi[q]; tie[q] = hi[q]; need[q] = 256 - chi[q]; } }
            if (done[0] && done[1]) break;
            const float tv = half ? mid[1] : mid[0]; const float ntb_ = tv * -BIGF; const f32x2 ntb2 = {ntb_, ntb_}; f32x2 ca = {0.f, 0.f}, cb = {0.f, 0.f};
#pragma unroll
            for (int blk = 0; blk < 8; ++blk) if (16 * blk < nregs) {
#pragma unroll
                for (int jj = 0; jj < 8; jj += 4) cntp4(ca, cb, sc2[8 * blk + jj], sc2[8 * blk + jj + 1], sc2[8 * blk + jj + 2], sc2[8 * blk + jj + 3], big2, ntb2); }
            ca += cb; int cv = (int)(ca[0] + ca[1]);
            cv = half_sum(cv);
            const int c0 = __builtin_amdgcn_readlane(cv, 0), c1 = __builtin_amdgcn_readlane(cv, 32);
#pragma unroll
            for (int q = 0; q < 2; ++q) { const int cq = q ? c1 : c0;
                if (!done[q]) { if (cq == 256) { done[q] = true; thr[q] = mid[q]; need[q] = 0; } else if (cq > 256) lo[q] = mid[q]; else { hi[q] = mid[q]; chi[q] = cq; } } }
        }
#pragma unroll
        for (int q = 0; q < 2; ++q) if (!done[q]) { thr[q] = hi[q]; tie[q] = hi[q]; need[q] = 256 - chi[q]; }
        DSA_LAS unsigned* lq = list + half * 256;
        if (need[0] == 0 && need[1] == 0) {
            const float tv = half ? thr[1] : thr[0]; unsigned mk[4] = {0u, 0u, 0u, 0u};
#pragma unroll
            for (int blk = 0; blk < 8; ++blk) {
                if (16 * blk < nregs) {
#pragma unroll
                    for (int jj = 0; jj < 16; jj += 4) selmap4(mk[blk >> 1], SC(16 * blk + jj), SC(16 * blk + jj + 1), SC(16 * blk + jj + 2), SC(16 * blk + jj + 3), tv);
                } else if (blk & 1) mk[blk >> 1] <<= 16;
            }
            const int cv = __builtin_popcount(mk[0]) + __builtin_popcount(mk[1]) + __builtin_popcount(mk[2]) + __builtin_popcount(mk[3]);
            int incl = cv;
#pragma unroll
            for (int o = 1; o < 32; o <<= 1) { const int t = __shfl_up(incl, o, 32); if ((lane & 31) >= o) incl += t; }
            unsigned wp = (unsigned)(unsigned long long)lq + 4u * (unsigned)(incl - cv);
#pragma unroll
            for (int w = 0; w < 4; ++w) if (32 * w < nregs) { unsigned m = mk[w]; const unsigned kb_ = (unsigned)(1024 * w + (lane & 31));
                while (m) { const unsigned lz = (unsigned)__builtin_clz(m); *(DSA_LAS unsigned*)wp = (lz << 5) + kb_; wp += 4u; m ^= 0x80000000u >> lz; } }
        } else {
            const float tv = half ? thr[1] : thr[0], ev = half ? tie[1] : tie[0]; const int nd = half ? need[1] : need[0]; int base = 0, tb = 0;
#pragma unroll
            for (int blk = 0; blk < 8; ++blk) if (16 * blk < nregs) {
#pragma unroll
                for (int jj = 0; jj < 16; ++jj) { const int j = 16 * blk + jj; const float s = SC(j);
                    const bool eq = (s == ev); const unsigned long long meq = __builtin_amdgcn_ballot_w64(eq);
                    const unsigned elo = (unsigned)meq, ehi = (unsigned)(meq >> 32);
                    int pe = __builtin_amdgcn_mbcnt_hi(ehi, __builtin_amdgcn_mbcnt_lo(elo, 0)); if (half) pe -= __builtin_popcount(elo);
                    const bool sel = (s > tv) || (eq && (tb + pe < nd));
                    const unsigned long long ms = __builtin_amdgcn_ballot_w64(sel); const unsigned slo = (unsigned)ms, shi = (unsigned)(ms >> 32);
                    int pp = __builtin_amdgcn_mbcnt_hi(shi, __builtin_amdgcn_mbcnt_lo(slo, 0)); if (half) pp -= __builtin_popcount(slo);
                    const int pos = base + pp;
                    if (sel && pos < 256) lq[pos] = (unsigned)(32 * j + (lane & 31));
                    base += half ? __builtin_popcount(shi) : __builtin_popcount(slo); tb += half ? __builtin_popcount(ehi) : __builtin_popcount(elo); } }
            for (int p = base + (lane & 31); p < 256; p += 32) lq[p] = INVALID_ENTRY;
        }
    } else {
        for (int p = lane; p < 2 * ncnt; p += 64) { const int q = p / ncnt; list[q * 256 + (p - q * ncnt)] = (unsigned)(p - q * ncnt); }
    }
    asm volatile("s_waitcnt lgkmcnt(0)" ::: "memory");
#pragma unroll
    for (int q = 0; q < 2; ++q)
#pragma unroll
        for (int i = 0; i < 4; ++i) { const int p = lane + 64 * i; if (p < ncnt) { const unsigned e = list[q * 256 + p]; if (e != INVALID_ENTRY) list[q * 256 + p] = e | ((unsigned)t5_bucket((int)e - (tw + q)) << 16); } }
    asm volatile("s_waitcnt lgkmcnt(0)" ::: "memory");
    const int nq = ncnt >> 6;
    const int vrow = lane >> 3, vslot = lane & 7;
    const int ls_ = (((vslot >> 1) ^ ((vrow >> 1) & 3)) << 1) | (vslot & 1);
    const int trow = 4 * g + ((lane >> 2) & 3), tp = lane & 3, tx = (trow >> 1) & 3;
    const unsigned vbuf = ldsb + L_U + 65536 + wid * 8192;
    struct StepRegs { bf16x8 k[4][2]; bf16x8 v[8]; bf16x8 q[2]; };
    const char* const Kb_ = (const char*)(K + rb * 64), * const Vb_ = (const char*)(V + rb * 64), * const Qb_ = (const char*)(Q + (rb + tw) * 1024);
    const unsigned koff_ = (unsigned)(16 * g), voff_ = (unsigned)(16 * ls_), qoff_ = (unsigned)(kl * 128 + 16 * g);
#define DSA_STEP_LOAD(R, S) do { const int q_ = (S) / nq, qr_ = (S) - q_ * nq; const DSA_LAS unsigned* lq_ = list + q_ * 256 + 64 * qr_; \
        { const unsigned qo_ = qoff_ + (unsigned)q_ * 2048u; R.q[0] = *(const bf16x8*)(Qb_ + qo_); R.q[1] = *(const bf16x8*)(Qb_ + qo_ + 64u); } \
        _Pragma("unroll") for (int tt = 0; tt < 4; ++tt) { const unsigned ko_ = (lq_[16 * tt + kl] & 0xffffu) * 128u + koff_; R.k[tt][0] = *(const bf16x8*)(Kb_ + ko_); R.k[tt][1] = *(const bf16x8*)(Kb_ + ko_ + 64u); } \
        _Pragma("unroll") for (int i = 0; i < 8; ++i) { const unsigned vo_ = (lq_[8 * i + vrow] & 0xffffu) * 128u + voff_; R.v[i] = *(const bf16x8*)(Vb_ + vo_); } } while (0)
#define DSA_STEP(R, S, VB) do { const int q_ = (S) / nq, qr_ = (S) - q_ * nq; const DSA_LAS unsigned* lq_ = list + q_ * 256 + 64 * qr_; \
        if (qr_ == 0) { m_run = -1.0e30f; l_run = 0.f; _Pragma("unroll") for (int db = 0; db < 4; ++db) o[db] = (f32x4){0.f, 0.f, 0.f, 0.f}; } \
          \
        u32x4 e4[4]; f32x4 bv[4]; \
        _Pragma("unroll") for (int tt = 0; tt < 4; ++tt) e4[tt] = *(const DSA_LAS u32x4*)(lq_ + 16 * tt + 4 * g); \
        _Pragma("unroll") for (int tt = 0; tt < 4; ++tt) _Pragma("unroll") for (int r = 0; r < 4; ++r) bv[tt][r] = biasT[((e4[tt][r] >> 16) & 31u) * 16 + kl]; \
        f32x4 st[4]; \
        _Pragma("unroll") for (int tt = 0; tt < 4; ++tt) { \
            f32x4 a = __builtin_amdgcn_mfma_f32_16x16x32_bf16(R.k[tt][0], R.q[0], (f32x4){0.f, 0.f, 0.f, 0.f}, 0, 0, 0); a = __builtin_amdgcn_mfma_f32_16x16x32_bf16(R.k[tt][1], R.q[1], a, 0, 0, 0); \
            _Pragma("unroll") for (int r = 0; r < 4; ++r) a[r] = (e4[tt][r] >> 16) == 63u ? -1.0e30f : a[r] + bv[tt][r]; \
            st[tt] = a; } \
        float mloc = fmaxf(fmaxf(fmaxf(st[0][0], st[0][1]), fmaxf(st[0][2], st[0][3])), fmaxf(fmaxf(st[1][0], st[1][1]), fmaxf(st[1][2], st[1][3]))); \
        mloc = fmaxf(mloc, fmaxf(fmaxf(fmaxf(st[2][0], st[2][1]), fmaxf(st[2][2], st[2][3])), fmaxf(fmaxf(st[3][0], st[3][1]), fmaxf(st[3][2], st[3][3])))); \
        { auto r16 = __builtin_amdgcn_permlane16_swap(__float_as_uint(mloc), __float_as_uint(mloc), false, false); mloc = fmaxf(__uint_as_float(r16[0]), __uint_as_float(r16[1])); \
          auto r32_ = __builtin_amdgcn_permlane32_swap(__float_as_uint(mloc), __float_as_uint(mloc), false, false); mloc = fmaxf(__uint_as_float(r32_[0]), __uint_as_float(r32_[1])); } \
        const float mnew = fmaxf(m_run, mloc), alpha = __builtin_amdgcn_exp2f(m_run - mnew); m_run = mnew; \
        float ps = 0.f; unsigned pk[4][2]; \
        _Pragma("unroll") for (int tt = 0; tt < 4; ++tt) { f32x4 p; _Pragma("unroll") for (int r = 0; r < 4; ++r) p[r] = __builtin_amdgcn_exp2f(st[tt][r] - mnew); \
            ps += (p[0] + p[1]) + (p[2] + p[3]); pk[tt][0] = pg8::cvt_pk_bf16(p[0], p[1]); pk[tt][1] = pg8::cvt_pk_bf16(p[2], p[3]); } \
        l_run = l_run * alpha + ps; \
        _Pragma("unroll") for (int db = 0; db < 4; ++db) o[db] = o[db] * alpha; \
        { DSA_LAS unsigned char* vw = lds + L_U + 65536 + wid * 8192 + (VB) + vrow * 128 + vslot * 16; \
          _Pragma("unroll") for (int i = 0; i < 8; ++i) *(DSA_LAS bf16x8*)(vw + i * 1024) = R.v[i]; \
          asm volatile("s_waitcnt lgkmcnt(0)" ::: "memory"); } \
        _Pragma("unroll") for (int s2 = 0; s2 < 2; ++s2) { \
            const u32x4 pw = {pk[2 * s2][0], pk[2 * s2][1], pk[2 * s2 + 1][0], pk[2 * s2 + 1][1]}; const bf16x8 pb = __builtin_bit_cast(bf16x8, pw); \
            s16x4 v1[4], v2[4]; \
            _Pragma("unroll") for (int db = 0; db < 4; ++db) { const unsigned ta = vbuf + (VB) + trow * 128 + ((db ^ tx) << 5) + tp * 8; \
                v1[db] = s2 == 0 ? trrdo<0>(ta) : trrdo<4096>(ta); v2[db] = s2 == 0 ? trrdo<2048>(ta) : trrdo<6144>(ta); } \
            asm volatile("s_waitcnt lgkmcnt(0)" : "+v"(v1[0]), "+v"(v1[1]), "+v"(v1[2]), "+v"(v1[3]), "+v"(v2[0]), "+v"(v2[1]), "+v"(v2[2]), "+v"(v2[3]) :: "memory"); \
            _Pragma("unroll") for (int db = 0; db < 4; ++db) { const bf16x8 va = {v1[db][0], v1[db][1], v1[db][2], v1[db][3], v2[db][0], v2[db][1], v2[db][2], v2[db][3]}; \
                o[db] = __builtin_amdgcn_mfma_f32_16x16x32_bf16(va, pb, o[db], 0, 0, 0); } } \
        if (qr_ == nq - 1) { float lt = l_run; \
            { auto r16 = __builtin_amdgcn_permlane16_swap(__float_as_uint(lt), __float_as_uint(lt), false, false); lt = __uint_as_float(r16[0]) + __uint_as_float(r16[1]); \
              auto r32_ = __builtin_amdgcn_permlane32_swap(__float_as_uint(lt), __float_as_uint(lt), false, false); lt = __uint_as_float(r32_[0]) + __uint_as_float(r32_[1]); } \
            const float rl = __builtin_amdgcn_rcpf(lt); bf16_t* op = O + (rb + tw + q_) * 1024 + kl * 64 + 4 * g; \
            _Pragma("unroll") for (int db = 0; db < 4; ++db) { u32x2 w; w.x = pg8::cvt_pk_bf16(o[db][0] * rl, o[db][1] * rl); w.y = pg8::cvt_pk_bf16(o[db][2] * rl, o[db][3] * rl); *(u32x2*)(op + 16 * db) = w; } } \
    } while (0)
    {
        float m_run = -1.0e30f, l_run = 0.f; f32x4 o[4];
#pragma unroll
        for (int db = 0; db < 4; ++db) o[db] = (f32x4){0.f, 0.f, 0.f, 0.f};
        StepRegs RA, RB; const int nsteps = 2 * nq;
        DSA_STEP_LOAD(RA, 0);
#pragma unroll 1
        for (int s = 0; s < nsteps; s += 2) {
            DSA_STEP_LOAD(RB, s + 1);
            asm volatile("" ::: "memory");
            DSA_STEP(RA, s, 0);
            { const int sn_ = s + 2 < nsteps ? s + 2 : nsteps - 1; DSA_STEP_LOAD(RA, sn_); }
            asm volatile("" ::: "memory");
            DSA_STEP(RB, s + 1, 0);
        }
    }
#undef DSA_STEP
#undef DSA_STEP_LOAD
#undef DSA_KIDMA
}

#undef RELU
#undef SC
#undef QNAN
#undef DSA_LAS
#undef DSA_DPP
}
__device__ __forceinline__ void dsa_phase(Frame& F) {
    unsigned char* ws = wsp();
    const dsa::bf16_t* Q = (const dsa::bf16_t*)(ws + WS_AQ); const dsa::bf16_t* QI = (const dsa::bf16_t*)(ws + WS_AQI); const dsa::bf16_t* K = (const dsa::bf16_t*)(ws + WS_AK);
    const dsa::bf16_t* V = (const dsa::bf16_t*)(ws + WS_AV); const dsa::bf16_t* KI = (const dsa::bf16_t*)(ws + WS_AKI); const float* WI = (const float*)(ws + WS_AWI); dsa::bf16_t* O = (dsa::bf16_t*)(ws + WS_OB);
    { int t_ = threadIdx.x; asm volatile("" : "+v"(t_)); const float* rbias = inp(1); LAS float* bt = (LAS float*)(F.lds + dsa::L_BIAS); if (t_ < 512) bt[t_] = rbias[t_] * dsa::LOG2E; }
    __syncthreads();
    for (int pr = F.vcu; pr < NB * 32; pr += F.G) { const int b = pr >> 5, c0 = pr & 31;
        bool pre = false;
        for (int k = 0; k < 2; ++k) { const int c = k == 0 ? c0 : 63 - c0;
            for (int pass = 0; pass < 4; ++pass) { const bool last = (k == 1 && pass == 3); const int cn = (pass == 3) ? 63 - c0 : c; const bool pf = !last && cn >= 4;
                dsa::dsa_pass(Q, QI, K, V, KI, WI, O, b, c, pass, pre, pf, F.lds); pre = pf; } }
        __syncthreads(); }
    __syncthreads();
}

__device__ __forceinline__ void mla_phase(Frame& F, int j) {
    unsigned char* ws = wsp();
    const pg8::bf16_t* QB = (const pg8::bf16_t*)(ws + WS_QB); const pg8::bf16_t* KB = (const pg8::bf16_t*)(ws + WS_KB); const pg8::bf16_t* VB = (const pg8::bf16_t*)(ws + WS_VB); pg8::bf16_t* OB = (pg8::bf16_t*)(ws + WS_OB);
    const float* qgain = inp(16) + j * 96; const float* cosT = (const float*)(ws + WS_ROPE); const float* sinT = cosT + SEQ * 16;
    int ring = 0; bool pre = false;
    for (int item = F.vcu; item < NB * 16 * 8; item += F.G) { const int bh = item >> 3, s = item & 7, b = bh >> 4, h = bh & 15; const size_t rb = (size_t)b * SEQ;
        const pg8::bf16_t* Kc = KB + (size_t)bh * SEQ * 96; const pg8::bf16_t* Vc = VB + (size_t)bh * SEQ * 64;
        for (int k = 0; k < 2; ++k) { const int qb = k == 0 ? s : 15 - s;
            const pg8::bf16_t* Kn = Kc; const pg8::bf16_t* Vn = Vc;
            if (k == 1) { const int ni = item + F.G; if (ni < NB * 16 * 8) { const int bh2 = ni >> 3; Kn = KB + (size_t)bh2 * SEQ * 96; Vn = VB + (size_t)bh2 * SEQ * 64; } else { Kn = nullptr; Vn = nullptr; } }
            mla::attn_unit(QB + rb * 1536 + h * 96, Kc, Vc, OB + rb * 1024 + h * 64, qgain, cosT, sinT, qb, (char*)F.lds, Kn, Vn, pre, ring); pre = Kn != nullptr; } }
}

#ifndef PROBE_BAR2
#define PROBE_BAR2 0
#endif
#ifndef REP_DSA
#define REP_DSA 1
#endif
#ifndef REP_MLA
#define REP_MLA 1
#endif
#ifndef REP_UP
#define REP_UP 1
#endif
#ifndef DSA_ENABLED
#define DSA_ENABLED 0
#endif
struct Args { const float* in[21]; float* out; unsigned char* ws; };
__global__ void __launch_bounds__(NWAVES * 64, 2) yoco_fwd(Args args) {
    extern __shared__ __attribute__((aligned(16))) unsigned char lds[];
    Frame F;
    F.lds = (LAS unsigned char*)lds;
    F.MISC = (volatile LAS unsigned*)(F.lds + MISC_OFF);
    F.tid = threadIdx.x; F.lane = F.tid & 63; F.wave = __builtin_amdgcn_readfirstlane(F.tid >> 6);
    F.G = gridDim.x; { const int bx = blockIdx.x; F.vcu = (F.G % 8 == 0) ? (bx % 8) * (F.G / 8) + bx / 8 : bx; }
    F.gw = F.vcu * NWAVES + F.wave;
    F.ctl = (gu32*)(wsp() + WS_CTL);
#define ws wsp()
    for (int u = F.tid; u < (LDS_BYTES - LDSCTL_OFF) / 4; u += NWAVES * 64) ((LAS unsigned*)(F.lds + LDSCTL_OFF))[u] = 0u;
    __syncthreads();
    (void)xcd_barrier_post((unsigned*)(wsp() + WS_CTL) + CW_BAR, F.MISC + 8);
#define GRID_BAR() do { XcdBarrier bar_; bar_.bar = (unsigned*)(wsp() + WS_CTL) + CW_BAR; bar_.x = xb_xcc_id(); bar_.st = F.MISC + 8; xcd_barrier(bar_); if (PROBE_BAR2) xcd_barrier(bar_); } while (0)
    typedef pg8::bf16_t hb_t;

    p0_prologue(F);
    GRID_BAR();

    for (int L = 0; L < 2; ++L) {
        bool mixed = false;
        if (L < 2) {
            { pg8::Gemm g{(const hb_t*)(ws + WS_HB), (const hb_t*)(ws + WS_WIN) + (size_t)L * WIN_ELEMS, M, NIN, D}; pg8::StaticOrder S; S.init(M, NIN, F.G, (int)blockIdx.x);
              pg8::EpiInproj E{L};
              pg8::gemm_phase<pg8::EpiInproj, pg8::StaticOrder, PG8_ALIGN, PG8_SP2>(F.lds + RING_OFF, g, S, E); }
            GRID_BAR();
            for (int rep_ = 0; rep_ < REP_DSA; ++rep_) dsa_phase(F);
            GRID_BAR();
            mixed = true;
        }
        if (mixed) {
            const hb_t* Wo = L < 2 ? (const hb_t*)(ws + WS_WOA) + (size_t)L * D * D : (const hb_t*)(ws + WS_WOB) + (size_t)(L - 2) * D * D;
            pg8::Gemm g{(const hb_t*)(ws + WS_OB), Wo, M, D, D}; pg8::StaticOrder S; S.init(M, D, F.G, (int)blockIdx.x);
            pg8::EpiResidT<1, 0> E{1, 0};
            pg8::gemm_phase<pg8::EpiResidT<1, 0>, pg8::StaticOrder, PG8_ALIGN, PG8_SP2>(F.lds + RING_OFF, g, S, E);
            GRID_BAR();
        }
        { pg8::Gemm g{(const hb_t*)(ws + WS_HB), (const hb_t*)(ws + WS_WUP) + (size_t)L * D * FF, M, FF, D}; pg8::StaticOrder S; S.init(M, FF, F.G, (int)blockIdx.x);
          pg8::EpiUp E{0, (int)(WS_KB / MiB)};
          pg8::gemm_phase<pg8::EpiUp, pg8::StaticOrder, PG8_ALIGN, PG8_SP2>(F.lds + RING_OFF, g, S, E); }
        GRID_BAR();
        { pg8::Gemm g{(const hb_t*)(ws + WS_KB), (const hb_t*)(ws + WS_WDN) + (size_t)L * D * FF, M, D, FF}; pg8::StaticOrder S; S.init(M, D, F.G, (int)blockIdx.x);
          pg8::EpiResidT<0, 1> E{1, 0};
          pg8::gemm_phase<pg8::EpiResidT<0, 1>, pg8::StaticOrder, PG8_ALIGN, PG8_SP2>(F.lds + RING_OFF, g, S, E); }
        GRID_BAR();
    }
    for (int L = 2; L < 4; ++L) {
        bool mixed = false;
        if (L >= 2) {
            const int j = L - 2;
            if (j == 0) { pg8::Gemm g{(const hb_t*)(ws + WS_HB), (const hb_t*)(ws + WS_WKVQ), M, NKVQ, D}; pg8::StaticOrder S; S.init(M, NKVQ, F.G, (int)blockIdx.x);
              pg8::EpiKvq<0> E{};
              pg8::gemm_phase<pg8::EpiKvq<0>, pg8::StaticOrder, PG8_ALIGN, PG8_SP2>(F.lds + RING_OFF, g, S, E); }
            else { pg8::Gemm g{(const hb_t*)(ws + WS_HB), (const hb_t*)(ws + WS_WDQ1), M, NDQ1, D}; pg8::StaticOrder S; S.init(M, NDQ1, F.G, (int)blockIdx.x);
              pg8::EpiKvq<1> E{};
              pg8::gemm_phase<pg8::EpiKvq<1>, pg8::StaticOrder, PG8_ALIGN, PG8_SP2>(F.lds + RING_OFF, g, S, E); }
            GRID_BAR();
            if (j == 0) {
                int Kk = KVLORA; asm volatile("" : "+s"(Kk));
                pg8::Gemm g{(const hb_t*)(ws + WS_CKV), (const hb_t*)(ws + WS_WUKV), M, NUKV, Kk}; pg8::StaticOrder S; S.init(M, NUKV, F.G, (int)blockIdx.x);
                pg8::EpiUkv E{};
                pg8::gemm_phase<pg8::EpiUkv, pg8::StaticOrder, PG8_ALIGN, PG8_SP2>(F.lds + RING_OFF, g, S, E); }
            { int Kk = QLORA; asm volatile("" : "+s"(Kk)); pg8::Gemm g{(const hb_t*)(ws + WS_QL), (const hb_t*)(ws + WS_WUQ) + (size_t)j * WUQ_ELEMS, M, NUQ, Kk}; pg8::StaticOrder S; S.init(M, NUQ, F.G, (int)blockIdx.x);
              pg8::EpiUq E{};
              pg8::gemm_phase<pg8::EpiUq, pg8::StaticOrder, PG8_ALIGN, PG8_SP2>(F.lds + RING_OFF, g, S, E); }
            GRID_BAR();
            for (int rep_ = 0; rep_ < REP_MLA; ++rep_) mla_phase(F, j);
            GRID_BAR();
            mixed = true;
        }
        if (mixed) {
            const hb_t* Wo = L < 2 ? (const hb_t*)(ws + WS_WOA) + (size_t)L * D * D : (const hb_t*)(ws + WS_WOB) + (size_t)(L - 2) * D * D;
            pg8::Gemm g{(const hb_t*)(ws + WS_OB), Wo, M, D, D}; pg8::StaticOrder S; S.init(M, D, F.G, (int)blockIdx.x);
            pg8::EpiResidT<1, 0> E{1, 0};
            pg8::gemm_phase<pg8::EpiResidT<1, 0>, pg8::StaticOrder, PG8_ALIGN, PG8_SP2>(F.lds + RING_OFF, g, S, E);
            GRID_BAR();
        }
        const int nhalf = L == 3 ? 1 : 2, Mrows = L == 3 ? M : MH, hid_mib = L == 3 ? (int)(WS_KB / MiB) : (int)(WS_HID / MiB);
        for (int hf = 0; hf < nhalf; ++hf) {
            const size_t r0 = (size_t)hf * MH;
            for (int rep_ = 0; rep_ < REP_UP; ++rep_)
            { pg8::Gemm g{(const hb_t*)(ws + WS_HB) + r0 * D, (const hb_t*)(ws + WS_WUP) + (size_t)L * D * FF, Mrows, FF, D}; pg8::StaticOrder S; S.init(Mrows, FF, F.G, (int)blockIdx.x);
              pg8::EpiUp E{(int)r0, hid_mib};
              pg8::gemm_phase<pg8::EpiUp, pg8::StaticOrder, PG8_ALIGN, PG8_SP2>(F.lds + RING_OFF, g, S, E); }
            GRID_BAR();
            { pg8::Gemm g{(const hb_t*)(ws + (size_t)hid_mib * MiB), (const hb_t*)(ws + WS_WDN) + (size_t)L * D * FF, Mrows, D, FF}; pg8::StaticOrder S; S.init(Mrows, D, F.G, (int)blockIdx.x);
              pg8::EpiResidT<0, 1> E{L == 3 ? 2 : 1, (int)r0};
              pg8::gemm_phase<pg8::EpiResidT<0, 1>, pg8::StaticOrder, PG8_ALIGN, PG8_SP2>(F.lds + RING_OFF, g, S, E); }
            if (L != 3) GRID_BAR();
        }
        }
#undef ws
}
extern "C" void kernel_launch(void* const* d_in, const int* in_sizes, int n_in, void* d_out, int out_size, void* d_ws, size_t ws_size, hipStream_t stream) {
    static int grid = 0;
    if (grid == 0) {
        if (n_in != 21 || in_sizes[0] != M * D || out_size != M * D || ws_size < WS_END) { fprintf(stderr, "kernel_launch: unexpected shapes: n_in %d in0 %d out %d ws %zu\n", n_in, n_in > 0 ? in_sizes[0] : -1, out_size, ws_size); grid = -1; return; }
        int dev = 0, cus = 0, per_cu = 0;
        if (hipGetDevice(&dev) != hipSuccess || hipDeviceGetAttribute(&cus, hipDeviceAttributeMultiprocessorCount, dev) != hipSuccess) { grid = -1; return; }
        if (hipFuncSetAttribute((const void*)yoco_fwd, hipFuncAttributeMaxDynamicSharedMemorySize, LDS_BYTES) != hipSuccess) { fprintf(stderr, "kernel_launch: hipFuncSetAttribute failed\n"); grid = -1; return; }
        if (hipOccupancyMaxActiveBlocksPerMultiprocessor(&per_cu, (const void*)yoco_fwd, NWAVES * 64, LDS_BYTES) != hipSuccess || per_cu < 1) { fprintf(stderr, "kernel_launch: occupancy query reports %d\n", per_cu); }
        (void)hipGetLastError();
        grid = cus;
    }
    if (grid < 0) return;
    if (hipMemsetAsync((char*)d_ws + WS_CTL, 0, CTL_ZERO_BYTES, stream) != hipSuccess) return;
    Args a{};
    for (int i = 0; i < 21; ++i) a.in[i] = (const float*)d_in[i];
    a.out = (float*)d_out; a.ws = (unsigned char*)d_ws;
    hipLaunchKernelGGL(yoco_fwd, dim3(grid), dim3(NWAVES * 64), LDS_BYTES, stream, a);
}
```
